# Optimizing an MI355X kernel written in HIP

```python
import jax, jax.numpy as jnp
from jax import lax
import numpy as np

D_MODEL = 1024
BATCH = 8
SEQ = 2048
DEPTH = 2
DEC_BATCH = 128
DEC_SEQ = 4
PAST_LEN = 16384
PAGE_SIZE = 128

N_EVEN = (DEPTH + 1) // 2
N_ODD = DEPTH // 2
NORM_EPS = 1e-6

POOL_WINDOWS = (2, 4, 8, 16)
POOL_GROUPS = len(POOL_WINDOWS)
POOL_GROUP_DIM = D_MODEL // 16
POOL_DIM = POOL_GROUPS * POOL_GROUP_DIM
POOL_BUF = max(POOL_WINDOWS) - 1

RWKV_HEAD_DIM = 64
RWKV_DIM = D_MODEL - POOL_DIM
RWKV_HEADS = RWKV_DIM // RWKV_HEAD_DIM
DECAY_LORA = 64
AAA_LORA = 64
GATE_LORA = 128
RWKV_PROJ = 3 * RWKV_DIM + DECAY_LORA + AAA_LORA + GATE_LORA
RWKV_GN_EPS = 64e-5
EVEN_PROJ = POOL_DIM + RWKV_PROJ
EVEN_MIX = POOL_DIM + RWKV_DIM

CHUNK = 128
GMLP_DIM = D_MODEL // 2
GMLP_HEADS = 4
GMLP_HEAD_DIM = GMLP_DIM // GMLP_HEADS
LN_EPS = 1e-5

LRU_DIM = D_MODEL // 2
LRU_BLOCKS = 8
LRU_BLOCK_DIM = LRU_DIM // LRU_BLOCKS
CONV_WIDTH = 4
LRU_C = 8.0
ODD_PROJ = 2 * GMLP_DIM + 2 * LRU_DIM
ODD_MIX = GMLP_DIM + LRU_DIM

D_FF = 4 * D_MODEL

kernel_name = 'pool_rwkv7_gmlp_rglru_hybrid_step'


def rmsnorm(x, g):
    xf = x.astype(jnp.float32)
    y = xf * lax.rsqrt(jnp.mean(xf * xf, -1, keepdims=True) + NORM_EPS) * g.astype(jnp.float32)
    return y.astype(x.dtype)


def pool_mixer(u, buf, start, w_grp, scale):
    B, T, _ = u.shape
    full = jnp.concatenate([buf.astype(jnp.float32), u.astype(jnp.float32)], 1)
    cs = jnp.concatenate([jnp.zeros((B, 1, POOL_DIM), jnp.float32), jnp.cumsum(full, 1)], 1)
    end = POOL_BUF + 1
    pos = start + jnp.arange(T)
    means = []
    for gi, w in enumerate(POOL_WINDOWS):
        ch = slice(gi * POOL_GROUP_DIM, (gi + 1) * POOL_GROUP_DIM)
        s = cs[:, end:end + T, ch] - cs[:, end - w:end - w + T, ch]
        cnt = jnp.minimum(w, pos + 1).astype(jnp.float32)
        means.append(s / cnt[None, :, None])
    d = (jnp.concatenate(means, -1) - full[:, POOL_BUF:]).reshape(B, T, POOL_GROUPS, POOL_GROUP_DIM)
    y = jnp.einsum('btgc,gcd->btgd', d, w_grp.astype(jnp.float32)).reshape(B, T, POOL_DIM)
    return y * scale.astype(jnp.float32), full[:, -POOL_BUF:]


def rwkv7_mixer(p, shift_prev, wkv0, mu, w0, w_w2, a0, a_w2, g_w2, k_k, k_a, r_k, gn_g, gn_b):
    f32 = jnp.float32
    B, T, _ = p.shape
    p = p.astype(f32)
    p_prev = jnp.concatenate([shift_prev.astype(f32)[:, None], p[:, :-1]], 1)
    xs = p + (p_prev - p) * mu
    splits = [RWKV_DIM, 2 * RWKV_DIM, 3 * RWKV_DIM, 3 * RWKV_DIM + DECAY_LORA, 3 * RWKV_DIM + DECAY_LORA + AAA_LORA]
    r, k, v, cw, ca, cg = jnp.split(xs, splits, axis=-1)
    w = -jax.nn.softplus(-(w0 + jnp.tanh(cw) @ w_w2)) - 0.5
    decay = jnp.exp(-jnp.exp(w))
    a = jax.nn.sigmoid(a0 + ca @ a_w2)
    g = jax.nn.sigmoid(cg) @ g_w2
    hs = lambda t: t.reshape(B, T, RWKV_HEADS, RWKV_HEAD_DIM)
    kk = hs(k * k_k)
    kk = kk / jnp.maximum(jnp.sqrt(jnp.sum(kk * kk, -1, keepdims=True)), 1e-12)
    k = k * (1.0 + (a - 1.0) * k_a)
    r, k, v, decay, a = hs(r), hs(k), hs(v), hs(decay), hs(a)

    def step(S, inp):
        r_t, k_t, v_t, w_t, kk_t, a_t = inp
        Sk = jnp.einsum('bhvk,bhk->bhv', S, kk_t)
        S = (S * w_t[:, :, None, :] - Sk[..., None] * (kk_t * a_t)[:, :, None, :]
             + v_t[..., None] * k_t[:, :, None, :])
        return S, jnp.einsum('bhvk,bhk->bhv', S, r_t)

    tm = lambda t: jnp.moveaxis(t, 1, 0)
    S_T, o = lax.scan(step, wkv0.astype(f32), (tm(r), tm(k), tm(v), tm(decay), tm(kk), tm(a)))
    o = jnp.moveaxis(o, 0, 1)
    m = jnp.mean(o, -1, keepdims=True)
    var = jnp.mean(jnp.square(o - m), -1, keepdims=True)
    o = ((o - m) * lax.rsqrt(var + RWKV_GN_EPS)).reshape(B, T, RWKV_DIM) * gn_g + gn_b
    bonus = jnp.sum(r * k * r_k, -1, keepdims=True) * v
    o = o + bonus.reshape(B, T, RWKV_DIM)
    return o * g, p[:, -1], S_T


def gmlp_mixer(q, ln_g, ln_b, ws, bs):
    f32 = jnp.float32
    B, T, _ = q.shape
    z = jax.nn.gelu(q.astype(f32))
    u, v = z[..., :GMLP_DIM], z[..., GMLP_DIM:]
    m = jnp.mean(v, -1, keepdims=True)
    var = jnp.mean(jnp.square(v - m), -1, keepdims=True)
    v = (v - m) * lax.rsqrt(var + LN_EPS) * ln_g + ln_b
    pad = (-T) % CHUNK
    nc = (T + pad) // CHUNK
    vh = jnp.pad(v, ((0, 0), (0, pad), (0, 0))).reshape(B, nc, CHUNK, GMLP_HEADS, GMLP_HEAD_DIM)
    causal = jnp.tril(jnp.ones((CHUNK, CHUNK), bool))
    wm = jnp.where(causal[None], ws.astype(f32), 0.0)
    mix = jnp.einsum('hij,bcjhd->bcihd', wm, vh) + bs.astype(f32).T[None, None, :, :, None]
    mix = mix.reshape(B, nc * CHUNK, GMLP_DIM)[:, :T]
    return u * mix, v


def rglru_mixer(q, conv_buf, h0, conv_w, conv_b, wx, bx, wa, ba, lam):
    f32 = jnp.float32
    B, T, _ = q.shape
    q = q.astype(f32)
    gate_in, xr = q[..., :LRU_DIM], q[..., LRU_DIM:]
    full = jnp.concatenate([conv_buf.astype(f32), xr], 1)
    xc = full[:, CONV_WIDTH - 1:] * conv_w[CONV_WIDTH - 1]
    for j in range(CONV_WIDTH - 1):
        xc = xc + full[:, j:j + T] * conv_w[j]
    xc = xc + conv_b
    xb = xc.reshape(B, T, LRU_BLOCKS, LRU_BLOCK_DIM)
    gx = jax.nn.sigmoid(jnp.einsum('btnc,ncd->btnd', xb, wx).reshape(B, T, LRU_DIM) + bx)
    ga = jax.nn.sigmoid(jnp.einsum('btnc,ncd->btnd', xb, wa).reshape(B, T, LRU_DIM) + ba)
    log_a = -LRU_C * ga * jax.nn.softplus(-lam)
    a = jnp.exp(log_a)
    b = jnp.sqrt(-jnp.expm1(2.0 * log_a)) * gx * xc
    b = b.at[:, 0].add(a[:, 0] * h0.astype(f32))
    comb = lambda l, r: (l[0] * r[0], r[0] * l[1] + r[1])
    _, h = lax.associative_scan(comb, (a, b), axis=1)
    y = h * jax.nn.gelu(gate_in)
    return y, full[:, -(CONV_WIDTH - 1):], h[:, -1]


def trunk(x, start, st_pool, st_shift, st_wkv, st_conv, st_lru, prm):
    n_pool, n_shift, n_wkv, n_conv, n_lru, n_v = [], [], [], [], [], []
    for layer in range(DEPTH):
        i = layer // 2
        if layer % 2 == 0:
            h = rmsnorm(x, prm['ev_norm_g'][i])
            p = h @ prm['ev_w_in'][i]
            yA, nb = pool_mixer(p[..., :POOL_DIM], st_pool[i], start, prm['pool_w'][i], prm['pool_scale'][i])
            yB, ns, nS = rwkv7_mixer(p[..., POOL_DIM:], st_shift[i], st_wkv[i], prm['rwkv_mu'][i], prm['rwkv_w0'][i],
                                     prm['rwkv_w_w2'][i], prm['rwkv_a0'][i], prm['rwkv_a_w2'][i], prm['rwkv_g_w2'][i],
                                     prm['rwkv_k_k'][i], prm['rwkv_k_a'][i], prm['rwkv_r_k'][i],
                                     prm['rwkv_gn_g'][i], prm['rwkv_gn_b'][i])
            y = jnp.concatenate([yA, yB], -1).astype(x.dtype)
            x = x + y @ prm['ev_w_out'][i]
            n_pool.append(nb); n_shift.append(ns); n_wkv.append(nS)
        else:
            h = rmsnorm(x, prm['od_norm_g'][i])
            q = h @ prm['od_w_in'][i]
            yC, vrows = gmlp_mixer(q[..., :2 * GMLP_DIM], prm['gmlp_ln_g'][i], prm['gmlp_ln_b'][i],
                                   prm['gmlp_ws'][i], prm['gmlp_bs'][i])
            yD, nc, nh = rglru_mixer(q[..., 2 * GMLP_DIM:], st_conv[i], st_lru[i], prm['lru_conv_w'][i],
                                     prm['lru_conv_b'][i], prm['lru_wx'][i], prm['lru_bx'][i], prm['lru_wa'][i],
                                     prm['lru_ba'][i], prm['lru_lam'][i])
            y = jnp.concatenate([yC, yD], -1).astype(x.dtype)
            x = x + y @ prm['od_w_out'][i]
            n_conv.append(nc); n_lru.append(nh); n_v.append(vrows)
        hf = rmsnorm(x, prm['ff_norm_g'][layer])
        x = x + jnp.square(jax.nn.relu(hf @ prm['ff_w1'][layer])) @ prm['ff_w2'][layer]
    y = rmsnorm(x, prm['final_norm_g'])
    return y, jnp.stack(n_pool), jnp.stack(n_shift), jnp.stack(n_wkv), jnp.stack(n_conv), jnp.stack(n_lru), jnp.stack(n_v)


def setup_inputs(seed: int = 0) -> dict:
    key = jax.random.key(seed)
    ks = iter(jax.random.split(key, 64))
    f32 = jnp.float32
    nrm = lambda shape, s: s * jax.random.normal(next(ks), shape, f32)
    gain = lambda shape: 1.0 + 0.02 * jax.random.normal(next(ks), shape, f32)
    unif = lambda shape, lo, hi: jax.random.uniform(next(ks), shape, f32, lo, hi)
    a_target = unif((N_ODD, LRU_DIM), 0.9, 0.999)
    s_root = a_target ** (1.0 / LRU_C)
    lru_lam = jnp.log(s_root) - jnp.log1p(-s_root)
    return {
        'x_prompt': nrm((BATCH, SEQ, D_MODEL), 1.0),
        'x_sample': nrm((DEC_BATCH, DEC_SEQ, D_MODEL), 1.0),
        'state_pool': nrm((N_EVEN, DEC_BATCH, POOL_BUF, POOL_DIM), 1.0),
        'state_shift': nrm((N_EVEN, DEC_BATCH, RWKV_PROJ), 1.0),
        'state_wkv': nrm((N_EVEN, DEC_BATCH, RWKV_HEADS, RWKV_HEAD_DIM, RWKV_HEAD_DIM), 1.0),
        'state_conv': nrm((N_ODD, DEC_BATCH, CONV_WIDTH - 1, LRU_DIM), 1.0),
        'state_lru': nrm((N_ODD, DEC_BATCH, LRU_DIM), 0.5),
        'ev_norm_g': gain((N_EVEN, D_MODEL)),
        'ev_w_in': nrm((N_EVEN, D_MODEL, EVEN_PROJ), D_MODEL ** -0.5),
        'pool_w': nrm((N_EVEN, POOL_GROUPS, POOL_GROUP_DIM, POOL_GROUP_DIM), POOL_GROUP_DIM ** -0.5),
        'pool_scale': unif((N_EVEN, POOL_DIM), 0.5, 1.0),
        'rwkv_mu': unif((N_EVEN, RWKV_PROJ), 0.0, 1.0),
        'rwkv_w0': unif((N_EVEN, RWKV_DIM), -6.0, 1.0),
        'rwkv_w_w2': nrm((N_EVEN, DECAY_LORA, RWKV_DIM), 0.5 * DECAY_LORA ** -0.5),
        'rwkv_a0': nrm((N_EVEN, RWKV_DIM), 0.5),
        'rwkv_a_w2': nrm((N_EVEN, AAA_LORA, RWKV_DIM), AAA_LORA ** -0.5),
        'rwkv_g_w2': nrm((N_EVEN, GATE_LORA, RWKV_DIM), GATE_LORA ** -0.5),
        'rwkv_k_k': unif((N_EVEN, RWKV_DIM), 0.7, 1.0),
        'rwkv_k_a': unif((N_EVEN, RWKV_DIM), 0.8, 1.2),
        'rwkv_r_k': nrm((N_EVEN, RWKV_HEADS, RWKV_HEAD_DIM), 0.1),
        'rwkv_gn_g': gain((N_EVEN, RWKV_DIM)),
        'rwkv_gn_b': nrm((N_EVEN, RWKV_DIM), 0.02),
        'ev_w_out': nrm((N_EVEN, EVEN_MIX, D_MODEL), EVEN_MIX ** -0.5),
        'od_norm_g': gain((N_ODD, D_MODEL)),
        'od_w_in': nrm((N_ODD, D_MODEL, ODD_PROJ), D_MODEL ** -0.5),
        'gmlp_ln_g': gain((N_ODD, GMLP_DIM)),
        'gmlp_ln_b': nrm((N_ODD, GMLP_DIM), 0.02),
        'gmlp_ws': nrm((N_ODD, GMLP_HEADS, CHUNK, CHUNK), CHUNK ** -0.5),
        'gmlp_bs': 1.0 + nrm((N_ODD, GMLP_HEADS, CHUNK), 0.01),
        'lru_conv_w': nrm((N_ODD, CONV_WIDTH, LRU_DIM), CONV_WIDTH ** -0.5),
        'lru_conv_b': nrm((N_ODD, LRU_DIM), 0.02),
        'lru_wx': nrm((N_ODD, LRU_BLOCKS, LRU_BLOCK_DIM, LRU_BLOCK_DIM), LRU_BLOCK_DIM ** -0.5),
        'lru_bx': nrm((N_ODD, LRU_DIM), 0.02),
        'lru_wa': nrm((N_ODD, LRU_BLOCKS, LRU_BLOCK_DIM, LRU_BLOCK_DIM), LRU_BLOCK_DIM ** -0.5),
        'lru_ba': nrm((N_ODD, LRU_DIM), 0.02),
        'lru_lam': lru_lam,
        'od_w_out': nrm((N_ODD, ODD_MIX, D_MODEL), ODD_MIX ** -0.5),
        'ff_norm_g': gain((DEPTH, D_MODEL)),
        'ff_w1': nrm((DEPTH, D_MODEL, D_FF), D_MODEL ** -0.5),
        'ff_w2': nrm((DEPTH, D_FF, D_MODEL), D_FF ** -0.5),
        'final_norm_g': gain((D_MODEL,)),
    }


def reference(x_prompt, x_sample, state_pool, state_shift, state_wkv, state_conv, state_lru,
              ev_norm_g, ev_w_in, pool_w, pool_scale, rwkv_mu, rwkv_w0, rwkv_w_w2, rwkv_a0, rwkv_a_w2,
              rwkv_g_w2, rwkv_k_k, rwkv_k_a, rwkv_r_k, rwkv_gn_g, rwkv_gn_b, ev_w_out,
              od_norm_g, od_w_in, gmlp_ln_g, gmlp_ln_b, gmlp_ws, gmlp_bs, lru_conv_w, lru_conv_b,
              lru_wx, lru_bx, lru_wa, lru_ba, lru_lam, od_w_out,
              ff_norm_g, ff_w1, ff_w2, final_norm_g):
    prm = dict(ev_norm_g=ev_norm_g, ev_w_in=ev_w_in, pool_w=pool_w, pool_scale=pool_scale, rwkv_mu=rwkv_mu,
               rwkv_w0=rwkv_w0, rwkv_w_w2=rwkv_w_w2, rwkv_a0=rwkv_a0, rwkv_a_w2=rwkv_a_w2, rwkv_g_w2=rwkv_g_w2,
               rwkv_k_k=rwkv_k_k, rwkv_k_a=rwkv_k_a, rwkv_r_k=rwkv_r_k, rwkv_gn_g=rwkv_gn_g, rwkv_gn_b=rwkv_gn_b,
               ev_w_out=ev_w_out, od_norm_g=od_norm_g, od_w_in=od_w_in, gmlp_ln_g=gmlp_ln_g, gmlp_ln_b=gmlp_ln_b,
               gmlp_ws=gmlp_ws, gmlp_bs=gmlp_bs, lru_conv_w=lru_conv_w, lru_conv_b=lru_conv_b, lru_wx=lru_wx,
               lru_bx=lru_bx, lru_wa=lru_wa, lru_ba=lru_ba, lru_lam=lru_lam, od_w_out=od_w_out,
               ff_norm_g=ff_norm_g, ff_w1=ff_w1, ff_w2=ff_w2, final_norm_g=final_norm_g)
    dt = x_prompt.dtype
    B = x_prompt.shape[0]
    z_pool = jnp.zeros((N_EVEN, B, POOL_BUF, POOL_DIM), dt)
    z_shift = jnp.zeros((N_EVEN, B, RWKV_PROJ), dt)
    z_wkv = jnp.zeros((N_EVEN, B, RWKV_HEADS, RWKV_HEAD_DIM, RWKV_HEAD_DIM), dt)
    z_conv = jnp.zeros((N_ODD, B, CONV_WIDTH - 1, LRU_DIM), dt)
    z_lru = jnp.zeros((N_ODD, B, LRU_DIM), dt)
    y_prompt, p_pool, p_shift, p_wkv, p_conv, p_lru, _ = trunk(
        x_prompt, 0, z_pool, z_shift, z_wkv, z_conv, z_lru, prm)
    y_sample, s_pool, s_shift, s_wkv, s_conv, s_lru, s_gmlp_v = trunk(
        x_sample, PAST_LEN, state_pool, state_shift, state_wkv, state_conv, state_lru, prm)
    return (y_prompt, y_sample, p_pool, p_shift, p_wkv, p_conv, p_lru,
            s_pool, s_shift, s_wkv, s_conv, s_lru, s_gmlp_v)
```

```cpp
#include <hip/hip_runtime.h>
#include <hip/hip_cooperative_groups.h>
#include <cstdio>
namespace cg = cooperative_groups;

typedef unsigned short u16;
typedef __attribute__((ext_vector_type(8))) short bf16x8;
typedef __attribute__((ext_vector_type(16))) float f32x16;

constexpr int MT = 16896;
constexpr int NP = 16384;

struct Params {
  const float* in[41];
  float* out;
  char* ws;
};

constexpr size_t OUT_Y = 0;
constexpr size_t OUT_PPOOL = (size_t)MT * 1024;
constexpr size_t OUT_PSHIFT = OUT_PPOOL + 8 * 15 * 256;
constexpr size_t OUT_PWKV = OUT_PSHIFT + 8 * 2560;
constexpr size_t OUT_PCONV = OUT_PWKV + 8 * 12 * 4096;
constexpr size_t OUT_PLRU = OUT_PCONV + 8 * 3 * 512;
constexpr size_t OUT_SPOOL = OUT_PLRU + 8 * 512;
constexpr size_t OUT_SSHIFT = OUT_SPOOL + 128 * 15 * 256;
constexpr size_t OUT_SWKV = OUT_SSHIFT + 128 * 2560;
constexpr size_t OUT_SCONV = OUT_SWKV + (size_t)128 * 12 * 4096;
constexpr size_t OUT_SLRU = OUT_SCONV + 128 * 3 * 512;
constexpr size_t OUT_SGV = OUT_SLRU + 128 * 512;

constexpr size_t O_WIN0 = 0;
constexpr size_t O_WOUT0 = O_WIN0 + 2816ull * 1024 * 2;
constexpr size_t O_WF10 = O_WOUT0 + 1024ull * 1024 * 2;
constexpr size_t O_WF20 = O_WF10 + 4096ull * 1024 * 2;
constexpr size_t O_WIN1 = O_WF20 + 4096ull * 1024 * 2;
constexpr size_t O_WOUT1 = O_WIN1 + 2048ull * 1024 * 2;
constexpr size_t O_WF11 = O_WOUT1 + 1024ull * 1024 * 2;
constexpr size_t O_WF21 = O_WF11 + 4096ull * 1024 * 2;
constexpr size_t O_WLW = O_WF21 + 4096ull * 1024 * 2;
constexpr size_t O_WLA = O_WLW + 768 * 64 * 2;
constexpr size_t O_WLG = O_WLA + 768 * 64 * 2;
constexpr size_t O_WM = O_WLG + 768 * 128 * 2;
constexpr size_t O_CNT = O_WM + 4 * 128 * 128 * 2;
constexpr size_t O_PART = O_CNT + 256;
constexpr size_t O_XB = O_PART + (size_t)MT * 16 * 4;
constexpr size_t O_Y = O_XB + (size_t)MT * 1024 * 2;
constexpr size_t O_AR = O_Y + (size_t)MT * 1024 * 2;
constexpr size_t O_P = O_AR;
constexpr size_t O_LIN = O_P + (size_t)MT * 2816 * 2;
constexpr size_t O_WPRE = O_LIN + (size_t)MT * 256 * 2;
constexpr size_t O_APRE = O_XB;
constexpr size_t O_BS = O_APRE + (size_t)MT * 768 * 2;
constexpr size_t O_CA = O_AR + (size_t)MT * 2048 * 2;
constexpr size_t O_HL = O_CA + (size_t)MT * 512 * 4;
constexpr size_t O_SEG = O_HL + (size_t)MT * 512 * 4;
constexpr size_t O_H = O_AR;
constexpr size_t O_XBAR = O_SEG + (size_t)1056 * 1024 * 4;
constexpr size_t O_CAR = O_XBAR + 16384;
constexpr size_t O_WXT = O_CAR + (size_t)1024 * 512 * 4;
constexpr size_t WS_NEED = O_WXT + 131072;

__device__ __forceinline__ u16 f2bf(float f) {
  __bf16 h = (__bf16)f;
  return __builtin_bit_cast(u16, h);
}
__device__ __forceinline__ float bf2f(u16 h) { return __uint_as_float(((unsigned)h) << 16); }
__device__ __forceinline__ float frcp_(float x) { return __builtin_amdgcn_rcpf(x); }
__device__ __forceinline__ float sigmoidf_(float x) { return frcp_(1.0f + __expf(-x)); }
__device__ __forceinline__ float tanhf_(float x) {
  float e = __expf(2.0f * x);
  return 1.0f - 2.0f * frcp_(1.0f + e);
}
__device__ __forceinline__ float geluf_(float x) {
  float y = 0.7978845608028654f * (x + 0.044715f * x * x * x);
  return 0.5f * x * (1.0f + tanhf_(y));
}
template <int CTRL>
__device__ __forceinline__ float dppmov(float v) {
  return __int_as_float(__builtin_amdgcn_update_dpp(0, __float_as_int(v), CTRL, 0xF, 0xF, true));
}
__device__ __forceinline__ float reduce8(float v) {
  v += dppmov<0xB1>(v);
  v += dppmov<0x4E>(v);
  v += dppmov<0x141>(v);
  return v;
}
__device__ __forceinline__ float row16sum(float v) {
  v += dppmov<0xB1>(v);
  v += dppmov<0x4E>(v);
  v += dppmov<0x141>(v);
  v += dppmov<0x140>(v);
  return v;
}
__device__ __forceinline__ float wsum64(float v) {
  v = row16sum(v);
  v += __int_as_float(__builtin_amdgcn_update_dpp(0, __float_as_int(v), 0x142, 0xA, 0xF, false));
  v += __int_as_float(__builtin_amdgcn_update_dpp(0, __float_as_int(v), 0x143, 0xC, 0xF, false));
  return __int_as_float(__builtin_amdgcn_readlane(__float_as_int(v), 63));
}
__device__ __forceinline__ float hsum32(float v) {
  v = row16sum(v);
  return v + __shfl_xor(v, 16);
}
__device__ __forceinline__ const float* xrow(const Params& p, int row) {
  return row < NP ? p.in[0] + (size_t)row * 1024 : p.in[1] + (size_t)(row - NP) * 1024;
}
__device__ __forceinline__ float prevP(const Params& p, const u16* P, int row, int c) {
  const int rp = row > 0 ? row - 1 : 0;
  float v = bf2f(P[(size_t)rp * 2816 + 256 + c]);
  const bool start = (row < NP) ? ((row & 2047) == 0) : (((row - NP) & 3) == 0);
  if (start) v = (row < NP) ? 0.f : p.in[3][(size_t)((row - NP) >> 2) * 2560 + c];
  return v;
}

__shared__ __attribute__((aligned(16))) unsigned char smem[114688];
#define RAW_BARRIER() do { asm volatile("s_waitcnt lgkmcnt(0)" ::: "memory"); __builtin_amdgcn_s_barrier(); asm volatile("" ::: "memory"); } while (0)
__shared__ int s_task;
__shared__ int s_simdcnt[4];
__shared__ int s_role[8];
__shared__ int s_role2[8];

#define XB_TMO      128
#define XB_XCNT(j)  (256  + 64 * (j))
#define XB_XSUB(j)  (1280 + 64 * (j))
#define XB_XGEN(j)  (2304 + 64 * (j))
#define XB_TOP      3328
#define XB_TOPGEN   3392
#define XCD_BAR_WORDS 3456
#define XB_SPIN_CAP (1u << 18)
#define LAS __attribute__((address_space(3)))

__device__ __forceinline__ unsigned xb_ld(unsigned* p)              { return __hip_atomic_load(p, __ATOMIC_RELAXED, __HIP_MEMORY_SCOPE_AGENT); }
__device__ __forceinline__ unsigned xb_add(unsigned* p, unsigned v) { return __hip_atomic_fetch_add(p, v, __ATOMIC_RELAXED, __HIP_MEMORY_SCOPE_AGENT); }
__device__ __forceinline__ unsigned xb_xcc_id() { return (unsigned)__builtin_amdgcn_s_getreg((3 << 11) | 20) & 0xFu; }
#define XB_SPIN(cond, bar) do { unsigned _sp = 0; while (cond) { __builtin_amdgcn_s_sleep(1); \
    if ((++_sp & 255u) == 0u) { if (xb_ld(&(bar)[XB_TMO])) break; if (_sp > XB_SPIN_CAP) { atomicAdd(&(bar)[XB_TMO], 1u); break; } } } } while (0)

struct XcdBarrier {
    unsigned* bar; unsigned x;
    volatile LAS unsigned* st;
};

__device__ __forceinline__ XcdBarrier xcd_barrier_post(unsigned* bar, volatile LAS unsigned* st) {
    XcdBarrier b; b.bar = bar; b.x = xb_xcc_id(); b.st = st;
    if (threadIdx.x == 0) (void)xb_add(&bar[XB_XCNT(b.x)], 1u);
    return b;
}
__device__ __forceinline__ void xcd_barrier_complete(unsigned* bar, unsigned x, unsigned& nloc, unsigned& nx) {
    const unsigned G = gridDim.x * gridDim.y * gridDim.z;
    unsigned sum, cnt, mine, sp = 0u;
    for (;;) {
        sum = 0u; cnt = 0u; mine = 0u;
#pragma unroll
        for (unsigned j = 0; j < 16; ++j) { const unsigned c = xb_ld(&bar[XB_XCNT(j)]); sum += c; cnt += (c > 0u) ? 1u : 0u; mine = (j == x) ? c : mine; }
        if (sum == G) break;
        __builtin_amdgcn_s_sleep(1);
        if ((++sp & 255u) == 0u) { if (xb_ld(&bar[XB_TMO])) break; if (sp > XB_SPIN_CAP) { atomicAdd(&bar[XB_TMO], 1u); break; } }
    }
    nloc = mine > 0u ? mine : 1u; nx = cnt > 0u ? cnt : 1u;
}

__device__ __forceinline__ void xcd_barrier(const XcdBarrier& b) {
    asm volatile("s_waitcnt vmcnt(0)" ::: "memory");
    __syncthreads();
    if (threadIdx.x == 0) {
        unsigned* bar = b.bar;
        __builtin_amdgcn_s_waitcnt(0);
        unsigned nloc = b.st[0], nx = b.st[1];
        if (nloc == 0u) { xcd_barrier_complete(bar, b.x, nloc, nx); b.st[0] = nloc; b.st[1] = nx; }
        const unsigned old = xb_add(&bar[XB_XSUB(b.x)], 1u);
        const unsigned gen = old / nloc;
        if (old + 1u == (gen + 1u) * nloc) {
            __builtin_amdgcn_fence(__ATOMIC_RELEASE, "agent");
            asm volatile("s_waitcnt vmcnt(0)" ::: "memory");
            const unsigned og = xb_add(&bar[XB_TOP], 1u);
            const unsigned tg = og / nx;
            if (og + 1u == (tg + 1u) * nx) xb_add(&bar[XB_TOPGEN], 1u);
            else XB_SPIN(xb_ld(&bar[XB_TOPGEN]) == tg, bar);
            __builtin_amdgcn_fence(__ATOMIC_ACQUIRE, "agent");
            xb_add(&bar[XB_XGEN(b.x)], 1u);
            asm volatile("s_waitcnt vmcnt(0)" ::: "memory");
        } else {
            XB_SPIN(xb_ld(&bar[XB_XGEN(b.x)]) == gen, bar);
            __builtin_amdgcn_fence(__ATOMIC_ACQUIRE, "agent");
            asm volatile("s_waitcnt vmcnt(0)" ::: "memory");
        }
    }
    __syncthreads();
}


__device__ __forceinline__ void convT(const float* __restrict__ W, int K, int N, const float* __restrict__ g, u16* __restrict__ WT) {
  float* t = (float*)smem;
  const int tilesN = N / 128, tiles = (K / 64) * tilesN;
  const int tx = threadIdx.x & 127, ty = threadIdx.x >> 7;
  const int sx = threadIdx.x & 63, sy = threadIdx.x >> 6;
  for (int tl = blockIdx.x; tl < tiles; tl += gridDim.x) {
    const int k0 = (tl / tilesN) * 64, n0 = (tl % tilesN) * 128;
    float v[16];
#pragma unroll
    for (int i = 0; i < 16; i++) v[i] = W[(size_t)(k0 + ty + 4 * i) * N + n0 + tx];
    if (g) {
#pragma unroll
      for (int i = 0; i < 16; i++) v[i] *= g[k0 + ty + 4 * i];
    }
    __syncthreads();
#pragma unroll
    for (int i = 0; i < 16; i++) t[(ty + 4 * i) * 129 + tx] = v[i];
    __syncthreads();
#pragma unroll
    for (int i = 0; i < 16; i++) {
      const int n = sy + 8 * i;
      WT[(size_t)(n0 + n) * K + k0 + sx] = f2bf(t[sx * 129 + n]);
    }
  }
}

__device__ __forceinline__ void phase0(const Params& p) {
  char* ws = p.ws;
  convT(p.in[8], 1024, 2816, p.in[7], (u16*)(ws + O_WIN0));
  convT(p.in[22], 1024, 1024, nullptr, (u16*)(ws + O_WOUT0));
  convT(p.in[38], 1024, 4096, p.in[37], (u16*)(ws + O_WF10));
  convT(p.in[39], 4096, 1024, nullptr, (u16*)(ws + O_WF20));
  convT(p.in[24], 1024, 2048, p.in[23], (u16*)(ws + O_WIN1));
  convT(p.in[36], 1024, 1024, nullptr, (u16*)(ws + O_WOUT1));
  convT(p.in[38] + (size_t)1024 * 4096, 1024, 4096, p.in[37] + 1024, (u16*)(ws + O_WF11));
  convT(p.in[39] + (size_t)1024 * 4096, 4096, 1024, nullptr, (u16*)(ws + O_WF21));
  convT(p.in[13], 64, 768, nullptr, (u16*)(ws + O_WLW));
  convT(p.in[15], 64, 768, nullptr, (u16*)(ws + O_WLA));
  convT(p.in[16], 128, 768, nullptr, (u16*)(ws + O_WLG));
  {
    u16* wm = (u16*)(ws + O_WM);
    const float* wsrc = p.in[27];
    for (int e = blockIdx.x * 512 + threadIdx.x; e < 4 * 128 * 128; e += gridDim.x * 512) {
      int i = (e >> 7) & 127, j = e & 127;
      wm[e] = (j <= i) ? f2bf(wsrc[e]) : (u16)0;
    }
  }
  {
    u16* wxt = (u16*)(ws + O_WXT);
    for (int e = blockIdx.x * 512 + threadIdx.x; e < 16 * 64 * 64; e += gridDim.x * 512) {
      const int m = e >> 12, d = (e >> 6) & 63, c = e & 63;
      const float* src = (m < 8) ? p.in[31] : p.in[33];
      wxt[e] = f2bf(src[(m & 7) * 4096 + c * 64 + d]);
    }
  }
  if (blockIdx.x == 0 && threadIdx.x < 64) ((int*)(ws + O_CNT))[threadIdx.x] = 0;
  if (blockIdx.x == 1) for (int e = threadIdx.x; e < 3456; e += 512) ((unsigned*)(ws + O_XBAR))[e] = 0u;
  for (int e = blockIdx.x * 512 + threadIdx.x; e < 512 * 256; e += gridDim.x * 512) ((float4*)(p.out + (size_t)NP * 1024))[e] = ((const float4*)p.in[1])[e];
  {
    u16* xb = (u16*)(ws + O_XB);
    float* part = (float*)(ws + O_PART);
    const int lane = threadIdx.x & 63, wave = threadIdx.x >> 6;
    for (int row = blockIdx.x * 8 + wave; row < MT; row += gridDim.x * 8) {
      const float* xr = xrow(p, row);
      float ss = 0.f;
#pragma unroll
      for (int i = 0; i < 4; i++) {
        float4 v = *(const float4*)(xr + i * 256 + lane * 4);
        ss += v.x * v.x + v.y * v.y + v.z * v.z + v.w * v.w;
        ushort4 o;
        o.x = f2bf(v.x); o.y = f2bf(v.y); o.z = f2bf(v.z); o.w = f2bf(v.w);
        *(ushort4*)(xb + (size_t)row * 1024 + i * 256 + lane * 4) = o;
      }
      ss = wsum64(ss);
      if (lane < 16) part[(size_t)row * 16 + lane] = (lane == 0) ? ss : 0.f;
    }
  }
}

enum { EPI_SCALE = 0, EPI_PLAIN = 1, EPI_FF1 = 2, EPI_RES = 3, EPI_POST = 4 };

template <int EPI>
__device__ __forceinline__ void gemm_epi(const Params& p, const f32x16 acc0, const f32x16 acc1, int mi, int wm, int wn, int lane,
                                         int m0, int nt, int c0, int c1, const float* sRs, u16* __restrict__ outb, int ldo,
                                         int resid_in) {
  float* part = (float*)(p.ws + O_PART);
  float* xf = p.out;
    const int rbase = wm * 64 + mi * 32 + 4 * (lane >> 5);
    if (EPI == EPI_SCALE || EPI == EPI_PLAIN || EPI == EPI_FF1) {
#pragma unroll
      for (int i = 0; i < 16; i++) {
        const int rl = rbase + (i & 3) + 8 * (i >> 2);
        const int row = m0 + rl;
        float v0 = acc0[i], v1 = acc1[i];
        if (EPI != EPI_PLAIN) { float rs = sRs[rl]; v0 *= rs; v1 *= rs; }
        if (EPI == EPI_FF1) { v0 = fmaxf(v0, 0.f); v1 = fmaxf(v1, 0.f); v0 *= v0; v1 *= v1; }
        outb[(size_t)row * ldo + c0] = f2bf(v0);
        outb[(size_t)row * ldo + c1] = f2bf(v1);
      }
    } else if (EPI == EPI_RES) {
#pragma unroll
      for (int i = 0; i < 16; i++) {
        const int rl = rbase + (i & 3) + 8 * (i >> 2);
        const int row = m0 + rl;
        const float* res = resid_in ? xrow(p, row) : (xf + (size_t)row * 1024);
        float v0 = res[c0] + acc0[i], v1 = res[c1] + acc1[i];
        xf[(size_t)row * 1024 + c0] = v0;
        xf[(size_t)row * 1024 + c1] = v1;
        outb[(size_t)row * 1024 + c0] = f2bf(v0);
        outb[(size_t)row * 1024 + c1] = f2bf(v1);
        float s = hsum32(v0 * v0 + v1 * v1);
        if ((lane & 31) == 0) part[(size_t)row * 16 + nt * 2 + wn] = s;
      }
    } else {
      const int hh = nt * 2 + wn;
      const u16* P = (const u16*)(p.ws + O_P);
      u16* Y = (u16*)(p.ws + O_Y);
      const float* bs = (const float*)(p.ws + O_BS);
      const int ch0 = hh * 64 + (lane & 31), ch1 = ch0 + 32;
      const float gg0 = p.in[20][ch0], gg1 = p.in[20][ch1];
      const float gb0 = p.in[21][ch0], gb1 = p.in[21][ch1];
      const float mu0 = p.in[11][1536 + ch0], mu1 = p.in[11][1536 + ch1];
#pragma unroll 8
      for (int i = 0; i < 16; i++) {
        const int rl = rbase + (i & 3) + 8 * (i >> 2);
        const int row = m0 + rl;
        float o0 = bf2f(Y[(size_t)row * 1024 + 256 + ch0]);
        float o1 = bf2f(Y[(size_t)row * 1024 + 256 + ch1]);
        float mean = hsum32(o0 + o1) * (1.0f / 64.0f);
        float d0 = o0 - mean, d1 = o1 - mean;
        float var = hsum32(d0 * d0 + d1 * d1) * (1.0f / 64.0f);
        float rstd = rsqrtf(var + 64e-5f);
        float pv0 = bf2f(P[(size_t)row * 2816 + 256 + 1536 + ch0]);
        float pv1 = bf2f(P[(size_t)row * 2816 + 256 + 1536 + ch1]);
        float pp0 = prevP(p, P, row, 1536 + ch0), pp1 = prevP(p, P, row, 1536 + ch1);
        float vv0 = pv0 + (pp0 - pv0) * mu0, vv1 = pv1 + (pp1 - pv1) * mu1;
        float b = bs[((size_t)row * 12 + hh) * 4 + 2];
        float y0 = (d0 * rstd * gg0 + gb0 + b * vv0) * acc0[i];
        float y1 = (d1 * rstd * gg1 + gb1 + b * vv1) * acc1[i];
        Y[(size_t)row * 1024 + 256 + ch0] = f2bf(y0);
        Y[(size_t)row * 1024 + 256 + ch1] = f2bf(y1);
      }
    }
}

template <int EPI>
__device__ __forceinline__ void gemm_phase(const Params& p, const u16* __restrict__ A, int lda, const u16* __restrict__ BT, int ldb,
                           int K, int N, u16* __restrict__ outb, int ldo, int resid_in, int boff) {
  constexpr int LS = 72;
  constexpr int SA = 256 * LS, SB = 128 * LS, STG = SA + SB;
  u16* sm = (u16*)smem;
  float* sRs = (float*)(sm + 2 * STG);
  const int tid = threadIdx.x, lane = tid & 63, wave = tid >> 6;
  const int wm = wave >> 1, wn = wave & 1;
  const int lrow = tid >> 3, lch = tid & 7;
  const int NT = N / 128;
  const int tiles = (MT / 256) * NT;
  const int KTALL = K / 64;
  float* part = (float*)(p.ws + O_PART);
  int bstart = (int)blockIdx.x - boff;
  if (bstart < 0) bstart += gridDim.x;
  const size_t a64 = (size_t)64 * lda, b64 = (size_t)64 * ldb;
  const int G = gridDim.x;
  int t_full = tiles, split = 1;
  if (EPI == EPI_RES) {
    const int tail = tiles % G;
    if (tail > 0 && (G % tail) == 0 && (KTALL % (G / tail)) == 0) { t_full = tiles - tail; split = G / tail; }
  }
  const int units = t_full + (tiles - t_full) * split;
  for (int un = bstart; un < units; un += G) {
    int tl = un, kbeg = 0, KT = KTALL;
    bool part_unit = false;
    if (un >= t_full) { const int v = un - t_full; tl = t_full + v / split; KT = KTALL / split; kbeg = (v % split) * KT; part_unit = true; }
    int mt = tl / NT, nt = tl % NT;
    if (EPI == EPI_RES && NT == 8 && G == 256 && !part_unit) {
      const int rr = tl >> 8, bb = tl & 255;
      const int xx = bb & 7, jj = bb >> 3;
      mt = rr * 32 + xx * 4 + (jj >> 3);
      nt = jj & 7;
    } else if ((EPI == EPI_FF1 || EPI == EPI_SCALE) && G == 256 && (NT == 32 || NT == 16) && tl < (tiles & ~255)) {
      const int rr = tl >> 8, bb = tl & 255;
      const int xx = bb & 7, jj = bb >> 3;
      if (NT == 32) { mt = rr * 8 + (xx >> 2) * 4 + (jj >> 3); nt = (xx & 3) * 8 + (jj & 7); }
      else { mt = rr * 16 + (xx >> 1) * 4 + (jj >> 3); nt = (xx & 1) * 8 + (jj & 7); }
    }
    const int m0 = mt * 256, n0 = nt * 128;
    const u16* gA = A + (size_t)(m0 + lrow) * lda + lch * 8 + (size_t)kbeg * 64;
    const u16* gB = BT + (size_t)(n0 + lrow) * ldb + lch * 8 + (size_t)kbeg * 64;
    uint4 xa0, xa1, xa2, xa3, xb0, xb1;
    uint4 ya0, ya1, ya2, ya3, yb0, yb1;
#define LOADX(kt_) { const u16* qa = gA + (kt_) * 64; const u16* qb = gB + (kt_) * 64; \
    xa0 = *(const uint4*)qa; xa1 = *(const uint4*)(qa + a64); xa2 = *(const uint4*)(qa + 2 * a64); xa3 = *(const uint4*)(qa + 3 * a64); \
    xb0 = *(const uint4*)qb; xb1 = *(const uint4*)(qb + b64); }
#define LOADY(kt_) { const u16* qa = gA + (kt_) * 64; const u16* qb = gB + (kt_) * 64; \
    ya0 = *(const uint4*)qa; ya1 = *(const uint4*)(qa + a64); ya2 = *(const uint4*)(qa + 2 * a64); ya3 = *(const uint4*)(qa + 3 * a64); \
    yb0 = *(const uint4*)qb; yb1 = *(const uint4*)(qb + b64); }
#define WRITEX(st_) { u16* wa = sm + (st_) * STG + lrow * LS + lch * 8; u16* wb = wa + SA; \
    *(uint4*)wa = xa0; *(uint4*)(wa + 64 * LS) = xa1; *(uint4*)(wa + 128 * LS) = xa2; *(uint4*)(wa + 192 * LS) = xa3; \
    *(uint4*)wb = xb0; *(uint4*)(wb + 64 * LS) = xb1; }
#define WRITEY(st_) { u16* wa = sm + (st_) * STG + lrow * LS + lch * 8; u16* wb = wa + SA; \
    *(uint4*)wa = ya0; *(uint4*)(wa + 64 * LS) = ya1; *(uint4*)(wa + 128 * LS) = ya2; *(uint4*)(wa + 192 * LS) = ya3; \
    *(uint4*)wb = yb0; *(uint4*)(wb + 64 * LS) = yb1; }
#define COMPUTE(st_) { const u16* ab = sm + (st_) * STG + (wm * 64 + (lane & 31)) * LS + (lane >> 5) * 8; \
    const u16* bb = sm + (st_) * STG + SA + (wn * 64 + (lane & 31)) * LS + (lane >> 5) * 8; \
    _Pragma("unroll") for (int ks = 0; ks < 4; ks++) { \
      bf16x8 fa0 = *(const bf16x8*)(ab + ks * 16); bf16x8 fa1 = *(const bf16x8*)(ab + 32 * LS + ks * 16); \
      bf16x8 fb0 = *(const bf16x8*)(bb + ks * 16); bf16x8 fb1 = *(const bf16x8*)(bb + 32 * LS + ks * 16); \
      acc00 = __builtin_amdgcn_mfma_f32_32x32x16_bf16(fa0, fb0, acc00, 0, 0, 0); \
      acc01 = __builtin_amdgcn_mfma_f32_32x32x16_bf16(fa0, fb1, acc01, 0, 0, 0); \
      acc10 = __builtin_amdgcn_mfma_f32_32x32x16_bf16(fa1, fb0, acc10, 0, 0, 0); \
      acc11 = __builtin_amdgcn_mfma_f32_32x32x16_bf16(fa1, fb1, acc11, 0, 0, 0); } }
    LOADX(0);
    if (KT > 1) LOADY(1);
    __syncthreads();
    if (EPI == EPI_SCALE || EPI == EPI_FF1) {
      if (tid < 256) {
        const float4* pp = (const float4*)(part + (size_t)(m0 + tid) * 16);
        float4 a = pp[0], b = pp[1], c = pp[2], d = pp[3];
        float s = (a.x + a.y + a.z + a.w) + (b.x + b.y + b.z + b.w) + (c.x + c.y + c.z + c.w) + (d.x + d.y + d.z + d.w);
        sRs[tid] = rsqrtf(s * (1.0f / 1024.0f) + 1e-6f);
      }
    }
    WRITEX(0);
    if (KT > 2) LOADX(2);
    RAW_BARRIER();
    f32x16 acc00, acc01, acc10, acc11;
#pragma unroll
    for (int i = 0; i < 16; i++) { acc00[i] = 0.f; acc01[i] = 0.f; acc10[i] = 0.f; acc11[i] = 0.f; }
    for (int kt = 0; kt < KT; kt += 2) {
      if (kt + 1 < KT) WRITEY(1);
      if (kt + 3 < KT) LOADY(kt + 3);
      COMPUTE(0);
      RAW_BARRIER();
      if (kt + 1 >= KT) break;
      if (kt + 2 < KT) WRITEX(0);
      if (kt + 4 < KT) LOADX(kt + 4);
      COMPUTE(1);
      RAW_BARRIER();
    }
#undef LOADX
#undef LOADY
#undef WRITEX
#undef WRITEY
#undef COMPUTE
    const int c0 = n0 + wn * 64 + (lane & 31);
    const int c1 = c0 + 32;
    if (EPI == EPI_RES && part_unit) {
      float* xfp = p.out;
#pragma unroll
      for (int i = 0; i < 16; i++) {
        const int rl = wm * 64 + 4 * (lane >> 5) + (i & 3) + 8 * (i >> 2);
        float* r0p = xfp + (size_t)(m0 + rl) * 1024;
        float* r1p = r0p + (size_t)32 * 1024;
        atomicAdd(r0p + c0, acc00[i]); atomicAdd(r0p + c1, acc01[i]);
        atomicAdd(r1p + c0, acc10[i]); atomicAdd(r1p + c1, acc11[i]);
      }
    } else {
      gemm_epi<EPI>(p, acc00, acc01, 0, wm, wn, lane, m0, nt, c0, c1, sRs, outb, ldo, resid_in);
      gemm_epi<EPI>(p, acc10, acc11, 1, wm, wn, lane, m0, nt, c0, c1, sRs, outb, ldo, resid_in);
    }
  }
}

__device__ __forceinline__ void pool_item(const Params& p, int it) {
  const u16* P = (const u16*)(p.ws + O_P);
  u16* Y = (u16*)(p.ws + O_Y);
  float* hist = (float*)smem;
  float* dS = hist + 47 * 256;
  const int tid = threadIdx.x;
  const int col = tid & 255, hf = tid >> 8;
  const int gi = col >> 6, dd = col & 63;
  const int w = 2 << gi;
  const float* pw = p.in[9] + gi * 4096 + dd;
  const float sc = p.in[10][col];
  {
    int r0, t0, nrows, pos0;
    const float* st = nullptr;
    const float* shs = nullptr;
    if (it < 512) { r0 = it * 32; t0 = r0 & 2047; nrows = 32; pos0 = t0; }
    else { const int b = it - 512; r0 = NP + b * 4; t0 = 0; nrows = 4; pos0 = 16384; st = p.in[2] + (size_t)b * 3840; shs = p.in[3] + (size_t)b * 2560; }
    __syncthreads();
    const int nh = 15 + nrows;
#pragma unroll 8
    for (int hr = hf; hr < nh; hr += 2) {
      const int t = t0 - 15 + hr;
      float v = 0.f;
      if (t >= 0) v = bf2f(P[(size_t)(r0 - t0 + t) * 2816 + col]);
      else if (st) v = st[(15 + t) * 256 + col];
      hist[hr * 256 + col] = v;
    }
    __syncthreads();
    const int q0 = hf * 16;
    for (int q = 0; q < 16; q++) {
      const int tk = q0 + q;
      if (tk < nrows) {
        float s = 0.f;
        for (int i = 0; i < w; i++) s += hist[(15 + tk - i) * 256 + col];
        const float cnt = (float)min(w, pos0 + tk + 1);
        dS[tk * 256 + col] = s / cnt - hist[(15 + tk) * 256 + col];
      }
    }
    __syncthreads();
    float acc[16];
#pragma unroll
    for (int q = 0; q < 16; q++) acc[q] = 0.f;
    if (q0 < nrows) {
#pragma unroll 4
      for (int c = 0; c < 64; c += 4) {
        float w0 = pw[(c + 0) * 64], w1 = pw[(c + 1) * 64], w2 = pw[(c + 2) * 64], w3 = pw[(c + 3) * 64];
#pragma unroll
        for (int q = 0; q < 16; q++) {
          float4 d = *(const float4*)(dS + (q0 + q) * 256 + gi * 64 + c);
          acc[q] += d.x * w0 + d.y * w1 + d.z * w2 + d.w * w3;
        }
      }
    }
#pragma unroll
    for (int q = 0; q < 16; q++) {
      if (q0 + q < nrows) Y[(size_t)(r0 + q0 + q) * 1024 + col] = f2bf(acc[q] * sc);
    }
  }
}

__device__ __forceinline__ void pool_phase(const Params& p) {
  const u16* P = (const u16*)(p.ws + O_P);
  u16* LIN = (u16*)(p.ws + O_LIN);
  const int tid = threadIdx.x;
  const int col = tid & 255, hf = tid >> 8;
  const float mu = p.in[11][2304 + col];
  for (int it = blockIdx.x; it < 512 + 128; it += gridDim.x) {
    int r0, t0, nrows;
    const float* shs = nullptr;
    if (it < 512) { r0 = it * 32; t0 = r0 & 2047; nrows = 32; }
    else { const int b = it - 512; r0 = NP + b * 4; t0 = 0; nrows = 4; shs = p.in[3] + (size_t)b * 2560; }
    const int q0 = hf * 16;
    if (q0 < nrows) {
      const int nq = min(16, nrows - q0);
      float pv[17];
      {
        const int rowp = r0 + q0 - 1;
        float v0;
        if (t0 + q0 == 0) v0 = shs ? shs[2304 + col] : 0.f;
        else v0 = bf2f(P[(size_t)rowp * 2816 + 2560 + col]);
        pv[0] = v0;
      }
#pragma unroll
      for (int q = 0; q < 16; q++) pv[q + 1] = (q < nq) ? bf2f(P[(size_t)(r0 + q0 + q) * 2816 + 2560 + col]) : 0.f;
#pragma unroll
      for (int q = 0; q < 16; q++) {
        if (q < nq) {
          float xs = pv[q + 1] + (pv[q] - pv[q + 1]) * mu;
          float v = (col < 64) ? tanhf_(xs) : ((col < 128) ? xs : sigmoidf_(xs));
          LIN[(size_t)(r0 + q0 + q) * 256 + col] = f2bf(v);
        }
      }
    }
  }
  const int gt = blockIdx.x * 512 + tid, gs = gridDim.x * 512;
  for (int e = gt; e < 8 * 15 * 256; e += gs) {
    int b = e / 3840, r = (e / 256) % 15, c = e & 255;
    p.out[OUT_PPOOL + e] = bf2f(P[(size_t)(b * 2048 + 2033 + r) * 2816 + c]);
  }
  for (int e = gt; e < 128 * 15 * 256; e += gs) {
    int b = e / 3840, r = (e / 256) % 15, c = e & 255;
    float v;
    if (r < 11) v = p.in[2][(size_t)b * 3840 + (r + 4) * 256 + c];
    else v = bf2f(P[(size_t)(NP + b * 4 + (r - 11)) * 2816 + c]);
    p.out[OUT_SPOOL + e] = v;
  }
  for (int e = gt; e < 8 * 2560; e += gs) {
    int b = e / 2560, c = e % 2560;
    p.out[OUT_PSHIFT + e] = bf2f(P[(size_t)(b * 2048 + 2047) * 2816 + 256 + c]);
  }
  for (int e = gt; e < 128 * 2560; e += gs) {
    int b = e / 2560, c = e % 2560;
    p.out[OUT_SSHIFT + e] = bf2f(P[(size_t)(NP + b * 4 + 3) * 2816 + 256 + c]);
  }
}

__device__ __forceinline__ void rwkv_prep_phase(const Params& p) {
  const u16* P = (const u16*)(p.ws + O_P);
  u16* APRE = (u16*)(p.ws + O_APRE);
  u16* WPRE = (u16*)(p.ws + O_WPRE);
  float* SC = (float*)(p.ws + O_BS);
  const int lane = threadIdx.x & 63, wave = __builtin_amdgcn_readfirstlane(threadIdx.x >> 6);
  for (int row = blockIdx.x * 8 + wave; row < MT; row += gridDim.x * 8) {
    const u16* Pr = P + (size_t)row * 2816 + 256;
#pragma unroll 12
    for (int h = 0; h < 12; h++) {
      const int ch = h * 64 + lane;
      float pr = bf2f(Pr[ch]), pk = bf2f(Pr[768 + ch]);
      float qr = prevP(p, P, row, ch), qk = prevP(p, P, row, 768 + ch);
      float wl = p.in[12][ch] + bf2f(WPRE[(size_t)row * 768 + ch]);
      float r = pr + (qr - pr) * p.in[11][ch], k = pk + (qk - pk) * p.in[11][768 + ch];
      float a = sigmoidf_(p.in[14][ch] + bf2f(APRE[(size_t)row * 768 + ch]));
      a = bf2f(f2bf(a));
      float omd = 1.0f - __expf(-0.6065306597126334f * sigmoidf_(wl));
      float kkr = k * p.in[17][ch];
      float n2 = wsum64(kkr * kkr);
      float inv = frcp_(fmaxf(__builtin_amdgcn_sqrtf(n2), 1e-12f));
      float kap = kkr * inv;
      float kp = k * (1.0f + (a - 1.0f) * p.in[18][ch]);
      float al = kap * a;
      float ar = wsum64(al * r);
      float kr = wsum64(kp * r);
      float bsum = wsum64(r * kp * p.in[19][ch]);
      APRE[(size_t)row * 768 + ch] = f2bf(a);
      WPRE[(size_t)row * 768 + ch] = f2bf(omd);
      if (lane == 0) *(float4*)(SC + ((size_t)row * 12 + h) * 4) = make_float4(ar, kr, bsum, inv);
    }
  }
}

constexpr int TC = 16;
typedef float v2f __attribute__((ext_vector_type(2)));
typedef float v4f __attribute__((ext_vector_type(4)));

struct StRaw {
  unsigned cr[2], ck[2], cv[2];
  unsigned qr[2], qk[2], qv[2];
  unsigned wp[2], ap[2];
  float inv[2], sc2[2];
  v2f s_r, s_k, s_v;
  float m;
};
struct StConst { v2f mur, muk, muv, kk_, ka_; };

__device__ __forceinline__ v2f bfpair(unsigned u) {
  v2f r;
  r.x = __uint_as_float(u << 16);
  r.y = __uint_as_float(u & 0xffff0000u);
  return r;
}

template <bool SAMPLE>
__device__ __forceinline__ void st_load(const Params& p, StRaw& R, int row0, int b, int h, int c, int sw, int lane) {
  const u16* P = (const u16*)(p.ws + O_P);
  const u16* WPRE = (const u16*)(p.ws + O_WPRE);
  const u16* APRE = (const u16*)(p.ws + O_APRE);
  const float* SC = (const float*)(p.ws + O_BS);
  const int l2 = lane & 31, tp = lane >> 5;
  const int ch = h * 64 + 2 * l2;
  const int t0 = c * TC + sw * 4;
  R.m = (t0 + tp == 0) ? 0.f : 1.f;
  if (SAMPLE) {
    const float* sp = p.in[3] + (size_t)b * 2560 + ch;
    R.s_r = *(const v2f*)sp; R.s_k = *(const v2f*)(sp + 768); R.s_v = *(const v2f*)(sp + 1536);
  }
#pragma unroll
  for (int ps = 0; ps < 2; ps++) {
    const int t = t0 + 2 * ps + tp;
    const int tq = t > 0 ? t - 1 : 0;
    const u16* Pc = P + (size_t)(row0 + t) * 2816 + 256 + ch;
    const u16* Pq = P + (size_t)(row0 + tq) * 2816 + 256 + ch;
    R.cr[ps] = *(const unsigned*)Pc; R.ck[ps] = *(const unsigned*)(Pc + 768); R.cv[ps] = *(const unsigned*)(Pc + 1536);
    R.qr[ps] = *(const unsigned*)Pq; R.qk[ps] = *(const unsigned*)(Pq + 768); R.qv[ps] = *(const unsigned*)(Pq + 1536);
    const size_t row = row0 + t;
    R.wp[ps] = *(const unsigned*)(WPRE + row * 768 + ch);
    R.ap[ps] = *(const unsigned*)(APRE + row * 768 + ch);
    R.inv[ps] = SC[(row * 12 + h) * 4 + 3];
    R.sc2[ps] = SC[(row * 12 + h) * 4 + (lane & 1)];
  }
}

template <bool SAMPLE>
__device__ __forceinline__ void st_compute(const StConst& K, const StRaw& R, int sw, int lane, float* ops, float* scal) {
  const int l2 = lane & 31, tp = lane >> 5;
#pragma unroll
  for (int ps = 0; ps < 2; ps++) {
    const int tt = sw * 4 + 2 * ps + tp;
    v2f pr = bfpair(R.cr[ps]), pk = bfpair(R.ck[ps]), pv = bfpair(R.cv[ps]);
    v2f qr = bfpair(R.qr[ps]), qk = bfpair(R.qk[ps]), qv = bfpair(R.qv[ps]);
    if (ps == 0) {
      if (SAMPLE) { if (R.m == 0.f) { qr = R.s_r; qk = R.s_k; qv = R.s_v; } }
      else { const v2f mm = {R.m, R.m}; qr *= mm; qk *= mm; qv *= mm; }
    }
    const v2f r = pr + (qr - pr) * K.mur;
    const v2f k = pk + (qk - pk) * K.muk;
    const v2f v = pv + (qv - pv) * K.muv;
    const v2f one = {1.0f, 1.0f};
    const v2f dec = one - bfpair(R.wp[ps]);
    const v2f a = bfpair(R.ap[ps]);
    const v2f iv = {R.inv[ps], R.inv[ps]};
    const v2f kap = k * K.kk_ * iv;
    const v2f kp = k * (one + (a - one) * K.ka_);
    float* o6 = ops + tt * 384 + 2 * l2;
    *(v2f*)(o6) = dec; *(v2f*)(o6 + 64) = kap * a; *(v2f*)(o6 + 128) = kp; *(v2f*)(o6 + 192) = kap; *(v2f*)(o6 + 256) = dec * r; *(v2f*)(o6 + 320) = v;
    if (l2 < 2) scal[tt * 2 + l2] = R.sc2[ps];
  }
}

struct ScD { v4f a0, a1, q0, q1; };
struct ScU { v4f w0, w1, l0, l1, k0, k1; float v; v2f sc; };
__device__ __forceinline__ void scd_load(ScD& O, const float* o6, int j8) {
  O.a0 = *(const v4f*)(o6 + 192 + j8); O.a1 = *(const v4f*)(o6 + 192 + j8 + 4);
  O.q0 = *(const v4f*)(o6 + 256 + j8); O.q1 = *(const v4f*)(o6 + 256 + j8 + 4);
}
__device__ __forceinline__ void scu_load(ScU& O, const float* o6, const float* sb, int tt, int j8, int srow) {
  O.w0 = *(const v4f*)(o6 + j8); O.w1 = *(const v4f*)(o6 + j8 + 4);
  O.l0 = *(const v4f*)(o6 + 64 + j8); O.l1 = *(const v4f*)(o6 + 64 + j8 + 4);
  O.k0 = *(const v4f*)(o6 + 128 + j8); O.k1 = *(const v4f*)(o6 + 128 + j8 + 4);
  O.v = o6[320 + srow];
  O.sc = *(const v2f*)(sb + tt * 2);
}
__device__ __forceinline__ void sc_step(const ScD& D, const ScU& U, v2f& s0, v2f& s1, v2f& s2, v2f& s3, float* obuf, int tt, int lane) {
  v2f pd2 = s0 * D.a0.lo;
  v2f qd2 = s0 * D.q0.lo;
  pd2 = s1 * D.a0.hi + pd2; qd2 = s1 * D.q0.hi + qd2;
  pd2 = s2 * D.a1.lo + pd2; qd2 = s2 * D.q1.lo + qd2;
  pd2 = s3 * D.a1.hi + pd2; qd2 = s3 * D.q1.hi + qd2;
  float pd = reduce8(pd2.x + pd2.y);
  float qd = reduce8(qd2.x + qd2.y);
  const float v = U.v;
  const float o = qd - pd * U.sc.x + v * U.sc.y;
  const v2f vv = {v, v};
  const v2f np = {-pd, -pd};
  s0 = s0 * U.w0.lo + (np * U.l0.lo + vv * U.k0.lo);
  s1 = s1 * U.w0.hi + (np * U.l0.hi + vv * U.k0.hi);
  s2 = s2 * U.w1.lo + (np * U.l1.lo + vv * U.k1.lo);
  s3 = s3 * U.w1.hi + (np * U.l1.hi + vv * U.k1.hi);
  obuf[tt * 8 + (lane >> 3)] = o;
}

template <int STEPS>
__device__ __forceinline__ void scan_steps(v2f& s0, v2f& s1, v2f& s2, v2f& s3, const float* ob, const float* sb, int j8, int srow,
                                           float* obuf, int lane) {
  ScD A, B, C;
  ScU P, Q;
  scd_load(A, ob, j8);
  scu_load(P, ob, sb, 0, j8, srow);
  scd_load(B, ob + 384, j8);
#define SC_STEP(DX_, DZ_, UX_, UZ_, tt_) { \
    if ((tt_) + 1 < STEPS) scu_load(UZ_, ob + ((tt_) + 1) * 384, sb, (tt_) + 1, j8, srow); \
    if ((tt_) + 2 < STEPS) scd_load(DZ_, ob + ((tt_) + 2) * 384, j8); \
    asm volatile("" ::: "memory"); sc_step(DX_, UX_, s0, s1, s2, s3, obuf, (tt_), lane); asm volatile("" ::: "memory"); }
  SC_STEP(A, C, P, Q, 0) SC_STEP(B, A, Q, P, 1) SC_STEP(C, B, P, Q, 2) SC_STEP(A, C, Q, P, 3)
  if (STEPS > 4) {
    SC_STEP(B, A, P, Q, 4) SC_STEP(C, B, Q, P, 5) SC_STEP(A, C, P, Q, 6) SC_STEP(B, A, Q, P, 7)
    SC_STEP(C, B, P, Q, 8) SC_STEP(A, C, Q, P, 9) SC_STEP(B, A, P, Q, 10) SC_STEP(C, B, Q, P, 11)
    SC_STEP(A, C, P, Q, 12) SC_STEP(B, A, Q, P, 13) SC_STEP(C, B, P, Q, 14) SC_STEP(A, C, Q, P, 15)
  }
#undef SC_STEP
}

__device__ __forceinline__ void scan_phase(const Params& p, int cidx, int task_lo, int task_hi) {
  float* ops = (float*)smem;
  float* scal = ops + 2 * TC * 384;
  float* obufs = scal + 2 * TC * 2;
  u16* Y = (u16*)(p.ws + O_Y);
  int* counter = (int*)(p.ws + O_CNT) + cidx;
  const int tid = threadIdx.x, lane = tid & 63, wave = __builtin_amdgcn_readfirstlane(tid >> 6);
  {
    if (tid < 4) s_simdcnt[tid] = 0;
    __syncthreads();
    if (lane == 0) {
      const int simd = (int)__builtin_amdgcn_s_getreg(2308) & 3;
      const int r = atomicAdd(&s_simdcnt[simd], 1);
      s_role[wave] = simd | (r << 4);
    }
    __syncthreads();
    if (tid == 0) {
      int ns = 0;
      for (int w = 0; w < 8; w++) ns += ((s_role[w] >> 4) == 0);
      int st = 0;
      for (int w = 0; w < 8; w++) {
        int v;
        if (ns == 4) v = ((s_role[w] >> 4) == 0) ? (s_role[w] & 3) : (4 + st++);
        else v = w;
        s_role2[w] = v;
      }
    }
    __syncthreads();
  }
  const int rolew = __builtin_amdgcn_readfirstlane(s_role2[wave]);
  while (true) {
    __syncthreads();
    if (tid == 0) s_task = atomicAdd(counter, 1);
    __syncthreads();
    const int task = __builtin_amdgcn_readfirstlane(s_task) + task_lo;
    if (task >= task_hi) break;
    int b, h, half, row0, T;
    bool sample;
    if (task < 192) { b = task / 24; h = (task % 24) >> 1; half = task & 1; row0 = b * 2048; T = 2048; sample = false; }
    else { int u = task - 192; b = u / 24; h = (u % 24) >> 1; half = u & 1; row0 = NP + b * 4; T = 4; sample = true; }
    const int nch = (T + TC - 1) / TC;
    const int sbase = half * 32 + (rolew & 3) * 8;
    const int srow = sbase + (lane >> 3);
    const int j8 = (lane & 7) * 8;
    float* obuf = obufs + (rolew & 3) * 128;
    if (rolew < 4) {
      v2f s0 = {0.f, 0.f}, s1 = s0, s2 = s0, s3 = s0;
      if (sample) {
        const float* sp = p.in[4] + ((size_t)(b * 12 + h) * 64 + srow) * 64 + j8;
        v4f x0 = *(const v4f*)sp, x1 = *(const v4f*)(sp + 4);
        s0 = x0.lo; s1 = x0.hi; s2 = x1.lo; s3 = x1.hi;
      }
      RAW_BARRIER();
      for (int c = 0; c < nch; c++) {
        const int buf = c & 1;
        const float* ob = ops + buf * TC * 384;
        const float* sb = scal + buf * TC * 2;
        if (sample) scan_steps<4>(s0, s1, s2, s3, ob, sb, j8, srow, obuf, lane);
        else scan_steps<TC>(s0, s1, s2, s3, ob, sb, j8, srow, obuf, lane);
        const int tt = lane >> 2, pr = lane & 3;
        if (tt < T) {
          v2f ov = *(const v2f*)(obuf + tt * 8 + 2 * pr);
          unsigned pk = (unsigned)f2bf(ov.x) | ((unsigned)f2bf(ov.y) << 16);
          *(unsigned*)(Y + (size_t)(row0 + c * TC + tt) * 1024 + 256 + h * 64 + sbase + 2 * pr) = pk;
        }
        RAW_BARRIER();
      }
      float* dp = p.out + (sample ? OUT_SWKV : OUT_PWKV) + ((size_t)(b * 12 + h) * 64 + srow) * 64 + j8;
      *(float4*)dp = make_float4(s0.x, s0.y, s1.x, s1.y);
      *(float4*)(dp + 4) = make_float4(s2.x, s2.y, s3.x, s3.y);
    } else {
      const int sw = rolew - 4;
      const int ch = h * 64 + 2 * (lane & 31);
      StConst K;
      K.mur = *(const v2f*)(p.in[11] + ch); K.muk = *(const v2f*)(p.in[11] + 768 + ch); K.muv = *(const v2f*)(p.in[11] + 1536 + ch);
      K.kk_ = *(const v2f*)(p.in[17] + ch); K.ka_ = *(const v2f*)(p.in[18] + ch);
      if (sample) {
        if (sw == 0) {
          StRaw RS;
          st_load<true>(p, RS, row0, b, h, 0, 0, lane);
          st_compute<true>(K, RS, 0, lane, ops, scal);
        }
        RAW_BARRIER();
        RAW_BARRIER();
      } else {
        StRaw RA, RB;
        st_load<false>(p, RA, row0, b, h, 0, sw, lane);
        st_compute<false>(K, RA, sw, lane, ops, scal);
        st_load<false>(p, RA, row0, b, h, 1, sw, lane);
        st_load<false>(p, RB, row0, b, h, 2, sw, lane);
        RAW_BARRIER();
        for (int c = 0; c < nch; c += 2) {
          st_compute<false>(K, RA, sw, lane, ops + TC * 384, scal + TC * 2);
          st_load<false>(p, RA, row0, b, h, (c + 3 < nch) ? c + 3 : c + 1, sw, lane);
          RAW_BARRIER();
          st_compute<false>(K, RB, sw, lane, ops, scal);
          st_load<false>(p, RB, row0, b, h, (c + 4 < nch) ? c + 4 : c + 2 < nch ? c + 2 : c, sw, lane);
          RAW_BARRIER();
        }
      }
    }
  }
}

__device__ __forceinline__ void pool_queue(const Params& p) {
  int* counter = (int*)(p.ws + O_CNT) + 2;
  while (true) {
    __syncthreads();
    if (threadIdx.x == 0) s_task = atomicAdd(counter, 1);
    __syncthreads();
    const int it = __builtin_amdgcn_readfirstlane(s_task);
    if (it >= 640) break;
    pool_item(p, it);
  }
}

__device__ __forceinline__ void mix1_phase(const Params& p) {
  const u16* Q = (const u16*)(p.ws + O_P);
  u16* Y = (u16*)(p.ws + O_Y);
  const u16* WM = (const u16*)(p.ws + O_WM);
  const int tid = threadIdx.x, lane = tid & 63, wave = tid >> 6;
  constexpr int N_GP = 512, N_GS = 128, N_LRU = MT / 16;
  for (int it = blockIdx.x; it < N_GP + N_GS + N_LRU; it += gridDim.x) {
    __syncthreads();
    if (it < N_GP) {
      const int h = it & 3, ck = (it >> 2) & 15, b = it >> 6;
      const int r0 = b * 2048 + ck * 128;
      u16* vT = (u16*)smem;
      {
        const u16* qb = Q + (size_t)(r0 + wave * 16) * 2048 + 512 + lane * 8;
        float lg[8], lb[8];
        if ((lane >> 4) == h) {
#pragma unroll
          for (int e = 0; e < 8; e++) { lg[e] = p.in[25][h * 128 + (lane & 15) * 8 + e]; lb[e] = p.in[26][h * 128 + (lane & 15) * 8 + e]; }
        } else {
#pragma unroll
          for (int e = 0; e < 8; e++) { lg[e] = 0.f; lb[e] = 0.f; }
        }
        uint4 cur0 = *(const uint4*)(qb), cur1 = *(const uint4*)(qb + 2048), cur2 = *(const uint4*)(qb + 2 * 2048), cur3 = *(const uint4*)(qb + 3 * 2048);
        for (int bt = 0; bt < 4; bt++) {
          uint4 nx0 = cur0, nx1 = cur1, nx2 = cur2, nx3 = cur3;
          if (bt < 3) {
            const u16* qn = qb + (size_t)(bt + 1) * 4 * 2048;
            nx0 = *(const uint4*)(qn); nx1 = *(const uint4*)(qn + 2048); nx2 = *(const uint4*)(qn + 2 * 2048); nx3 = *(const uint4*)(qn + 3 * 2048);
          }
#pragma unroll
          for (int u = 0; u < 4; u++) {
            const uint4 raw = (u == 0) ? cur0 : (u == 1) ? cur1 : (u == 2) ? cur2 : cur3;
            const int j = wave * 16 + bt * 4 + u;
            const u16* rp = (const u16*)&raw;
            float z[8];
            float sm = 0.f;
#pragma unroll
            for (int e = 0; e < 8; e++) { z[e] = geluf_(bf2f(rp[e])); sm += z[e]; }
            const float mean = wsum64(sm) * (1.0f / 512.0f);
            float s2 = 0.f;
#pragma unroll
            for (int e = 0; e < 8; e++) { z[e] -= mean; s2 += z[e] * z[e]; }
            const float rstd = rsqrtf(wsum64(s2) * (1.0f / 512.0f) + 1e-5f);
            if ((lane >> 4) == h) {
#pragma unroll
              for (int e = 0; e < 8; e++) {
                const int d = (lane & 15) * 8 + e;
                vT[d * 136 + j] = f2bf(z[e] * rstd * lg[e] + lb[e]);
              }
            }
          }
          cur0 = nx0; cur1 = nx1; cur2 = nx2; cur3 = nx3;
        }
      }
      __syncthreads();
      const int wm = wave >> 1, wn = wave & 1;
      f32x16 acc0, acc1;
#pragma unroll
      for (int i = 0; i < 16; i++) { acc0[i] = 0.f; acc1[i] = 0.f; }
      const u16* ag = WM + (size_t)h * 16384 + (size_t)(wm * 32 + (lane & 31)) * 128 + (lane >> 5) * 8;
      const u16* bb = vT + (wn * 64 + (lane & 31)) * 136 + (lane >> 5) * 8;
      const int nks = 2 * (wm + 1);
      for (int ks = 0; ks < nks; ks++) {
        bf16x8 a = *(const bf16x8*)(ag + ks * 16);
        bf16x8 b0 = *(const bf16x8*)(bb + ks * 16);
        bf16x8 b1 = *(const bf16x8*)(bb + 32 * 136 + ks * 16);
        acc0 = __builtin_amdgcn_mfma_f32_32x32x16_bf16(a, b0, acc0, 0, 0, 0);
        acc1 = __builtin_amdgcn_mfma_f32_32x32x16_bf16(a, b1, acc1, 0, 0, 0);
      }
      const int d0 = h * 128 + wn * 64 + (lane & 31), d1 = d0 + 32;
#pragma unroll 4
      for (int i = 0; i < 16; i++) {
        const int il = wm * 32 + (i & 3) + 8 * (i >> 2) + 4 * (lane >> 5);
        const int row = r0 + il;
        const float bsv = p.in[28][h * 128 + il];
        float u0 = geluf_(bf2f(Q[(size_t)row * 2048 + d0]));
        float u1 = geluf_(bf2f(Q[(size_t)row * 2048 + d1]));
        Y[(size_t)row * 1024 + d0] = f2bf(u0 * (acc0[i] + bsv));
        Y[(size_t)row * 1024 + d1] = f2bf(u1 * (acc1[i] + bsv));
      }
    } else if (it < N_GP + N_GS) {
      const int b = it - N_GP;
      const int r0 = NP + b * 4;
      float* vs = (float*)smem;
      if (wave < 4) {
        const int row = r0 + wave;
        uint4 raw = *(const uint4*)(Q + (size_t)row * 2048 + 512 + lane * 8);
        const u16* rp = (const u16*)&raw;
        float z[8];
        float s = 0.f;
#pragma unroll
        for (int e = 0; e < 8; e++) { z[e] = geluf_(bf2f(rp[e])); s += z[e]; }
        const float mean = wsum64(s) * (1.0f / 512.0f);
        float s2 = 0.f;
#pragma unroll
        for (int e = 0; e < 8; e++) { z[e] -= mean; s2 += z[e] * z[e]; }
        const float rstd = rsqrtf(wsum64(s2) * (1.0f / 512.0f) + 1e-5f);
#pragma unroll
        for (int e = 0; e < 8; e++) {
          const int d = lane * 8 + e;
          float vn = z[e] * rstd * p.in[25][d] + p.in[26][d];
          vs[wave * 512 + d] = vn;
          p.out[OUT_SGV + (size_t)(b * 4 + wave) * 512 + d] = vn;
        }
      }
      __syncthreads();
      {
        const int ch = tid, hh = ch >> 7;
        for (int i = 0; i < 4; i++) {
          float mix = p.in[28][hh * 128 + i];
          for (int j = 0; j <= i; j++) mix += p.in[27][(size_t)(hh * 128 + i) * 128 + j] * vs[j * 512 + ch];
          float u = geluf_(bf2f(Q[(size_t)(r0 + i) * 2048 + ch]));
          Y[(size_t)(r0 + i) * 1024 + ch] = f2bf(u * mix);
        }
      }
    } else {
      const int li = it - N_GP - N_GS;
      const int r0 = li * 16;
      u16* xcb = (u16*)smem;
      float* gxs = (float*)(smem + 16 * 520 * 2);
      float* gas = gxs + 16 * 512;
      const int ch = tid;
      float* CA = (float*)(p.ws + O_CA);
      float* HL = (float*)(p.ws + O_HL);
      float* SEG = (float*)(p.ws + O_SEG);
      const float cw0 = p.in[29][ch], cw1 = p.in[29][512 + ch], cw2 = p.in[29][1024 + ch], cw3 = p.in[29][1536 + ch];
      const float cb = p.in[30][ch];
      {
        float xr[19];
#pragma unroll
        for (int q = 0; q < 19; q++) {
          const int row = r0 - 3 + q;
          float v = 0.f;
          bool valid;
          int tq;
          if (r0 < NP) { tq = (r0 & 2047) - 3 + q; valid = tq >= 0; }
          else { valid = true; tq = 0; }
          if (r0 < NP) { if (valid) v = bf2f(Q[(size_t)row * 2048 + 1536 + ch]); }
          else v = bf2f(Q[(size_t)(row < NP ? NP : row) * 2048 + 1536 + ch]);
          xr[q] = v;
        }
#pragma unroll
        for (int q = 0; q < 16; q++) {
          float x0 = xr[q], x1 = xr[q + 1], x2 = xr[q + 2], x3 = xr[q + 3];
          if (r0 >= NP) {
            const int rs = r0 - NP + q;
            const int t = rs & 3;
            const float* st = p.in[5] + (size_t)(rs >> 2) * 1536 + ch;
            if (t < 3) x0 = st[t * 512];
            if (t < 2) x1 = st[(t + 1) * 512];
            if (t < 1) x2 = st[(t + 2) * 512];
          }
          const float xc = cb + cw0 * x0 + cw1 * x1 + cw2 * x2 + cw3 * x3;
          xcb[q * 520 + ch] = f2bf(xc);
        }
      }
      __syncthreads();
      {
        const u16* WXT = (const u16*)(p.ws + O_WXT);
        const int n = wave;
        typedef __attribute__((ext_vector_type(4))) float f32x4;
        f32x4 ac[8];
#pragma unroll
        for (int i = 0; i < 8; i++) { ac[i][0] = 0.f; ac[i][1] = 0.f; ac[i][2] = 0.f; ac[i][3] = 0.f; }
#pragma unroll
        for (int kh = 0; kh < 2; kh++) {
          const bf16x8 af = *(const bf16x8*)(xcb + (lane & 15) * 520 + n * 64 + kh * 32 + (lane >> 4) * 8);
          bf16x8 bfr[8];
#pragma unroll
          for (int i = 0; i < 8; i++) {
            const int w = i >> 2, dt = i & 3;
            bfr[i] = *(const bf16x8*)(WXT + ((size_t)((w * 8 + n) * 64 + dt * 16 + (lane & 15))) * 64 + kh * 32 + (lane >> 4) * 8);
          }
#pragma unroll
          for (int i = 0; i < 8; i++) ac[i] = __builtin_amdgcn_mfma_f32_16x16x32_bf16(af, bfr[i], ac[i], 0, 0, 0);
        }
#pragma unroll
        for (int i = 0; i < 8; i++) {
          const int w = i >> 2, dt = i & 3;
          float* dst = (w ? gas : gxs) + n * 64 + dt * 16 + (lane & 15);
#pragma unroll
          for (int r = 0; r < 4; r++) dst[((lane >> 4) * 4 + r) * 512] = ac[i][r];
        }
      }
      __syncthreads();
      const float bx = p.in[32][ch], ba = p.in[34][ch];
      const float lam = p.in[35][ch];
      const float spl = fmaxf(-lam, 0.f) + log1pf(__expf(-fabsf(lam)));
      float hl = 0.f, ca = 1.f;
#pragma unroll 4
      for (int q = 0; q < 16; q++) {
        const int row = r0 + q;
        if (row >= NP) {
          int rs = row - NP;
          if ((rs & 3) == 0) { hl = p.in[6][(size_t)(rs >> 2) * 512 + ch]; ca = 1.f; }
        }
        float gx = sigmoidf_(gxs[q * 512 + ch] + bx), ga = sigmoidf_(gas[q * 512 + ch] + ba);
        float la = -8.0f * ga * spl;
        float a = __expf(la);
        float bb = __builtin_amdgcn_sqrtf(fmaxf(1.0f - a * a, 0.f)) * gx * bf2f(xcb[q * 520 + ch]);
        hl = a * hl + bb;
        ca = ca * a;
        CA[(size_t)row * 512 + ch] = ca;
        HL[(size_t)row * 512 + ch] = hl;
      }
      SEG[(size_t)li * 1024 + ch] = ca;
      SEG[(size_t)li * 1024 + 512 + ch] = hl;
    }
  }
}

__device__ __forceinline__ void lru_fix_phase(const Params& p, const XcdBarrier& xb) {
  const u16* Q = (const u16*)(p.ws + O_P);
  u16* Y = (u16*)(p.ws + O_Y);
  const float* CA = (const float*)(p.ws + O_CA);
  const float* HL = (const float*)(p.ws + O_HL);
  const float* SEG = (const float*)(p.ws + O_SEG);
  const int ch = threadIdx.x;
  const bool blocked = (gridDim.x == 256);
  for (int k = 0; k < (blocked ? 1 : 0); k++) {
    const int li0 = blockIdx.x * 4;
    const int b = li0 >> 7, s0 = li0 & 127;
    const float* sg = SEG + (size_t)(b * 128) * 1024 + ch;
    float carry = 0.f;
#pragma unroll 8
    for (int q = 0; q < s0; q++) carry = sg[(size_t)q * 1024] * carry + sg[(size_t)q * 1024 + 512];
    for (int u = 0; u < 4; u++) {
      const int li = li0 + u;
      const int r0 = li * 16;
#pragma unroll 8
      for (int q = 0; q < 16; q++) {
        const int row = r0 + q;
        float hv = HL[(size_t)row * 512 + ch] + CA[(size_t)row * 512 + ch] * carry;
        float gate = geluf_(bf2f(Q[(size_t)row * 2048 + 1024 + ch]));
        Y[(size_t)row * 1024 + 512 + ch] = f2bf(hv * gate);
        if ((row & 2047) == 2047) p.out[OUT_PLRU + (size_t)(row >> 11) * 512 + ch] = hv;
      }
      carry = sg[(size_t)(s0 + u) * 1024] * carry + sg[(size_t)(s0 + u) * 1024 + 512];
    }
  }
  for (int li = (blocked ? 1024 : 0) + blockIdx.x; li < MT / 16; li += gridDim.x) {
    const int r0 = li * 16;
    float carry = 0.f;
    if (r0 < NP) {
      const int b = r0 >> 11, sN = (r0 & 2047) >> 4;
      const float* sg = SEG + (size_t)(b * 128) * 1024 + ch;
      for (int q = 0; q < sN; q++) carry = sg[(size_t)q * 1024] * carry + sg[(size_t)q * 1024 + 512];
    }
#pragma unroll 8
    for (int q = 0; q < 16; q++) {
      const int row = r0 + q;
      float hv = HL[(size_t)row * 512 + ch] + CA[(size_t)row * 512 + ch] * carry;
      float gate = geluf_(bf2f(Q[(size_t)row * 2048 + 1024 + ch]));
      Y[(size_t)row * 1024 + 512 + ch] = f2bf(hv * gate);
      if (row < NP) {
        if ((row & 2047) == 2047) p.out[OUT_PLRU + (size_t)(row >> 11) * 512 + ch] = hv;
      } else {
        int rs = row - NP;
        if ((rs & 3) == 3) p.out[OUT_SLRU + (size_t)(rs >> 2) * 512 + ch] = hv;
      }
    }
  }
  const int gt = blockIdx.x * 512 + threadIdx.x, gs = gridDim.x * 512;
  for (int e = gt; e < 8 * 3 * 512; e += gs) {
    int b = e / 1536, i = (e / 512) % 3, c = e & 511;
    p.out[OUT_PCONV + e] = bf2f(Q[(size_t)(b * 2048 + 2045 + i) * 2048 + 1536 + c]);
  }
  for (int e = gt; e < 128 * 3 * 512; e += gs) {
    int b = e / 1536, i = (e / 512) % 3, c = e & 511;
    p.out[OUT_SCONV + e] = bf2f(Q[(size_t)(NP + b * 4 + 1 + i) * 2048 + 1536 + c]);
  }
}

__device__ __forceinline__ void res_fix_phase(const Params& p) {
  u16* xb = (u16*)(p.ws + O_XB);
  float* part = (float*)(p.ws + O_PART);
  const int lane = threadIdx.x & 63, wave = threadIdx.x >> 6;
  for (int row = NP + blockIdx.x * 8 + wave; row < MT; row += gridDim.x * 8) {
    const float* xr = p.out + (size_t)row * 1024;
    float ss = 0.f;
#pragma unroll
    for (int i = 0; i < 4; i++) {
      float4 v = *(const float4*)(xr + i * 256 + lane * 4);
      ss += v.x * v.x + v.y * v.y + v.z * v.z + v.w * v.w;
      ushort4 o;
      o.x = f2bf(v.x); o.y = f2bf(v.y); o.z = f2bf(v.z); o.w = f2bf(v.w);
      *(ushort4*)(xb + (size_t)row * 1024 + i * 256 + lane * 4) = o;
    }
    ss = wsum64(ss);
    if (lane < 16) part[(size_t)row * 16 + lane] = (lane == 0) ? ss : 0.f;
  }
}

__device__ __forceinline__ void final_phase(const Params& p) {
  const float* part = (const float*)(p.ws + O_PART);
  const float* g = p.in[40];
  const int lane = threadIdx.x & 63, wave = threadIdx.x >> 6;
  for (int row = blockIdx.x * 8 + wave; row < MT; row += gridDim.x * 8) {
    float s = (lane < 16) ? part[(size_t)row * 16 + lane] : 0.f;
    s = wsum64(s);
    const float rs = rsqrtf(s * (1.0f / 1024.0f) + 1e-6f);
    float* xr = p.out + (size_t)row * 1024;
#pragma unroll
    for (int i = 0; i < 4; i++) {
      float4 v = *(float4*)(xr + i * 256 + lane * 4);
      float4 gg = *(const float4*)(g + i * 256 + lane * 4);
      v.x *= rs * gg.x; v.y *= rs * gg.y; v.z *= rs * gg.z; v.w *= rs * gg.w;
      *(float4*)(xr + i * 256 + lane * 4) = v;
    }
  }
}


constexpr int NPHASE = 22;
enum { K_P0 = 0, K_G_SCALE, K_G_PLAIN, K_G_FF1, K_G_RES, K_G_POST, K_POOL, K_SCAN, K_MIX1, K_LRUFIX, K_FINAL };

#define PH(n, sync_) if (plo <= (n) && (n) <= phi) { if ((n) > plo && (sync_)) { if ((n) == 1) { grid.sync(); xb = xcd_barrier_post((unsigned*)(ws + O_XBAR), (volatile LAS unsigned*)&xb_words); } else xcd_barrier(xb); }
#define PHEND }
#define WSB(o) ((const u16*)(ws + (o)))
#define WSO(o) ((u16*)(ws + (o)))
__global__ void __launch_bounds__(512) mega(Params p, int plo, int phi) {
  cg::grid_group grid = cg::this_grid();
  char* ws = p.ws;
  __shared__ uint4 xb_words;
  if (threadIdx.x == 0) xb_words = make_uint4(0u, 0u, 0u, 0u);
  __syncthreads();
  XcdBarrier xb; xb.bar = (unsigned*)(ws + O_XBAR); xb.x = 0; xb.st = (volatile LAS unsigned*)&xb_words;
  PH(0, 1) phase0(p); PHEND
  PH(1, 1) gemm_phase<EPI_SCALE>(p, WSB(O_XB), 1024, WSB(O_WIN0), 1024, 1024, 2816, WSO(O_P), 2816, 0, 0); PHEND
  PH(2, 1) pool_phase(p); PHEND
  PH(3, 1) gemm_phase<EPI_PLAIN>(p, WSB(O_LIN), 256, WSB(O_WLW), 64, 64, 768, WSO(O_WPRE), 768, 0, 0); PHEND
  PH(4, 0) gemm_phase<EPI_PLAIN>(p, WSB(O_LIN + 128), 256, WSB(O_WLA), 64, 64, 768, WSO(O_APRE), 768, 0, 140); PHEND
  PH(5, 1) rwkv_prep_phase(p); PHEND
  PH(6, 1) scan_phase(p, 0, 0, 3264); pool_queue(p); PHEND
  PH(7, 1) gemm_phase<EPI_POST>(p, WSB(O_LIN + 256), 256, WSB(O_WLG), 128, 128, 768, nullptr, 0, 0, 0); PHEND
  PH(8, 1) gemm_phase<EPI_RES>(p, WSB(O_Y), 1024, WSB(O_WOUT0), 1024, 1024, 1024, WSO(O_XB), 1024, 1, 0); PHEND
  PH(9, 1) res_fix_phase(p); PHEND
  PH(10, 1) gemm_phase<EPI_FF1>(p, WSB(O_XB), 1024, WSB(O_WF10), 1024, 1024, 4096, WSO(O_H), 4096, 0, 0); PHEND
  PH(11, 1) gemm_phase<EPI_RES>(p, WSB(O_H), 4096, WSB(O_WF20), 4096, 4096, 1024, WSO(O_XB), 1024, 0, 0); PHEND
  PH(12, 1) res_fix_phase(p); PHEND
  PH(13, 1) gemm_phase<EPI_SCALE>(p, WSB(O_XB), 1024, WSB(O_WIN1), 1024, 1024, 2048, WSO(O_P), 2048, 0, 0); PHEND
  PH(14, 1) mix1_phase(p); PHEND
  PH(15, 1) lru_fix_phase(p, xb); PHEND
  PH(16, 1) gemm_phase<EPI_RES>(p, WSB(O_Y), 1024, WSB(O_WOUT1), 1024, 1024, 1024, WSO(O_XB), 1024, 0, 0); PHEND
  PH(17, 1) res_fix_phase(p); PHEND
  PH(18, 1) gemm_phase<EPI_FF1>(p, WSB(O_XB), 1024, WSB(O_WF11), 1024, 1024, 4096, WSO(O_H), 4096, 0, 0); PHEND
  PH(19, 1) gemm_phase<EPI_RES>(p, WSB(O_H), 4096, WSB(O_WF21), 4096, 4096, 1024, WSO(O_XB), 1024, 0, 0); PHEND
  PH(20, 1) res_fix_phase(p); PHEND
  PH(21, 1) final_phase(p); PHEND
}

extern "C" void kernel_launch(void* const* d_in, const int* in_sizes, int n_in, void* d_out, int out_size, void* d_ws,
                              size_t ws_size, hipStream_t stream) {
  static int grid_blocks = 0;
  if (!grid_blocks) {
    int dev = 0, cus = 0, per_cu = 0;
    hipGetDevice(&dev);
    hipDeviceGetAttribute(&cus, hipDeviceAttributeMultiprocessorCount, dev);
    hipOccupancyMaxActiveBlocksPerMultiprocessor(&per_cu, mega, 512, 0);
    if (per_cu < 1) per_cu = 1;
    grid_blocks = cus;
    if (grid_blocks > cus * per_cu) grid_blocks = cus * per_cu;
    if (ws_size < WS_NEED) fprintf(stderr, "workspace too small: %zu < %zu\n", ws_size, (size_t)WS_NEED);
  }
  Params p{};
  for (int i = 0; i < 41; i++) p.in[i] = (const float*)d_in[i];
  p.out = (float*)d_out;
  p.ws = (char*)d_ws;
  int plo = 0, phi = NPHASE - 1;
  void* args[] = {&p, &plo, &phi};
  hipError_t e = hipLaunchCooperativeKernel((void*)mega, dim3(grid_blocks), dim3(512), args, 0, stream);
  if (e != hipSuccess) fprintf(stderr, "cooperative launch failed: %s (grid %d)\n", hipGetErrorString(e), grid_blocks);
}
```

```cpp
#include <hip/hip_runtime.h>
#include <hip/hip_cooperative_groups.h>
#include <cstdio>
namespace cg = cooperative_groups;

typedef unsigned short u16;
typedef __attribute__((ext_vector_type(8))) short bf16x8;
typedef __attribute__((ext_vector_type(16))) float f32x16;

constexpr int MT = 16896;
constexpr int NP = 16384;

struct Params {
  const float* in[41];
  float* out;
  char* ws;
};

constexpr size_t OUT_Y = 0;
constexpr size_t OUT_PPOOL = (size_t)MT * 1024;
constexpr size_t OUT_PSHIFT = OUT_PPOOL + 8 * 15 * 256;
constexpr size_t OUT_PWKV = OUT_PSHIFT + 8 * 2560;
constexpr size_t OUT_PCONV = OUT_PWKV + 8 * 12 * 4096;
constexpr size_t OUT_PLRU = OUT_PCONV + 8 * 3 * 512;
constexpr size_t OUT_SPOOL = OUT_PLRU + 8 * 512;
constexpr size_t OUT_SSHIFT = OUT_SPOOL + 128 * 15 * 256;
constexpr size_t OUT_SWKV = OUT_SSHIFT + 128 * 2560;
constexpr size_t OUT_SCONV = OUT_SWKV + (size_t)128 * 12 * 4096;
constexpr size_t OUT_SLRU = OUT_SCONV + 128 * 3 * 512;
constexpr size_t OUT_SGV = OUT_SLRU + 128 * 512;

constexpr size_t O_WIN0 = 0;
constexpr size_t O_WOUT0 = O_WIN0 + 2816ull * 1024 * 2;
constexpr size_t O_WF10 = O_WOUT0 + 1024ull * 1024 * 2;
constexpr size_t O_WF20 = O_WF10 + 4096ull * 1024 * 2;
constexpr size_t O_WIN1 = O_WF20 + 4096ull * 1024 * 2;
constexpr size_t O_WOUT1 = O_WIN1 + 2048ull * 1024 * 2;
constexpr size_t O_WF11 = O_WOUT1 + 1024ull * 1024 * 2;
constexpr size_t O_WF21 = O_WF11 + 4096ull * 1024 * 2;
constexpr size_t O_WLW = O_WF21 + 4096ull * 1024 * 2;
constexpr size_t O_WLA = O_WLW + 768 * 64 * 2;
constexpr size_t O_WLG = O_WLA + 768 * 64 * 2;
constexpr size_t O_WM = O_WLG + 768 * 128 * 2;
constexpr size_t O_CNT = O_WM + 4 * 128 * 128 * 2;
constexpr size_t O_PART = O_CNT + 256;
constexpr size_t O_XB = O_PART + (size_t)MT * 16 * 4;
constexpr size_t O_Y = O_XB + (size_t)MT * 1024 * 2;
constexpr size_t O_AR = O_Y + (size_t)MT * 1024 * 2;
constexpr size_t O_P = O_AR;
constexpr size_t O_LIN = O_P + (size_t)MT * 2816 * 2;
constexpr size_t O_WPRE = O_LIN + (size_t)MT * 256 * 2;
constexpr size_t O_APRE = O_XB;
constexpr size_t O_BS = O_APRE + (size_t)MT * 768 * 2;
constexpr size_t O_CA = O_AR + (size_t)MT * 2048 * 2;
constexpr size_t O_HL = O_CA + (size_t)MT * 512 * 4;
constexpr size_t O_SEG = O_HL + (size_t)MT * 512 * 4;
constexpr size_t O_H = O_AR;
constexpr size_t O_XBAR = O_SEG + (size_t)1056 * 1024 * 4;
constexpr size_t O_CAR = O_XBAR + 16384;
constexpr size_t O_WXT = O_CAR + (size_t)1024 * 512 * 4;
constexpr size_t WS_NEED = O_WXT + 131072;

__device__ __forceinline__ u16 f2bf(float f) {
  __bf16 h = (__bf16)f;
  return __builtin_bit_cast(u16, h);
}
__device__ __forceinline__ float bf2f(u16 h) { return __uint_as_float(((unsigned)h) << 16); }
__device__ __forceinline__ float frcp_(float x) { return __builtin_amdgcn_rcpf(x); }
__device__ __forceinline__ float sigmoidf_(float x) { return frcp_(1.0f + __expf(-x)); }
__device__ __forceinline__ float tanhf_(float x) {
  float e = __expf(2.0f * x);
  return 1.0f - 2.0f * frcp_(1.0f + e);
}
__device__ __forceinline__ float geluf_(float x) {
  float y = 0.7978845608028654f * (x + 0.044715f * x * x * x);
  return 0.5f * x * (1.0f + tanhf_(y));
}
template <int CTRL>
__device__ __forceinline__ float dppmov(float v) {
  return __int_as_float(__builtin_amdgcn_update_dpp(0, __float_as_int(v), CTRL, 0xF, 0xF, true));
}
__device__ __forceinline__ float reduce8(float v) {
  v += dppmov<0xB1>(v);
  v += dppmov<0x4E>(v);
  v += dppmov<0x141>(v);
  return v;
}
__device__ __forceinline__ float row16sum(float v) {
  v += dppmov<0xB1>(v);
  v += dppmov<0x4E>(v);
  v += dppmov<0x141>(v);
  v += dppmov<0x140>(v);
  return v;
}
__device__ __forceinline__ float wsum64(float v) {
  v = row16sum(v);
  v += __int_as_float(__builtin_amdgcn_update_dpp(0, __float_as_int(v), 0x142, 0xA, 0xF, false));
  v += __int_as_float(__builtin_amdgcn_update_dpp(0, __float_as_int(v), 0x143, 0xC, 0xF, false));
  return __int_as_float(__builtin_amdgcn_readlane(__float_as_int(v), 63));
}
__device__ __forceinline__ float hsum32(float v) {
  v = row16sum(v);
  return v + __shfl_xor(v, 16);
}
__device__ __forceinline__ const float* xrow(const Params& p, int row) {
  return row < NP ? p.in[0] + (size_t)row * 1024 : p.in[1] + (size_t)(row - NP) * 1024;
}
__device__ __forceinline__ float prevP(const Params& p, const u16* P, int row, int c) {
  const int rp = row > 0 ? row - 1 : 0;
  float v = bf2f(P[(size_t)rp * 2816 + 256 + c]);
  const bool start = (row < NP) ? ((row & 2047) == 0) : (((row - NP) & 3) == 0);
  if (start) v = (row < NP) ? 0.f : p.in[3][(size_t)((row - NP) >> 2) * 2560 + c];
  return v;
}

__shared__ __attribute__((aligned(16))) unsigned char smem[114688];
#define RAW_BARRIER() do { asm volatile("s_waitcnt lgkmcnt(0)" ::: "memory"); __builtin_amdgcn_s_barrier(); asm volatile("" ::: "memory"); } while (0)
__shared__ int s_task;
__shared__ int s_simdcnt[4];
__shared__ int s_role[8];
__shared__ int s_role2[8];

#define XB_TMO      128
#define XB_XCNT(j)  (256  + 64 * (j))
#define XB_XSUB(j)  (1280 + 64 * (j))
#define XB_XGEN(j)  (2304 + 64 * (j))
#define XB_TOP      3328
#define XB_TOPGEN   3392
#define XCD_BAR_WORDS 3456
#define XB_SPIN_CAP (1u << 18)
#define LAS __attribute__((address_space(3)))

__device__ __forceinline__ unsigned xb_ld(unsigned* p)              { return __hip_atomic_load(p, __ATOMIC_RELAXED, __HIP_MEMORY_SCOPE_AGENT); }
__device__ __forceinline__ unsigned xb_add(unsigned* p, unsigned v) { return __hip_atomic_fetch_add(p, v, __ATOMIC_RELAXED, __HIP_MEMORY_SCOPE_AGENT); }
__device__ __forceinline__ unsigned xb_xcc_id() { return (unsigned)__builtin_amdgcn_s_getreg((3 << 11) | 20) & 0xFu; }
#define XB_SPIN(cond, bar) do { unsigned _sp = 0; while (cond) { __builtin_amdgcn_s_sleep(1); \
    if ((++_sp & 255u) == 0u) { if (xb_ld(&(bar)[XB_TMO])) break; if (_sp > XB_SPIN_CAP) { atomicAdd(&(bar)[XB_TMO], 1u); break; } } } } while (0)

struct XcdBarrier {
    unsigned* bar; unsigned x;
    volatile LAS unsigned* st;
};

__device__ __forceinline__ XcdBarrier xcd_barrier_post(unsigned* bar, volatile LAS unsigned* st) {
    XcdBarrier b; b.bar = bar; b.x = xb_xcc_id(); b.st = st;
    if (threadIdx.x == 0) (void)xb_add(&bar[XB_XCNT(b.x)], 1u);
    return b;
}
__device__ __forceinline__ void xcd_barrier_complete(unsigned* bar, unsigned x, unsigned& nloc, unsigned& nx) {
    const unsigned G = gridDim.x * gridDim.y * gridDim.z;
    unsigned sum, cnt, mine, sp = 0u;
    for (;;) {
        sum = 0u; cnt = 0u; mine = 0u;
#pragma unroll
        for (unsigned j = 0; j < 16; ++j) { const unsigned c = xb_ld(&bar[XB_XCNT(j)]); sum += c; cnt += (c > 0u) ? 1u : 0u; mine = (j == x) ? c : mine; }
        if (sum == G) break;
        __builtin_amdgcn_s_sleep(1);
        if ((++sp & 255u) == 0u) { if (xb_ld(&bar[XB_TMO])) break; if (sp > XB_SPIN_CAP) { atomicAdd(&bar[XB_TMO], 1u); break; } }
    }
    nloc = mine > 0u ? mine : 1u; nx = cnt > 0u ? cnt : 1u;
}

__device__ __forceinline__ void xcd_barrier(const XcdBarrier& b) {
    asm volatile("s_waitcnt vmcnt(0)" ::: "memory");
    __syncthreads();
    if (threadIdx.x == 0) {
        unsigned* bar = b.bar;
        __builtin_amdgcn_s_waitcnt(0);
        unsigned nloc = b.st[0], nx = b.st[1];
        if (nloc == 0u) { xcd_barrier_complete(bar, b.x, nloc, nx); b.st[0] = nloc; b.st[1] = nx; }
        const unsigned old = xb_add(&bar[XB_XSUB(b.x)], 1u);
        const unsigned gen = old / nloc;
        if (old + 1u == (gen + 1u) * nloc) {
            __builtin_amdgcn_fence(__ATOMIC_RELEASE, "agent");
            asm volatile("s_waitcnt vmcnt(0)" ::: "memory");
            const unsigned og = xb_add(&bar[XB_TOP], 1u);
            const unsigned tg = og / nx;
            if (og + 1u == (tg + 1u) * nx) xb_add(&bar[XB_TOPGEN], 1u);
            else XB_SPIN(xb_ld(&bar[XB_TOPGEN]) == tg, bar);
            __builtin_amdgcn_fence(__ATOMIC_ACQUIRE, "agent");
            xb_add(&bar[XB_XGEN(b.x)], 1u);
            asm volatile("s_waitcnt vmcnt(0)" ::: "memory");
        } else {
            XB_SPIN(xb_ld(&bar[XB_XGEN(b.x)]) == gen, bar);
            __builtin_amdgcn_fence(__ATOMIC_ACQUIRE, "agent");
            asm volatile("s_waitcnt vmcnt(0)" ::: "memory");
        }
    }
    __syncthreads();
}


__device__ __forceinline__ void convT(const float* __restrict__ W, int K, int N, const float* __restrict__ g, u16* __restrict__ WT) {
  float* t = (float*)smem;
  const int tilesN = N / 128, tiles = (K / 64) * tilesN;
  const int tx = threadIdx.x & 127, ty = threadIdx.x >> 7;
  const int sx = threadIdx.x & 63, sy = threadIdx.x >> 6;
  for (int tl = blockIdx.x; tl < tiles; tl += gridDim.x) {
    const int k0 = (tl / tilesN) * 64, n0 = (tl % tilesN) * 128;
    float v[16];
#pragma unroll
    for (int i = 0; i < 16; i++) v[i] = W[(size_t)(k0 + ty + 4 * i) * N + n0 + tx];
    if (g) {
#pragma unroll
      for (int i = 0; i < 16; i++) v[i] *= g[k0 + ty + 4 * i];
    }
    __syncthreads();
#pragma unroll
    for (int i = 0; i < 16; i++) t[(ty + 4 * i) * 129 + tx] = v[i];
    __syncthreads();
#pragma unroll
    for (int i = 0; i < 16; i++) {
      const int n = sy + 8 * i;
      WT[(size_t)(n0 + n) * K + k0 + sx] = f2bf(t[sx * 129 + n]);
    }
  }
}

__device__ __forceinline__ void phase0(const Params& p) {
  char* ws = p.ws;
  convT(p.in[8], 1024, 2816, p.in[7], (u16*)(ws + O_WIN0));
  convT(p.in[22], 1024, 1024, nullptr, (u16*)(ws + O_WOUT0));
  convT(p.in[38], 1024, 4096, p.in[37], (u16*)(ws + O_WF10));
  convT(p.in[39], 4096, 1024, nullptr, (u16*)(ws + O_WF20));
  convT(p.in[24], 1024, 2048, p.in[23], (u16*)(ws + O_WIN1));
  convT(p.in[36], 1024, 1024, nullptr, (u16*)(ws + O_WOUT1));
  convT(p.in[38] + (size_t)1024 * 4096, 1024, 4096, p.in[37] + 1024, (u16*)(ws + O_WF11));
  convT(p.in[39] + (size_t)1024 * 4096, 4096, 1024, nullptr, (u16*)(ws + O_WF21));
  convT(p.in[13], 64, 768, nullptr, (u16*)(ws + O_WLW));
  convT(p.in[15], 64, 768, nullptr, (u16*)(ws + O_WLA));
  convT(p.in[16], 128, 768, nullptr, (u16*)(ws + O_WLG));
  {
    u16* wm = (u16*)(ws + O_WM);
    const float* wsrc = p.in[27];
    for (int e = blockIdx.x * 512 + threadIdx.x; e < 4 * 128 * 128; e += gridDim.x * 512) {
      int i = (e >> 7) & 127, j = e & 127;
      wm[e] = (j <= i) ? f2bf(wsrc[e]) : (u16)0;
    }
  }
  {
    u16* wxt = (u16*)(ws + O_WXT);
    for (int e = blockIdx.x * 512 + threadIdx.x; e < 16 * 64 * 64; e += gridDim.x * 512) {
      const int m = e >> 12, d = (e >> 6) & 63, c = e & 63;
      const float* src = (m < 8) ? p.in[31] : p.in[33];
      wxt[e] = f2bf(src[(m & 7) * 4096 + c * 64 + d]);
    }
  }
  if (blockIdx.x == 0 && threadIdx.x < 64) ((int*)(ws + O_CNT))[threadIdx.x] = 0;
  if (blockIdx.x == 1) for (int e = threadIdx.x; e < 3456; e += 512) ((unsigned*)(ws + O_XBAR))[e] = 0u;
  for (int e = blockIdx.x * 512 + threadIdx.x; e < 512 * 256; e += gridDim.x * 512) ((float4*)(p.out + (size_t)NP * 1024))[e] = ((const float4*)p.in[1])[e];
  {
    u16* xb = (u16*)(ws + O_XB);
    float* part = (float*)(ws + O_PART);
    const int lane = threadIdx.x & 63, wave = threadIdx.x >> 6;
    for (int row = blockIdx.x * 8 + wave; row < MT; row += gridDim.x * 8) {
      const float* xr = xrow(p, row);
      float ss = 0.f;
#pragma unroll
      for (int i = 0; i < 4; i++) {
        float4 v = *(const float4*)(xr + i * 256 + lane * 4);
        ss += v.x * v.x + v.y * v.y + v.z * v.z + v.w * v.w;
        ushort4 o;
        o.x = f2bf(v.x); o.y = f2bf(v.y); o.z = f2bf(v.z); o.w = f2bf(v.w);
        *(ushort4*)(xb + (size_t)row * 1024 + i * 256 + lane * 4) = o;
      }
      ss = wsum64(ss);
      if (lane < 16) part[(size_t)row * 16 + lane] = (lane == 0) ? ss : 0.f;
    }
  }
}

enum { EPI_SCALE = 0, EPI_PLAIN = 1, EPI_FF1 = 2, EPI_RES = 3, EPI_POST = 4 };

template <int EPI>
__device__ __forceinline__ void gemm_epi(const Params& p, const f32x16 acc0, const f32x16 acc1, int mi, int wm, int wn, int lane,
                                         int m0, int nt, int c0, int c1, const float* sRs, u16* __restrict__ outb, int ldo,
                                         int resid_in) {
  float* part = (float*)(p.ws + O_PART);
  float* xf = p.out;
    const int rbase = wm * 64 + mi * 32 + 4 * (lane >> 5);
    if (EPI == EPI_SCALE || EPI == EPI_PLAIN || EPI == EPI_FF1) {
#pragma unroll
      for (int i = 0; i < 16; i++) {
        const int rl = rbase + (i & 3) + 8 * (i >> 2);
        const int row = m0 + rl;
        float v0 = acc0[i], v1 = acc1[i];
        if (EPI != EPI_PLAIN) { float rs = sRs[rl]; v0 *= rs; v1 *= rs; }
        if (EPI == EPI_FF1) { v0 = fmaxf(v0, 0.f); v1 = fmaxf(v1, 0.f); v0 *= v0; v1 *= v1; }
        outb[(size_t)row * ldo + c0] = f2bf(v0);
        outb[(size_t)row * ldo + c1] = f2bf(v1);
      }
    } else if (EPI == EPI_RES) {
#pragma unroll
      for (int i = 0; i < 16; i++) {
        const int rl = rbase + (i & 3) + 8 * (i >> 2);
        const int row = m0 + rl;
        const float* res = resid_in ? xrow(p, row) : (xf + (size_t)row * 1024);
        float v0 = res[c0] + acc0[i], v1 = res[c1] + acc1[i];
        xf[(size_t)row * 1024 + c0] = v0;
        xf[(size_t)row * 1024 + c1] = v1;
        outb[(size_t)row * 1024 + c0] = f2bf(v0);
        outb[(size_t)row * 1024 + c1] = f2bf(v1);
        float s = hsum32(v0 * v0 + v1 * v1);
        if ((lane & 31) == 0) part[(size_t)row * 16 + nt * 2 + wn] = s;
      }
    } else {
      const int hh = nt * 2 + wn;
      const u16* P = (const u16*)(p.ws + O_P);
      u16* Y = (u16*)(p.ws + O_Y);
      const float* bs = (const float*)(p.ws + O_BS);
      const int ch0 = hh * 64 + (lane & 31), ch1 = ch0 + 32;
      const float gg0 = p.in[20][ch0], gg1 = p.in[20][ch1];
      const float gb0 = p.in[21][ch0], gb1 = p.in[21][ch1];
      const float mu0 = p.in[11][1536 + ch0], mu1 = p.in[11][1536 + ch1];
#pragma unroll 8
      for (int i = 0; i < 16; i++) {
        const int rl = rbase + (i & 3) + 8 * (i >> 2);
        const int row = m0 + rl;
        float o0 = bf2f(Y[(size_t)row * 1024 + 256 + ch0]);
        float o1 = bf2f(Y[(size_t)row * 1024 + 256 + ch1]);
        float mean = hsum32(o0 + o1) * (1.0f / 64.0f);
        float d0 = o0 - mean, d1 = o1 - mean;
        float var = hsum32(d0 * d0 + d1 * d1) * (1.0f / 64.0f);
        float rstd = rsqrtf(var + 64e-5f);
        float pv0 = bf2f(P[(size_t)row * 2816 + 256 + 1536 + ch0]);
        float pv1 = bf2f(P[(size_t)row * 2816 + 256 + 1536 + ch1]);
        float pp0 = prevP(p, P, row, 1536 + ch0), pp1 = prevP(p, P, row, 1536 + ch1);
        float vv0 = pv0 + (pp0 - pv0) * mu0, vv1 = pv1 + (pp1 - pv1) * mu1;
        float b = bs[((size_t)row * 12 + hh) * 4 + 2];
        float y0 = (d0 * rstd * gg0 + gb0 + b * vv0) * acc0[i];
        float y1 = (d1 * rstd * gg1 + gb1 + b * vv1) * acc1[i];
        Y[(size_t)row * 1024 + 256 + ch0] = f2bf(y0);
        Y[(size_t)row * 1024 + 256 + ch1] = f2bf(y1);
      }
    }
}

template <int EPI>
__device__ __forceinline__ void gemm_phase(const Params& p, const u16* __restrict__ A, int lda, const u16* __restrict__ BT, int ldb,
                           int K, int N, u16* __restrict__ outb, int ldo, int resid_in, int boff) {
  constexpr int LS = 72;
  constexpr int SA = 256 * LS, SB = 128 * LS, STG = SA + SB;
  u16* sm = (u16*)smem;
  float* sRs = (float*)(sm + 2 * STG);
  const int tid = threadIdx.x, lane = tid & 63, wave = tid >> 6;
  const int wm = wave >> 1, wn = wave & 1;
  const int lrow = tid >> 3, lch = tid & 7;
  const int NT = N / 128;
  const int tiles = (MT / 256) * NT;
  const int KTALL = K / 64;
  float* part = (float*)(p.ws + O_PART);
  int bstart = (int)blockIdx.x - boff;
  if (bstart < 0) bstart += gridDim.x;
  const size_t a64 = (size_t)64 * lda, b64 = (size_t)64 * ldb;
  const int G = gridDim.x;
  int t_full = tiles, split = 1;
  if (EPI == EPI_RES) {
    const int tail = tiles % G;
    if (tail > 0 && (G % tail) == 0 && (KTALL % (G / tail)) == 0) { t_full = tiles - tail; split = G / tail; }
  }
  const int units = t_full + (tiles - t_full) * split;
  for (int un = bstart; un < units; un += G) {
    int tl = un, kbeg = 0, KT = KTALL;
    bool part_unit = false;
    if (un >= t_full) { const int v = un - t_full; tl = t_full + v / split; KT = KTALL / split; kbeg = (v % split) * KT; part_unit = true; }
    int mt = tl / NT, nt = tl % NT;
    if (EPI == EPI_RES && NT == 8 && G == 256 && !part_unit) {
      const int rr = tl >> 8, bb = tl & 255;
      const int xx = bb & 7, jj = bb >> 3;
      mt = rr * 32 + xx * 4 + (jj >> 3);
      nt = jj & 7;
    } else if ((EPI == EPI_FF1 || EPI == EPI_SCALE) && G == 256 && (NT == 32 || NT == 16) && tl < (tiles & ~255)) {
      const int rr = tl >> 8, bb = tl & 255;
      const int xx = bb & 7, jj = bb >> 3;
      if (NT == 32) { mt = rr * 8 + (xx >> 2) * 4 + (jj >> 3); nt = (xx & 3) * 8 + (jj & 7); }
      else { mt = rr * 16 + (xx >> 1) * 4 + (jj >> 3); nt = (xx & 1) * 8 + (jj & 7); }
    }
    const int m0 = mt * 256, n0 = nt * 128;
    const u16* gA = A + (size_t)(m0 + lrow) * lda + lch * 8 + (size_t)kbeg * 64;
    const u16* gB = BT + (size_t)(n0 + lrow) * ldb + lch * 8 + (size_t)kbeg * 64;
    uint4 xa0, xa1, xa2, xa3, xb0, xb1;
    uint4 ya0, ya1, ya2, ya3, yb0, yb1;
#define LOADX(kt_) { const u16* qa = gA + (kt_) * 64; const u16* qb = gB + (kt_) * 64; \
    xa0 = *(const uint4*)qa; xa1 = *(const uint4*)(qa + a64); xa2 = *(const uint4*)(qa + 2 * a64); xa3 = *(const uint4*)(qa + 3 * a64); \
    xb0 = *(const uint4*)qb; xb1 = *(const uint4*)(qb + b64); }
#define LOADY(kt_) { const u16* qa = gA + (kt_) * 64; const u16* qb = gB + (kt_) * 64; \
    ya0 = *(const uint4*)qa; ya1 = *(const uint4*)(qa + a64); ya2 = *(const uint4*)(qa + 2 * a64); ya3 = *(const uint4*)(qa + 3 * a64); \
    yb0 = *(const uint4*)qb; yb1 = *(const uint4*)(qb + b64); }
#define WRITEX(st_) { u16* wa = sm + (st_) * STG + lrow * LS + lch * 8; u16* wb = wa + SA; \
    *(uint4*)wa = xa0; *(uint4*)(wa + 64 * LS) = xa1; *(uint4*)(wa + 128 * LS) = xa2; *(uint4*)(wa + 192 * LS) = xa3; \
    *(uint4*)wb = xb0; *(uint4*)(wb + 64 * LS) = xb1; }
#define WRITEY(st_) { u16* wa = sm + (st_) * STG + lrow * LS + lch * 8; u16* wb = wa + SA; \
    *(uint4*)wa = ya0; *(uint4*)(wa + 64 * LS) = ya1; *(uint4*)(wa + 128 * LS) = ya2; *(uint4*)(wa + 192 * LS) = ya3; \
    *(uint4*)wb = yb0; *(uint4*)(wb + 64 * LS) = yb1; }
#define COMPUTE(st_) { const u16* ab = sm + (st_) * STG + (wm * 64 + (lane & 31)) * LS + (lane >> 5) * 8; \
    const u16* bb = sm + (st_) * STG + SA + (wn * 64 + (lane & 31)) * LS + (lane >> 5) * 8; \
    _Pragma("unroll") for (int ks = 0; ks < 4; ks++) { \
      bf16x8 fa0 = *(const bf16x8*)(ab + ks * 16); bf16x8 fa1 = *(const bf16x8*)(ab + 32 * LS + ks * 16); \
      bf16x8 fb0 = *(const bf16x8*)(bb + ks * 16); bf16x8 fb1 = *(const bf16x8*)(bb + 32 * LS + ks * 16); \
      acc00 = __builtin_amdgcn_mfma_f32_32x32x16_bf16(fa0, fb0, acc00, 0, 0, 0); \
      acc01 = __builtin_amdgcn_mfma_f32_32x32x16_bf16(fa0, fb1, acc01, 0, 0, 0); \
      acc10 = __builtin_amdgcn_mfma_f32_32x32x16_bf16(fa1, fb0, acc10, 0, 0, 0); \
      acc11 = __builtin_amdgcn_mfma_f32_32x32x16_bf16(fa1, fb1, acc11, 0, 0, 0); } }
    LOADX(0);
    if (KT > 1) LOADY(1);
    __syncthreads();
    if (EPI == EPI_SCALE || EPI == EPI_FF1) {
      if (tid < 256) {
        const float4* pp = (const float4*)(part + (size_t)(m0 + tid) * 16);
        float4 a = pp[0], b = pp[1], c = pp[2], d = pp[3];
        float s = (a.x + a.y + a.z + a.w) + (b.x + b.y + b.z + b.w) + (c.x + c.y + c.z + c.w) + (d.x + d.y + d.z + d.w);
        sRs[tid] = rsqrtf(s * (1.0f / 1024.0f) + 1e-6f);
      }
    }
    WRITEX(0);
    if (KT > 2) LOADX(2);
    RAW_BARRIER();
    f32x16 acc00, acc01, acc10, acc11;
#pragma unroll
    for (int i = 0; i < 16; i++) { acc00[i] = 0.f; acc01[i] = 0.f; acc10[i] = 0.f; acc11[i] = 0.f; }
    for (int kt = 0; kt < KT; kt += 2) {
      if (kt + 1 < KT) WRITEY(1);
      if (kt + 3 < KT) LOADY(kt + 3);
      COMPUTE(0);
      RAW_BARRIER();
      if (kt + 1 >= KT) break;
      if (kt + 2 < KT) WRITEX(0);
      if (kt + 4 < KT) LOADX(kt + 4);
      COMPUTE(1);
      RAW_BARRIER();
    }
#undef LOADX
#undef LOADY
#undef WRITEX
#undef WRITEY
#undef COMPUTE
    const int c0 = n0 + wn * 64 + (lane & 31);
    const int c1 = c0 + 32;
    if (EPI == EPI_RES && part_unit) {
      float* xfp = p.out;
#pragma unroll
      for (int i = 0; i < 16; i++) {
        const int rl = wm * 64 + 4 * (lane >> 5) + (i & 3) + 8 * (i >> 2);
        float* r0p = xfp + (size_t)(m0 + rl) * 1024;
        float* r1p = r0p + (size_t)32 * 1024;
        atomicAdd(r0p + c0, acc00[i]); atomicAdd(r0p + c1, acc01[i]);
        atomicAdd(r1p + c0, acc10[i]); atomicAdd(r1p + c1, acc11[i]);
      }
    } else {
      gemm_epi<EPI>(p, acc00, acc01, 0, wm, wn, lane, m0, nt, c0, c1, sRs, outb, ldo, resid_in);
      gemm_epi<EPI>(p, acc10, acc11, 1, wm, wn, lane, m0, nt, c0, c1, sRs, outb, ldo, resid_in);
    }
  }
}

__device__ __forceinline__ void pool_item(const Params& p, int it) {
  const u16* P = (const u16*)(p.ws + O_P);
  u16* Y = (u16*)(p.ws + O_Y);
  float* hist = (float*)smem;
  float* dS = hist + 47 * 256;
  const int tid = threadIdx.x;
  const int col = tid & 255, hf = tid >> 8;
  const int gi = col >> 6, dd = col & 63;
  const int w = 2 << gi;
  const float* pw = p.in[9] + gi * 4096 + dd;
  const float sc = p.in[10][col];
  {
    int r0, t0, nrows, pos0;
    const float* st = nullptr;
    const float* shs = nullptr;
    if (it < 512) { r0 = it * 32; t0 = r0 & 2047; nrows = 32; pos0 = t0; }
    else { const int b = it - 512; r0 = NP + b * 4; t0 = 0; nrows = 4; pos0 = 16384; st = p.in[2] + (size_t)b * 3840; shs = p.in[3] + (size_t)b * 2560; }
    __syncthreads();
    const int nh = 15 + nrows;
#pragma unroll 8
    for (int hr = hf; hr < nh; hr += 2) {
      const int t = t0 - 15 + hr;
      float v = 0.f;
      if (t >= 0) v = bf2f(P[(size_t)(r0 - t0 + t) * 2816 + col]);
      else if (st) v = st[(15 + t) * 256 + col];
      hist[hr * 256 + col] = v;
    }
    __syncthreads();
    const int q0 = hf * 16;
    for (int q = 0; q < 16; q++) {
      const int tk = q0 + q;
      if (tk < nrows) {
        float s = 0.f;
        for (int i = 0; i < w; i++) s += hist[(15 + tk - i) * 256 + col];
        const float cnt = (float)min(w, pos0 + tk + 1);
        dS[tk * 256 + col] = s / cnt - hist[(15 + tk) * 256 + col];
      }
    }
    __syncthreads();
    float acc[16];
#pragma unroll
    for (int q = 0; q < 16; q++) acc[q] = 0.f;
    if (q0 < nrows) {
#pragma unroll 4
      for (int c = 0; c < 64; c += 4) {
        float w0 = pw[(c + 0) * 64], w1 = pw[(c + 1) * 64], w2 = pw[(c + 2) * 64], w3 = pw[(c + 3) * 64];
#pragma unroll
        for (int q = 0; q < 16; q++) {
          float4 d = *(const float4*)(dS + (q0 + q) * 256 + gi * 64 + c);
          acc[q] += d.x * w0 + d.y * w1 + d.z * w2 + d.w * w3;
        }
      }
    }
#pragma unroll
    for (int q = 0; q < 16; q++) {
      if (q0 + q < nrows) Y[(size_t)(r0 + q0 + q) * 1024 + col] = f2bf(acc[q] * sc);
    }
  }
}

__device__ __forceinline__ void pool_phase(const Params& p) {
  const u16* P = (const u16*)(p.ws + O_P);
  u16* LIN = (u16*)(p.ws + O_LIN);
  const int tid = threadIdx.x;
  const int col = tid & 255, hf = tid >> 8;
  const float mu = p.in[11][2304 + col];
  for (int it = blockIdx.x; it < 512 + 128; it += gridDim.x) {
    int r0, t0, nrows;
    const float* shs = nullptr;
    if (it < 512) { r0 = it * 32; t0 = r0 & 2047; nrows = 32; }
    else { const int b = it - 512; r0 = NP + b * 4; t0 = 0; nrows = 4; shs = p.in[3] + (size_t)b * 2560; }
    const int q0 = hf * 16;
    if (q0 < nrows) {
      const int nq = min(16, nrows - q0);
      float pv[17];
      {
        const int rowp = r0 + q0 - 1;
        float v0;
        if (t0 + q0 == 0) v0 = shs ? shs[2304 + col] : 0.f;
        else v0 = bf2f(P[(size_t)rowp * 2816 + 2560 + col]);
        pv[0] = v0;
      }
#pragma unroll
      for (int q = 0; q < 16; q++) pv[q + 1] = (q < nq) ? bf2f(P[(size_t)(r0 + q0 + q) * 2816 + 2560 + col]) : 0.f;
#pragma unroll
      for (int q = 0; q < 16; q++) {
        if (q < nq) {
          float xs = pv[q + 1] + (pv[q] - pv[q + 1]) * mu;
          float v = (col < 64) ? tanhf_(xs) : ((col < 128) ? xs : sigmoidf_(xs));
          LIN[(size_t)(r0 + q0 + q) * 256 + col] = f2bf(v);
        }
      }
    }
  }
  const int gt = blockIdx.x * 512 + tid, gs = gridDim.x * 512;
  for (int e = gt; e < 8 * 15 * 256; e += gs) {
    int b = e / 3840, r = (e / 256) % 15, c = e & 255;
    p.out[OUT_PPOOL + e] = bf2f(P[(size_t)(b * 2048 + 2033 + r) * 2816 + c]);
  }
  for (int e = gt; e < 128 * 15 * 256; e += gs) {
    int b = e / 3840, r = (e / 256) % 15, c = e & 255;
    float v;
    if (r < 11) v = p.in[2][(size_t)b * 3840 + (r + 4) * 256 + c];
    else v = bf2f(P[(size_t)(NP + b * 4 + (r - 11)) * 2816 + c]);
    p.out[OUT_SPOOL + e] = v;
  }
  for (int e = gt; e < 8 * 2560; e += gs) {
    int b = e / 2560, c = e % 2560;
    p.out[OUT_PSHIFT + e] = bf2f(P[(size_t)(b * 2048 + 2047) * 2816 + 256 + c]);
  }
  for (int e = gt; e < 128 * 2560; e += gs) {
    int b = e / 2560, c = e % 2560;
    p.out[OUT_SSHIFT + e] = bf2f(P[(size_t)(NP + b * 4 + 3) * 2816 + 256 + c]);
  }
}

__device__ __forceinline__ void rwkv_prep_phase(const Params& p) {
  const u16* P = (const u16*)(p.ws + O_P);
  u16* APRE = (u16*)(p.ws + O_APRE);
  u16* WPRE = (u16*)(p.ws + O_WPRE);
  float* SC = (float*)(p.ws + O_BS);
  const int lane = threadIdx.x & 63, wave = __builtin_amdgcn_readfirstlane(threadIdx.x >> 6);
  for (int row = blockIdx.x * 8 + wave; row < MT; row += gridDim.x * 8) {
    const u16* Pr = P + (size_t)row * 2816 + 256;
#pragma unroll 12
    for (int h = 0; h < 12; h++) {
      const int ch = h * 64 + lane;
      float pr = bf2f(Pr[ch]), pk = bf2f(Pr[768 + ch]);
      float qr = prevP(p, P, row, ch), qk = prevP(p, P, row, 768 + ch);
      float wl = p.in[12][ch] + bf2f(WPRE[(size_t)row * 768 + ch]);
      float r = pr + (qr - pr) * p.in[11][ch], k = pk + (qk - pk) * p.in[11][768 + ch];
      float a = sigmoidf_(p.in[14][ch] + bf2f(APRE[(size_t)row * 768 + ch]));
      a = bf2f(f2bf(a));
      float omd = 1.0f - __expf(-0.6065306597126334f * sigmoidf_(wl));
      float kkr = k * p.in[17][ch];
      float n2 = wsum64(kkr * kkr);
      float inv = frcp_(fmaxf(__builtin_amdgcn_sqrtf(n2), 1e-12f));
      float kap = kkr * inv;
      float kp = k * (1.0f + (a - 1.0f) * p.in[18][ch]);
      float al = kap * a;
      float ar = wsum64(al * r);
      float kr = wsum64(kp * r);
      float bsum = wsum64(r * kp * p.in[19][ch]);
      APRE[(size_t)row * 768 + ch] = f2bf(a);
      WPRE[(size_t)row * 768 + ch] = f2bf(omd);
      if (lane == 0) *(float4*)(SC + ((size_t)row * 12 + h) * 4) = make_float4(ar, kr, bsum, inv);
    }
  }
}

constexpr int TC = 16;
typedef float v2f __attribute__((ext_vector_type(2)));
typedef float v4f __attribute__((ext_vector_type(4)));

struct StRaw {
  unsigned cr[2], ck[2], cv[2];
  unsigned qr[2], qk[2], qv[2];
  unsigned wp[2], ap[2];
  float inv[2], sc2[2];
  v2f s_r, s_k, s_v;
  float m;
};
struct StConst { v2f mur, muk, muv, kk_, ka_; };

__device__ __forceinline__ v2f bfpair(unsigned u) {
  v2f r;
  r.x = __uint_as_float(u << 16);
  r.y = __uint_as_float(u & 0xffff0000u);
  return r;
}

template <bool SAMPLE>
__device__ __forceinline__ void st_load(const Params& p, StRaw& R, int row0, int b, int h, int c, int sw, int lane) {
  const u16* P = (const u16*)(p.ws + O_P);
  const u16* WPRE = (const u16*)(p.ws + O_WPRE);
  const u16* APRE = (const u16*)(p.ws + O_APRE);
  const float* SC = (const float*)(p.ws + O_BS);
  const int l2 = lane & 31, tp = lane >> 5;
  const int ch = h * 64 + 2 * l2;
  const int t0 = c * TC + sw * 4;
  R.m = (t0 + tp == 0) ? 0.f : 1.f;
  if (SAMPLE) {
    const float* sp = p.in[3] + (size_t)b * 2560 + ch;
    R.s_r = *(const v2f*)sp; R.s_k = *(const v2f*)(sp + 768); R.s_v = *(const v2f*)(sp + 1536);
  }
#pragma unroll
  for (int ps = 0; ps < 2; ps++) {
    const int t = t0 + 2 * ps + tp;
    const int tq = t > 0 ? t - 1 : 0;
    const u16* Pc = P + (size_t)(row0 + t) * 2816 + 256 + ch;
    const u16* Pq = P + (size_t)(row0 + tq) * 2816 + 256 + ch;
    R.cr[ps] = *(const unsigned*)Pc; R.ck[ps] = *(const unsigned*)(Pc + 768); R.cv[ps] = *(const unsigned*)(Pc + 1536);
    R.qr[ps] = *(const unsigned*)Pq; R.qk[ps] = *(const unsigned*)(Pq + 768); R.qv[ps] = *(const unsigned*)(Pq + 1536);
    const size_t row = row0 + t;
    R.wp[ps] = *(const unsigned*)(WPRE + row * 768 + ch);
    R.ap[ps] = *(const unsigned*)(APRE + row * 768 + ch);
    R.inv[ps] = SC[(row * 12 + h) * 4 + 3];
    R.sc2[ps] = SC[(row * 12 + h) * 4 + (lane & 1)];
  }
}

template <bool SAMPLE>
__device__ __forceinline__ void st_compute(const StConst& K, const StRaw& R, int sw, int lane, float* ops, float* scal) {
  const int l2 = lane & 31, tp = lane >> 5;
#pragma unroll
  for (int ps = 0; ps < 2; ps++) {
    const int tt = sw * 4 + 2 * ps + tp;
    v2f pr = bfpair(R.cr[ps]), pk = bfpair(R.ck[ps]), pv = bfpair(R.cv[ps]);
    v2f qr = bfpair(R.qr[ps]), qk = bfpair(R.qk[ps]), qv = bfpair(R.qv[ps]);
    if (ps == 0) {
      if (SAMPLE) { if (R.m == 0.f) { qr = R.s_r; qk = R.s_k; qv = R.s_v; } }
      else { const v2f mm = {R.m, R.m}; qr *= mm; qk *= mm; qv *= mm; }
    }
    const v2f r = pr + (qr - pr) * K.mur;
    const v2f k = pk + (qk - pk) * K.muk;
    const v2f v = pv + (qv - pv) * K.muv;
    const v2f one = {1.0f, 1.0f};
    const v2f dec = one - bfpair(R.wp[ps]);
    const v2f a = bfpair(R.ap[ps]);
    const v2f iv = {R.inv[ps], R.inv[ps]};
    const v2f kap = k * K.kk_ * iv;
    const v2f kp = k * (one + (a - one) * K.ka_);
    float* o6 = ops + tt * 384 + 2 * l2;
    *(v2f*)(o6) = dec; *(v2f*)(o6 + 64) = kap * a; *(v2f*)(o6 + 128) = kp; *(v2f*)(o6 + 192) = kap; *(v2f*)(o6 + 256) = dec * r; *(v2f*)(o6 + 320) = v;
    if (l2 < 2) scal[tt * 2 + l2] = R.sc2[ps];
  }
}

struct ScD { v4f a0, a1, q0, q1; };
struct ScU { v4f w0, w1, l0, l1, k0, k1; float v; v2f sc; };
__device__ __forceinline__ void scd_load(ScD& O, const float* o6, int j8) {
  O.a0 = *(const v4f*)(o6 + 192 + j8); O.a1 = *(const v4f*)(o6 + 192 + j8 + 4);
  O.q0 = *(const v4f*)(o6 + 256 + j8); O.q1 = *(const v4f*)(o6 + 256 + j8 + 4);
}
__device__ __forceinline__ void scu_load(ScU& O, const float* o6, const float* sb, int tt, int j8, int srow) {
  O.w0 = *(const v4f*)(o6 + j8); O.w1 = *(const v4f*)(o6 + j8 + 4);
  O.l0 = *(const v4f*)(o6 + 64 + j8); O.l1 = *(const v4f*)(o6 + 64 + j8 + 4);
  O.k0 = *(const v4f*)(o6 + 128 + j8); O.k1 = *(const v4f*)(o6 + 128 + j8 + 4);
  O.v = o6[320 + srow];
  O.sc = *(const v2f*)(sb + tt * 2);
}
__device__ __forceinline__ void sc_step(const ScD& D, const ScU& U, v2f& s0, v2f& s1, v2f& s2, v2f& s3, float* obuf, int tt, int lane) {
  v2f pd2 = s0 * D.a0.lo;
  v2f qd2 = s0 * D.q0.lo;
  pd2 = s1 * D.a0.hi + pd2; qd2 = s1 * D.q0.hi + qd2;
  pd2 = s2 * D.a1.lo + pd2; qd2 = s2 * D.q1.lo + qd2;
  pd2 = s3 * D.a1.hi + pd2; qd2 = s3 * D.q1.hi + qd2;
  float pd = reduce8(pd2.x + pd2.y);
  float qd = reduce8(qd2.x + qd2.y);
  const float v = U.v;
  const float o = qd - pd * U.sc.x + v * U.sc.y;
  const v2f vv = {v, v};
  const v2f np = {-pd, -pd};
  s0 = s0 * U.w0.lo + (np * U.l0.lo + vv * U.k0.lo);
  s1 = s1 * U.w0.hi + (np * U.l0.hi + vv * U.k0.hi);
  s2 = s2 * U.w1.lo + (np * U.l1.lo + vv * U.k1.lo);
  s3 = s3 * U.w1.hi + (np * U.l1.hi + vv * U.k1.hi);
  obuf[tt * 8 + (lane >> 3)] = o;
}

template <int STEPS>
__device__ __forceinline__ void scan_steps(v2f& s0, v2f& s1, v2f& s2, v2f& s3, const float* ob, const float* sb, int j8, int srow,
                                           float* obuf, int lane) {
  ScD A, B, C;
  ScU P, Q;
  scd_load(A, ob, j8);
  scu_load(P, ob, sb, 0, j8, srow);
  scd_load(B, ob + 384, j8);
#define SC_STEP(DX_, DZ_, UX_, UZ_, tt_) { \
    if ((tt_) + 1 < STEPS) scu_load(UZ_, ob + ((tt_) + 1) * 384, sb, (tt_) + 1, j8, srow); \
    if ((tt_) + 2 < STEPS) scd_load(DZ_, ob + ((tt_) + 2) * 384, j8); \
    asm volatile("" ::: "memory"); sc_step(DX_, UX_, s0, s1, s2, s3, obuf, (tt_), lane); asm volatile("" ::: "memory"); }
  SC_STEP(A, C, P, Q, 0) SC_STEP(B, A, Q, P, 1) SC_STEP(C, B, P, Q, 2) SC_STEP(A, C, Q, P, 3)
  if (STEPS > 4) {
    SC_STEP(B, A, P, Q, 4) SC_STEP(C, B, Q, P, 5) SC_STEP(A, C, P, Q, 6) SC_STEP(B, A, Q, P, 7)
    SC_STEP(C, B, P, Q, 8) SC_STEP(A, C, Q, P, 9) SC_STEP(B, A, P, Q, 10) SC_STEP(C, B, Q, P, 11)
    SC_STEP(A, C, P, Q, 12) SC_STEP(B, A, Q, P, 13) SC_STEP(C, B, P, Q, 14) SC_STEP(A, C, Q, P, 15)
  }
#undef SC_STEP
}

__device__ __forceinline__ void scan_phase(const Params& p, int cidx, int task_lo, int task_hi) {
  float* ops = (float*)smem;
  float* scal = ops + 2 * TC * 384;
  float* obufs = scal + 2 * TC * 2;
  u16* Y = (u16*)(p.ws + O_Y);
  int* counter = (int*)(p.ws + O_CNT) + cidx;
  const int tid = threadIdx.x, lane = tid & 63, wave = __builtin_amdgcn_readfirstlane(tid >> 6);
  {
    if (tid < 4) s_simdcnt[tid] = 0;
    __syncthreads();
    if (lane == 0) {
      const int simd = (int)__builtin_amdgcn_s_getreg(2308) & 3;
      const int r = atomicAdd(&s_simdcnt[simd], 1);
      s_role[wave] = simd | (r << 4);
    }
    __syncthreads();
    if (tid == 0) {
      int ns = 0;
      for (int w = 0; w < 8; w++) ns += ((s_role[w] >> 4) == 0);
      int st = 0;
      for (int w = 0; w < 8; w++) {
        int v;
        if (ns == 4) v = ((s_role[w] >> 4) == 0) ? (s_role[w] & 3) : (4 + st++);
        else v = w;
        s_role2[w] = v;
      }
    }
    __syncthreads();
  }
  const int rolew = __builtin_amdgcn_readfirstlane(s_role2[wave]);
  const bool stat = (gridDim.x == 256 && task_lo == 0);
  bool first = true;
  while (true) {
    __syncthreads();
    if (tid == 0) s_task = (stat && first && blockIdx.x < 192) ? -1 : atomicAdd(counter, 1);
    __syncthreads();
    const int tq = __builtin_amdgcn_readfirstlane(s_task);
    first = false;
    const int task = (tq < 0) ? ((int)(blockIdx.x & 7) * 24 + (int)(blockIdx.x >> 3)) : (tq + (stat ? 192 : task_lo));
    if (task >= task_hi) break;
    int b, h, half, row0, T;
    bool sample;
    if (task < 192) { b = task / 24; h = (task % 24) >> 1; half = task & 1; row0 = b * 2048; T = 2048; sample = false; }
    else { int u = task - 192; b = u / 24; h = (u % 24) >> 1; half = u & 1; row0 = NP + b * 4; T = 4; sample = true; }
    const int nch = (T + TC - 1) / TC;
    const int sbase = half * 32 + (rolew & 3) * 8;
    const int srow = sbase + (lane >> 3);
    const int j8 = (lane & 7) * 8;
    float* obuf = obufs + (rolew & 3) * 128;
    if (rolew < 4) {
      v2f s0 = {0.f, 0.f}, s1 = s0, s2 = s0, s3 = s0;
      if (sample) {
        const float* sp = p.in[4] + ((size_t)(b * 12 + h) * 64 + srow) * 64 + j8;
        v4f x0 = *(const v4f*)sp, x1 = *(const v4f*)(sp + 4);
        s0 = x0.lo; s1 = x0.hi; s2 = x1.lo; s3 = x1.hi;
      }
      RAW_BARRIER();
      for (int c = 0; c < nch; c++) {
        const int buf = c & 1;
        const float* ob = ops + buf * TC * 384;
        const float* sb = scal + buf * TC * 2;
        if (sample) scan_steps<4>(s0, s1, s2, s3, ob, sb, j8, srow, obuf, lane);
        else scan_steps<TC>(s0, s1, s2, s3, ob, sb, j8, srow, obuf, lane);
        const int tt = lane >> 2, pr = lane & 3;
        if (tt < T) {
          v2f ov = *(const v2f*)(obuf + tt * 8 + 2 * pr);
          unsigned pk = (unsigned)f2bf(ov.x) | ((unsigned)f2bf(ov.y) << 16);
          *(unsigned*)(Y + (size_t)(row0 + c * TC + tt) * 1024 + 256 + h * 64 + sbase + 2 * pr) = pk;
        }
        RAW_BARRIER();
      }
      float* dp = p.out + (sample ? OUT_SWKV : OUT_PWKV) + ((size_t)(b * 12 + h) * 64 + srow) * 64 + j8;
      *(float4*)dp = make_float4(s0.x, s0.y, s1.x, s1.y);
      *(float4*)(dp + 4) = make_float4(s2.x, s2.y, s3.x, s3.y);
    } else {
      const int sw = rolew - 4;
      const int ch = h * 64 + 2 * (lane & 31);
      StConst K;
      K.mur = *(const v2f*)(p.in[11] + ch); K.muk = *(const v2f*)(p.in[11] + 768 + ch); K.muv = *(const v2f*)(p.in[11] + 1536 + ch);
      K.kk_ = *(const v2f*)(p.in[17] + ch); K.ka_ = *(const v2f*)(p.in[18] + ch);
      if (sample) {
        if (sw == 0) {
          StRaw RS;
          st_load<true>(p, RS, row0, b, h, 0, 0, lane);
          st_compute<true>(K, RS, 0, lane, ops, scal);
        }
        RAW_BARRIER();
        RAW_BARRIER();
      } else {
        StRaw RA, RB;
        st_load<false>(p, RA, row0, b, h, 0, sw, lane);
        st_compute<false>(K, RA, sw, lane, ops, scal);
        st_load<false>(p, RA, row0, b, h, 1, sw, lane);
        st_load<false>(p, RB, row0, b, h, 2, sw, lane);
        RAW_BARRIER();
        for (int c = 0; c < nch; c += 2) {
          st_compute<false>(K, RA, sw, lane, ops + TC * 384, scal + TC * 2);
          st_load<false>(p, RA, row0, b, h, (c + 3 < nch) ? c + 3 : c + 1, sw, lane);
          RAW_BARRIER();
          st_compute<false>(K, RB, sw, lane, ops, scal);
          st_load<false>(p, RB, row0, b, h, (c + 4 < nch) ? c + 4 : c + 2 < nch ? c + 2 : c, sw, lane);
          RAW_BARRIER();
        }
      }
    }
  }
}

__device__ __forceinline__ void pool_queue(const Params& p) {
  int* counter = (int*)(p.ws + O_CNT) + 2;
  while (true) {
    __syncthreads();
    if (threadIdx.x == 0) s_task = atomicAdd(counter, 1);
    __syncthreads();
    const int it = __builtin_amdgcn_readfirstlane(s_task);
    if (it >= 640) break;
    pool_item(p, it);
  }
}

__device__ __forceinline__ void mix1_phase(const Params& p) {
  const u16* Q = (const u16*)(p.ws + O_P);
  u16* Y = (u16*)(p.ws + O_Y);
  const u16* WM = (const u16*)(p.ws + O_WM);
  const int tid = threadIdx.x, lane = tid & 63, wave = tid >> 6;
  constexpr int N_GP = 512, N_GS = 128, N_LRU = MT / 16;
  for (int it = blockIdx.x; it < N_GP + N_GS + N_LRU; it += gridDim.x) {
    __syncthreads();
    if (it < N_GP) {
      const int h = it & 3, ck = (it >> 2) & 15, b = it >> 6;
      const int r0 = b * 2048 + ck * 128;
      u16* vT = (u16*)smem;
      {
        const u16* qb = Q + (size_t)(r0 + wave * 16) * 2048 + 512 + lane * 8;
        float lg[8], lb[8];
        if ((lane >> 4) == h) {
#pragma unroll
          for (int e = 0; e < 8; e++) { lg[e] = p.in[25][h * 128 + (lane & 15) * 8 + e]; lb[e] = p.in[26][h * 128 + (lane & 15) * 8 + e]; }
        } else {
#pragma unroll
          for (int e = 0; e < 8; e++) { lg[e] = 0.f; lb[e] = 0.f; }
        }
        uint4 cur0 = *(const uint4*)(qb), cur1 = *(const uint4*)(qb + 2048), cur2 = *(const uint4*)(qb + 2 * 2048), cur3 = *(const uint4*)(qb + 3 * 2048);
        for (int bt = 0; bt < 4; bt++) {
          uint4 nx0 = cur0, nx1 = cur1, nx2 = cur2, nx3 = cur3;
          if (bt < 3) {
            const u16* qn = qb + (size_t)(bt + 1) * 4 * 2048;
            nx0 = *(const uint4*)(qn); nx1 = *(const uint4*)(qn + 2048); nx2 = *(const uint4*)(qn + 2 * 2048); nx3 = *(const uint4*)(qn + 3 * 2048);
          }
#pragma unroll
          for (int u = 0; u < 4; u++) {
            const uint4 raw = (u == 0) ? cur0 : (u == 1) ? cur1 : (u == 2) ? cur2 : cur3;
            const int j = wave * 16 + bt * 4 + u;
            const u16* rp = (const u16*)&raw;
            float z[8];
            float sm = 0.f;
#pragma unroll
            for (int e = 0; e < 8; e++) { z[e] = geluf_(bf2f(rp[e])); sm += z[e]; }
            const float mean = wsum64(sm) * (1.0f / 512.0f);
            float s2 = 0.f;
#pragma unroll
            for (int e = 0; e < 8; e++) { z[e] -= mean; s2 += z[e] * z[e]; }
            const float rstd = rsqrtf(wsum64(s2) * (1.0f / 512.0f) + 1e-5f);
            if ((lane >> 4) == h) {
#pragma unroll
              for (int e = 0; e < 8; e++) {
                const int d = (lane & 15) * 8 + e;
                vT[d * 136 + j] = f2bf(z[e] * rstd * lg[e] + lb[e]);
              }
            }
          }
          cur0 = nx0; cur1 = nx1; cur2 = nx2; cur3 = nx3;
        }
      }
      __syncthreads();
      const int wm = wave >> 1, wn = wave & 1;
      f32x16 acc0, acc1;
#pragma unroll
      for (int i = 0; i < 16; i++) { acc0[i] = 0.f; acc1[i] = 0.f; }
      const u16* ag = WM + (size_t)h * 16384 + (size_t)(wm * 32 + (lane & 31)) * 128 + (lane >> 5) * 8;
      const u16* bb = vT + (wn * 64 + (lane & 31)) * 136 + (lane >> 5) * 8;
      const int nks = 2 * (wm + 1);
      for (int ks = 0; ks < nks; ks++) {
        bf16x8 a = *(const bf16x8*)(ag + ks * 16);
        bf16x8 b0 = *(const bf16x8*)(bb + ks * 16);
        bf16x8 b1 = *(const bf16x8*)(bb + 32 * 136 + ks * 16);
        acc0 = __builtin_amdgcn_mfma_f32_32x32x16_bf16(a, b0, acc0, 0, 0, 0);
        acc1 = __builtin_amdgcn_mfma_f32_32x32x16_bf16(a, b1, acc1, 0, 0, 0);
      }
      const int d0 = h * 128 + wn * 64 + (lane & 31), d1 = d0 + 32;
#pragma unroll 4
      for (int i = 0; i < 16; i++) {
        const int il = wm * 32 + (i & 3) + 8 * (i >> 2) + 4 * (lane >> 5);
        const int row = r0 + il;
        const float bsv = p.in[28][h * 128 + il];
        float u0 = geluf_(bf2f(Q[(size_t)row * 2048 + d0]));
        float u1 = geluf_(bf2f(Q[(size_t)row * 2048 + d1]));
        Y[(size_t)row * 1024 + d0] = f2bf(u0 * (acc0[i] + bsv));
        Y[(size_t)row * 1024 + d1] = f2bf(u1 * (acc1[i] + bsv));
      }
    } else if (it < N_GP + N_GS) {
      const int b = it - N_GP;
      const int r0 = NP + b * 4;
      float* vs = (float*)smem;
      if (wave < 4) {
        const int row = r0 + wave;
        uint4 raw = *(const uint4*)(Q + (size_t)row * 2048 + 512 + lane * 8);
        const u16* rp = (const u16*)&raw;
        float z[8];
        float s = 0.f;
#pragma unroll
        for (int e = 0; e < 8; e++) { z[e] = geluf_(bf2f(rp[e])); s += z[e]; }
        const float mean = wsum64(s) * (1.0f / 512.0f);
        float s2 = 0.f;
#pragma unroll
        for (int e = 0; e < 8; e++) { z[e] -= mean; s2 += z[e] * z[e]; }
        const float rstd = rsqrtf(wsum64(s2) * (1.0f / 512.0f) + 1e-5f);
#pragma unroll
        for (int e = 0; e < 8; e++) {
          const int d = lane * 8 + e;
          float vn = z[e] * rstd * p.in[25][d] + p.in[26][d];
          vs[wave * 512 + d] = vn;
          p.out[OUT_SGV + (size_t)(b * 4 + wave) * 512 + d] = vn;
        }
      }
      __syncthreads();
      {
        const int ch = tid, hh = ch >> 7;
        for (int i = 0; i < 4; i++) {
          float mix = p.in[28][hh * 128 + i];
          for (int j = 0; j <= i; j++) mix += p.in[27][(size_t)(hh * 128 + i) * 128 + j] * vs[j * 512 + ch];
          float u = geluf_(bf2f(Q[(size_t)(r0 + i) * 2048 + ch]));
          Y[(size_t)(r0 + i) * 1024 + ch] = f2bf(u * mix);
        }
      }
    } else {
      const int li = it - N_GP - N_GS;
      const int r0 = li * 16;
      u16* xcb = (u16*)smem;
      float* gxs = (float*)(smem + 16 * 520 * 2);
      float* gas = gxs + 16 * 512;
      const int ch = tid;
      float* CA = (float*)(p.ws + O_CA);
      float* HL = (float*)(p.ws + O_HL);
      float* SEG = (float*)(p.ws + O_SEG);
      const float cw0 = p.in[29][ch], cw1 = p.in[29][512 + ch], cw2 = p.in[29][1024 + ch], cw3 = p.in[29][1536 + ch];
      const float cb = p.in[30][ch];
      {
        float xr[19];
#pragma unroll
        for (int q = 0; q < 19; q++) {
          const int row = r0 - 3 + q;
          float v = 0.f;
          bool valid;
          int tq;
          if (r0 < NP) { tq = (r0 & 2047) - 3 + q; valid = tq >= 0; }
          else { valid = true; tq = 0; }
          if (r0 < NP) { if (valid) v = bf2f(Q[(size_t)row * 2048 + 1536 + ch]); }
          else v = bf2f(Q[(size_t)(row < NP ? NP : row) * 2048 + 1536 + ch]);
          xr[q] = v;
        }
#pragma unroll
        for (int q = 0; q < 16; q++) {
          float x0 = xr[q], x1 = xr[q + 1], x2 = xr[q + 2], x3 = xr[q + 3];
          if (r0 >= NP) {
            const int rs = r0 - NP + q;
            const int t = rs & 3;
            const float* st = p.in[5] + (size_t)(rs >> 2) * 1536 + ch;
            if (t < 3) x0 = st[t * 512];
            if (t < 2) x1 = st[(t + 1) * 512];
            if (t < 1) x2 = st[(t + 2) * 512];
          }
          const float xc = cb + cw0 * x0 + cw1 * x1 + cw2 * x2 + cw3 * x3;
          xcb[q * 520 + ch] = f2bf(xc);
        }
      }
      __syncthreads();
      {
        const u16* WXT = (const u16*)(p.ws + O_WXT);
        const int n = wave;
        typedef __attribute__((ext_vector_type(4))) float f32x4;
        f32x4 ac[8];
#pragma unroll
        for (int i = 0; i < 8; i++) { ac[i][0] = 0.f; ac[i][1] = 0.f; ac[i][2] = 0.f; ac[i][3] = 0.f; }
#pragma unroll
        for (int kh = 0; kh < 2; kh++) {
          const bf16x8 af = *(const bf16x8*)(xcb + (lane & 15) * 520 + n * 64 + kh * 32 + (lane >> 4) * 8);
          bf16x8 bfr[8];
#pragma unroll
          for (int i = 0; i < 8; i++) {
            const int w = i >> 2, dt = i & 3;
            bfr[i] = *(const bf16x8*)(WXT + ((size_t)((w * 8 + n) * 64 + dt * 16 + (lane & 15))) * 64 + kh * 32 + (lane >> 4) * 8);
          }
#pragma unroll
          for (int i = 0; i < 8; i++) ac[i] = __builtin_amdgcn_mfma_f32_16x16x32_bf16(af, bfr[i], ac[i], 0, 0, 0);
        }
#pragma unroll
        for (int i = 0; i < 8; i++) {
          const int w = i >> 2, dt = i & 3;
          float* dst = (w ? gas : gxs) + n * 64 + dt * 16 + (lane & 15);
#pragma unroll
          for (int r = 0; r < 4; r++) dst[((lane >> 4) * 4 + r) * 512] = ac[i][r];
        }
      }
      __syncthreads();
      const float bx = p.in[32][ch], ba = p.in[34][ch];
      const float lam = p.in[35][ch];
      const float spl = fmaxf(-lam, 0.f) + log1pf(__expf(-fabsf(lam)));
      float hl = 0.f, ca = 1.f;
#pragma unroll 4
      for (int q = 0; q < 16; q++) {
        const int row = r0 + q;
        if (row >= NP) {
          int rs = row - NP;
          if ((rs & 3) == 0) { hl = p.in[6][(size_t)(rs >> 2) * 512 + ch]; ca = 1.f; }
        }
        float gx = sigmoidf_(gxs[q * 512 + ch] + bx), ga = sigmoidf_(gas[q * 512 + ch] + ba);
        float la = -8.0f * ga * spl;
        float a = __expf(la);
        float bb = __builtin_amdgcn_sqrtf(fmaxf(1.0f - a * a, 0.f)) * gx * bf2f(xcb[q * 520 + ch]);
        hl = a * hl + bb;
        ca = ca * a;
        CA[(size_t)row * 512 + ch] = ca;
        HL[(size_t)row * 512 + ch] = hl;
      }
      SEG[(size_t)li * 1024 + ch] = ca;
      SEG[(size_t)li * 1024 + 512 + ch] = hl;
    }
  }
}

__device__ __forceinline__ void lru_fix_phase(const Params& p, const XcdBarrier& xb) {
  const u16* Q = (const u16*)(p.ws + O_P);
  u16* Y = (u16*)(p.ws + O_Y);
  const float* CA = (const float*)(p.ws + O_CA);
  const float* HL = (const float*)(p.ws + O_HL);
  const float* SEG = (const float*)(p.ws + O_SEG);
  const int ch = threadIdx.x;
  const bool blocked = (gridDim.x == 256);
  for (int k = 0; k < (blocked ? 1 : 0); k++) {
    const int li0 = blockIdx.x * 4;
    const int b = li0 >> 7, s0 = li0 & 127;
    const float* sg = SEG + (size_t)(b * 128) * 1024 + ch;
    float carry = 0.f;
#pragma unroll 8
    for (int q = 0; q < s0; q++) carry = sg[(size_t)q * 1024] * carry + sg[(size_t)q * 1024 + 512];
    for (int u = 0; u < 4; u++) {
      const int li = li0 + u;
      const int r0 = li * 16;
#pragma unroll 8
      for (int q = 0; q < 16; q++) {
        const int row = r0 + q;
        float hv = HL[(size_t)row * 512 + ch] + CA[(size_t)row * 512 + ch] * carry;
        float gate = geluf_(bf2f(Q[(size_t)row * 2048 + 1024 + ch]));
        Y[(size_t)row * 1024 + 512 + ch] = f2bf(hv * gate);
        if ((row & 2047) == 2047) p.out[OUT_PLRU + (size_t)(row >> 11) * 512 + ch] = hv;
      }
      carry = sg[(size_t)(s0 + u) * 1024] * carry + sg[(size_t)(s0 + u) * 1024 + 512];
    }
  }
  for (int li = (blocked ? 1024 : 0) + blockIdx.x; li < MT / 16; li += gridDim.x) {
    const int r0 = li * 16;
    float carry = 0.f;
    if (r0 < NP) {
      const int b = r0 >> 11, sN = (r0 & 2047) >> 4;
      const float* sg = SEG + (size_t)(b * 128) * 1024 + ch;
      for (int q = 0; q < sN; q++) carry = sg[(size_t)q * 1024] * carry + sg[(size_t)q * 1024 + 512];
    }
#pragma unroll 8
    for (int q = 0; q < 16; q++) {
      const int row = r0 + q;
      float hv = HL[(size_t)row * 512 + ch] + CA[(size_t)row * 512 + ch] * carry;
      float gate = geluf_(bf2f(Q[(size_t)row * 2048 + 1024 + ch]));
      Y[(size_t)row * 1024 + 512 + ch] = f2bf(hv * gate);
      if (row < NP) {
        if ((row & 2047) == 2047) p.out[OUT_PLRU + (size_t)(row >> 11) * 512 + ch] = hv;
      } else {
        int rs = row - NP;
        if ((rs & 3) == 3) p.out[OUT_SLRU + (size_t)(rs >> 2) * 512 + ch] = hv;
      }
    }
  }
  const int gt = blockIdx.x * 512 + threadIdx.x, gs = gridDim.x * 512;
  for (int e = gt; e < 8 * 3 * 512; e += gs) {
    int b = e / 1536, i = (e / 512) % 3, c = e & 511;
    p.out[OUT_PCONV + e] = bf2f(Q[(size_t)(b * 2048 + 2045 + i) * 2048 + 1536 + c]);
  }
  for (int e = gt; e < 128 * 3 * 512; e += gs) {
    int b = e / 1536, i = (e / 512) % 3, c = e & 511;
    p.out[OUT_SCONV + e] = bf2f(Q[(size_t)(NP + b * 4 + 1 + i) * 2048 + 1536 + c]);
  }
}

__device__ __forceinline__ void res_fix_phase(const Params& p) {
  u16* xb = (u16*)(p.ws + O_XB);
  float* part = (float*)(p.ws + O_PART);
  const int lane = threadIdx.x & 63, wave = threadIdx.x >> 6;
  for (int row = NP + blockIdx.x * 8 + wave; row < MT; row += gridDim.x * 8) {
    const float* xr = p.out + (size_t)row * 1024;
    float ss = 0.f;
#pragma unroll
    for (int i = 0; i < 4; i++) {
      float4 v = *(const float4*)(xr + i * 256 + lane * 4);
      ss += v.x * v.x + v.y * v.y + v.z * v.z + v.w * v.w;
      ushort4 o;
      o.x = f2bf(v.x); o.y = f2bf(v.y); o.z = f2bf(v.z); o.w = f2bf(v.w);
      *(ushort4*)(xb + (size_t)row * 1024 + i * 256 + lane * 4) = o;
    }
    ss = wsum64(ss);
    if (lane < 16) part[(size_t)row * 16 + lane] = (lane == 0) ? ss : 0.f;
  }
}

__device__ __forceinline__ void final_phase(const Params& p) {
  const float* part = (const float*)(p.ws + O_PART);
  const float* g = p.in[40];
  const int lane = threadIdx.x & 63, wave = threadIdx.x >> 6;
  for (int row = blockIdx.x * 8 + wave; row < MT; row += gridDim.x * 8) {
    float s = (lane < 16) ? part[(size_t)row * 16 + lane] : 0.f;
    s = wsum64(s);
    const float rs = rsqrtf(s * (1.0f / 1024.0f) + 1e-6f);
    float* xr = p.out + (size_t)row * 1024;
#pragma unroll
    for (int i = 0; i < 4; i++) {
      float4 v = *(float4*)(xr + i * 256 + lane * 4);
      float4 gg = *(const float4*)(g + i * 256 + lane * 4);
      v.x *= rs * gg.x; v.y *= rs * gg.y; v.z *= rs * gg.z; v.w *= rs * gg.w;
      *(float4*)(xr + i * 256 + lane * 4) = v;
    }
  }
}


constexpr int NPHASE = 22;
enum { K_P0 = 0, K_G_SCALE, K_G_PLAIN, K_G_FF1, K_G_RES, K_G_POST, K_POOL, K_SCAN, K_MIX1, K_LRUFIX, K_FINAL };

#define PH(n, sync_) if (plo <= (n) && (n) <= phi) { if ((n) > plo && (sync_)) { if ((n) == 1) { grid.sync(); xb = xcd_barrier_post((unsigned*)(ws + O_XBAR), (volatile LAS unsigned*)&xb_words); } else xcd_barrier(xb); }
#define PHEND }
#define WSB(o) ((const u16*)(ws + (o)))
#define WSO(o) ((u16*)(ws + (o)))
__global__ void __launch_bounds__(512) mega(Params p, int plo, int phi) {
  cg::grid_group grid = cg::this_grid();
  char* ws = p.ws;
  __shared__ uint4 xb_words;
  if (threadIdx.x == 0) xb_words = make_uint4(0u, 0u, 0u, 0u);
  __syncthreads();
  XcdBarrier xb; xb.bar = (unsigned*)(ws + O_XBAR); xb.x = 0; xb.st = (volatile LAS unsigned*)&xb_words;
  PH(0, 1) phase0(p); PHEND
  PH(1, 1) gemm_phase<EPI_SCALE>(p, WSB(O_XB), 1024, WSB(O_WIN0), 1024, 1024, 2816, WSO(O_P), 2816, 0, 0); PHEND
  PH(2, 1) pool_phase(p); PHEND
  PH(3, 1) gemm_phase<EPI_PLAIN>(p, WSB(O_LIN), 256, WSB(O_WLW), 64, 64, 768, WSO(O_WPRE), 768, 0, 0); PHEND
  PH(4, 0) gemm_phase<EPI_PLAIN>(p, WSB(O_LIN + 128), 256, WSB(O_WLA), 64, 64, 768, WSO(O_APRE), 768, 0, 140); PHEND
  PH(5, 1) rwkv_prep_phase(p); PHEND
  PH(6, 1) scan_phase(p, 0, 0, 3264); pool_queue(p); PHEND
  PH(7, 1) gemm_phase<EPI_POST>(p, WSB(O_LIN + 256), 256, WSB(O_WLG), 128, 128, 768, nullptr, 0, 0, 0); PHEND
  PH(8, 1) gemm_phase<EPI_RES>(p, WSB(O_Y), 1024, WSB(O_WOUT0), 1024, 1024, 1024, WSO(O_XB), 1024, 1, 0); PHEND
  PH(9, 1) res_fix_phase(p); PHEND
  PH(10, 1) gemm_phase<EPI_FF1>(p, WSB(O_XB), 1024, WSB(O_WF10), 1024, 1024, 4096, WSO(O_H), 4096, 0, 0); PHEND
  PH(11, 1) gemm_phase<EPI_RES>(p, WSB(O_H), 4096, WSB(O_WF20), 4096, 4096, 1024, WSO(O_XB), 1024, 0, 0); PHEND
  PH(12, 1) res_fix_phase(p); PHEND
  PH(13, 1) gemm_phase<EPI_SCALE>(p, WSB(O_XB), 1024, WSB(O_WIN1), 1024, 1024, 2048, WSO(O_P), 2048, 0, 0); PHEND
  PH(14, 1) mix1_phase(p); PHEND
  PH(15, 1) lru_fix_phase(p, xb); PHEND
  PH(16, 1) gemm_phase<EPI_RES>(p, WSB(O_Y), 1024, WSB(O_WOUT1), 1024, 1024, 1024, WSO(O_XB), 1024, 0, 0); PHEND
  PH(17, 1) res_fix_phase(p); PHEND
  PH(18, 1) gemm_phase<EPI_FF1>(p, WSB(O_XB), 1024, WSB(O_WF11), 1024, 1024, 4096, WSO(O_H), 4096, 0, 0); PHEND
  PH(19, 1) gemm_phase<EPI_RES>(p, WSB(O_H), 4096, WSB(O_WF21), 4096, 4096, 1024, WSO(O_XB), 1024, 0, 0); PHEND
  PH(20, 1) res_fix_phase(p); PHEND
  PH(21, 1) final_phase(p); PHEND
}

extern "C" void kernel_launch(void* const* d_in, const int* in_sizes, int n_in, void* d_out, int out_size, void* d_ws,
                              size_t ws_size, hipStream_t stream) {
  static int grid_blocks = 0;
  if (!grid_blocks) {
    int dev = 0, cus = 0, per_cu = 0;
    hipGetDevice(&dev);
    hipDeviceGetAttribute(&cus, hipDeviceAttributeMultiprocessorCount, dev);
    hipOccupancyMaxActiveBlocksPerMultiprocessor(&per_cu, mega, 512, 0);
    if (per_cu < 1) per_cu = 1;
    grid_blocks = cus;
    if (grid_blocks > cus * per_cu) grid_blocks = cus * per_cu;
    if (ws_size < WS_NEED) fprintf(stderr, "workspace too small: %zu < %zu\n", ws_size, (size_t)WS_NEED);
  }
  Params p{};
  for (int i = 0; i < 41; i++) p.in[i] = (const float*)d_in[i];
  p.out = (float*)d_out;
  p.ws = (char*)d_ws;
  int plo = 0, phi = NPHASE - 1;
  void* args[] = {&p, &plo, &phi};
  hipError_t e = hipLaunchCooperativeKernel((void*)mega, dim3(grid_blocks), dim3(512), args, 0, stream);
  if (e != hipSuccess) fprintf(stderr, "cooperative launch failed: %s (grid %d)\n", hipGetErrorString(e), grid_blocks);
}
```

```cpp
#include <hip/hip_runtime.h>
#include <hip/hip_cooperative_groups.h>
#include <cstdio>
namespace cg = cooperative_groups;

typedef unsigned short u16;
typedef __attribute__((ext_vector_type(8))) short bf16x8;
typedef __attribute__((ext_vector_type(16))) float f32x16;

constexpr int MT = 16896;
constexpr int NP = 16384;

struct Params {
  const float* in[41];
  float* out;
  char* ws;
};

constexpr size_t OUT_Y = 0;
constexpr size_t OUT_PPOOL = (size_t)MT * 1024;
constexpr size_t OUT_PSHIFT = OUT_PPOOL + 8 * 15 * 256;
constexpr size_t OUT_PWKV = OUT_PSHIFT + 8 * 2560;
constexpr size_t OUT_PCONV = OUT_PWKV + 8 * 12 * 4096;
constexpr size_t OUT_PLRU = OUT_PCONV + 8 * 3 * 512;
constexpr size_t OUT_SPOOL = OUT_PLRU + 8 * 512;
constexpr size_t OUT_SSHIFT = OUT_SPOOL + 128 * 15 * 256;
constexpr size_t OUT_SWKV = OUT_SSHIFT + 128 * 2560;
constexpr size_t OUT_SCONV = OUT_SWKV + (size_t)128 * 12 * 4096;
constexpr size_t OUT_SLRU = OUT_SCONV + 128 * 3 * 512;
constexpr size_t OUT_SGV = OUT_SLRU + 128 * 512;

constexpr size_t O_WIN0 = 0;
constexpr size_t O_WOUT0 = O_WIN0 + 2816ull * 1024 * 2;
constexpr size_t O_WF10 = O_WOUT0 + 1024ull * 1024 * 2;
constexpr size_t O_WF20 = O_WF10 + 4096ull * 1024 * 2;
constexpr size_t O_WIN1 = O_WF20 + 4096ull * 1024 * 2;
constexpr size_t O_WOUT1 = O_WIN1 + 2048ull * 1024 * 2;
constexpr size_t O_WF11 = O_WOUT1 + 1024ull * 1024 * 2;
constexpr size_t O_WF21 = O_WF11 + 4096ull * 1024 * 2;
constexpr size_t O_WLW = O_WF21 + 4096ull * 1024 * 2;
constexpr size_t O_WLA = O_WLW + 768 * 64 * 2;
constexpr size_t O_WLG = O_WLA + 768 * 64 * 2;
constexpr size_t O_WM = O_WLG + 768 * 128 * 2;
constexpr size_t O_CNT = O_WM + 4 * 128 * 128 * 2;
constexpr size_t O_PART = O_CNT + 256;
constexpr size_t O_XB = O_PART + (size_t)MT * 16 * 4;
constexpr size_t O_Y = O_XB + (size_t)MT * 1024 * 2;
constexpr size_t O_AR = O_Y + (size_t)MT * 1024 * 2;
constexpr size_t O_P = O_AR;
constexpr size_t O_LIN = O_P + (size_t)MT * 2816 * 2;
constexpr size_t O_WPRE = O_LIN + (size_t)MT * 256 * 2;
constexpr size_t O_APRE = O_XB;
constexpr size_t O_BS = O_APRE + (size_t)MT * 768 * 2;
constexpr size_t O_CA = O_AR + (size_t)MT * 2048 * 2;
constexpr size_t O_HL = O_CA + (size_t)MT * 512 * 4;
constexpr size_t O_SEG = O_HL + (size_t)MT * 512 * 4;
constexpr size_t O_H = O_AR;
constexpr size_t O_XBAR = O_SEG + (size_t)1056 * 1024 * 4;
constexpr size_t O_CAR = O_XBAR + 16384;
constexpr size_t O_WXT = O_CAR + (size_t)1024 * 512 * 4;
constexpr size_t WS_NEED = O_WXT + 131072;

__device__ __forceinline__ u16 f2bf(float f) {
  __bf16 h = (__bf16)f;
  return __builtin_bit_cast(u16, h);
}
__device__ __forceinline__ float bf2f(u16 h) { return __uint_as_float(((unsigned)h) << 16); }
__device__ __forceinline__ float frcp_(float x) { return __builtin_amdgcn_rcpf(x); }
__device__ __forceinline__ float sigmoidf_(float x) { return frcp_(1.0f + __expf(-x)); }
__device__ __forceinline__ float tanhf_(float x) {
  float e = __expf(2.0f * x);
  return 1.0f - 2.0f * frcp_(1.0f + e);
}
__device__ __forceinline__ float geluf_(float x) {
  float y = 0.7978845608028654f * (x + 0.044715f * x * x * x);
  return 0.5f * x * (1.0f + tanhf_(y));
}
template <int CTRL>
__device__ __forceinline__ float dppmov(float v) {
  return __int_as_float(__builtin_amdgcn_update_dpp(0, __float_as_int(v), CTRL, 0xF, 0xF, true));
}
__device__ __forceinline__ float reduce8(float v) {
  v += dppmov<0xB1>(v);
  v += dppmov<0x4E>(v);
  v += dppmov<0x141>(v);
  return v;
}
__device__ __forceinline__ float row16sum(float v) {
  v += dppmov<0xB1>(v);
  v += dppmov<0x4E>(v);
  v += dppmov<0x141>(v);
  v += dppmov<0x140>(v);
  return v;
}
__device__ __forceinline__ float wsum64(float v) {
  v = row16sum(v);
  v += __int_as_float(__builtin_amdgcn_update_dpp(0, __float_as_int(v), 0x142, 0xA, 0xF, false));
  v += __int_as_float(__builtin_amdgcn_update_dpp(0, __float_as_int(v), 0x143, 0xC, 0xF, false));
  return __int_as_float(__builtin_amdgcn_readlane(__float_as_int(v), 63));
}
__device__ __forceinline__ float hsum32(float v) {
  v = row16sum(v);
  return v + __shfl_xor(v, 16);
}
__device__ __forceinline__ const float* xrow(const Params& p, int row) {
  return row < NP ? p.in[0] + (size_t)row * 1024 : p.in[1] + (size_t)(row - NP) * 1024;
}
__device__ __forceinline__ float prevP(const Params& p, const u16* P, int row, int c) {
  const int rp = row > 0 ? row - 1 : 0;
  float v = bf2f(P[(size_t)rp * 2816 + 256 + c]);
  const bool start = (row < NP) ? ((row & 2047) == 0) : (((row - NP) & 3) == 0);
  if (start) v = (row < NP) ? 0.f : p.in[3][(size_t)((row - NP) >> 2) * 2560 + c];
  return v;
}

__shared__ __attribute__((aligned(16))) unsigned char smem[114688];
#define RAW_BARRIER() do { asm volatile("s_waitcnt lgkmcnt(0)" ::: "memory"); __builtin_amdgcn_s_barrier(); asm volatile("" ::: "memory"); } while (0)
__shared__ int s_task;
__shared__ int s_simdcnt[4];
__shared__ int s_role[8];
__shared__ int s_role2[8];

#define XB_TMO      128
#define XB_XCNT(j)  (256  + 64 * (j))
#define XB_XSUB(j)  (1280 + 64 * (j))
#define XB_XGEN(j)  (2304 + 64 * (j))
#define XB_TOP      3328
#define XB_TOPGEN   3392
#define XCD_BAR_WORDS 3456
#define XB_SPIN_CAP (1u << 18)
#define LAS __attribute__((address_space(3)))

__device__ __forceinline__ unsigned xb_ld(unsigned* p)              { return __hip_atomic_load(p, __ATOMIC_RELAXED, __HIP_MEMORY_SCOPE_AGENT); }
__device__ __forceinline__ unsigned xb_add(unsigned* p, unsigned v) { return __hip_atomic_fetch_add(p, v, __ATOMIC_RELAXED, __HIP_MEMORY_SCOPE_AGENT); }
__device__ __forceinline__ unsigned xb_xcc_id() { return (unsigned)__builtin_amdgcn_s_getreg((3 << 11) | 20) & 0xFu; }
#define XB_SPIN(cond, bar) do { unsigned _sp = 0; while (cond) { __builtin_amdgcn_s_sleep(1); \
    if ((++_sp & 255u) == 0u) { if (xb_ld(&(bar)[XB_TMO])) break; if (_sp > XB_SPIN_CAP) { atomicAdd(&(bar)[XB_TMO], 1u); break; } } } } while (0)

struct XcdBarrier {
    unsigned* bar; unsigned x;
    volatile LAS unsigned* st;
};

__device__ __forceinline__ XcdBarrier xcd_barrier_post(unsigned* bar, volatile LAS unsigned* st) {
    XcdBarrier b; b.bar = bar; b.x = xb_xcc_id(); b.st = st;
    if (threadIdx.x == 0) (void)xb_add(&bar[XB_XCNT(b.x)], 1u);
    return b;
}
__device__ __forceinline__ void xcd_barrier_complete(unsigned* bar, unsigned x, unsigned& nloc, unsigned& nx) {
    const unsigned G = gridDim.x * gridDim.y * gridDim.z;
    unsigned sum, cnt, mine, sp = 0u;
    for (;;) {
        sum = 0u; cnt = 0u; mine = 0u;
#pragma unroll
        for (unsigned j = 0; j < 16; ++j) { const unsigned c = xb_ld(&bar[XB_XCNT(j)]); sum += c; cnt += (c > 0u) ? 1u : 0u; mine = (j == x) ? c : mine; }
        if (sum == G) break;
        __builtin_amdgcn_s_sleep(1);
        if ((++sp & 255u) == 0u) { if (xb_ld(&bar[XB_TMO])) break; if (sp > XB_SPIN_CAP) { atomicAdd(&bar[XB_TMO], 1u); break; } }
    }
    nloc = mine > 0u ? mine : 1u; nx = cnt > 0u ? cnt : 1u;
}

__device__ __forceinline__ void xcd_barrier(const XcdBarrier& b) {
    asm volatile("s_waitcnt vmcnt(0)" ::: "memory");
    __syncthreads();
    if (threadIdx.x == 0) {
        unsigned* bar = b.bar;
        __builtin_amdgcn_s_waitcnt(0);
        unsigned nloc = b.st[0], nx = b.st[1];
        if (nloc == 0u) { xcd_barrier_complete(bar, b.x, nloc, nx); b.st[0] = nloc; b.st[1] = nx; }
        const unsigned old = xb_add(&bar[XB_XSUB(b.x)], 1u);
        const unsigned gen = old / nloc;
        if (old + 1u == (gen + 1u) * nloc) {
            __builtin_amdgcn_fence(__ATOMIC_RELEASE, "agent");
            asm volatile("s_waitcnt vmcnt(0)" ::: "memory");
            const unsigned og = xb_add(&bar[XB_TOP], 1u);
            const unsigned tg = og / nx;
            if (og + 1u == (tg + 1u) * nx) xb_add(&bar[XB_TOPGEN], 1u);
            else XB_SPIN(xb_ld(&bar[XB_TOPGEN]) == tg, bar);
            __builtin_amdgcn_fence(__ATOMIC_ACQUIRE, "agent");
            xb_add(&bar[XB_XGEN(b.x)], 1u);
            asm volatile("s_waitcnt vmcnt(0)" ::: "memory");
        } else {
            XB_SPIN(xb_ld(&bar[XB_XGEN(b.x)]) == gen, bar);
            __builtin_amdgcn_fence(__ATOMIC_ACQUIRE, "agent");
            asm volatile("s_waitcnt vmcnt(0)" ::: "memory");
        }
    }
    __syncthreads();
}


__device__ __forceinline__ void convT(const float* __restrict__ W, int K, int N, const float* __restrict__ g, u16* __restrict__ WT) {
  float* t = (float*)smem;
  const int tilesN = N / 128, tiles = (K / 64) * tilesN;
  const int tx = threadIdx.x & 127, ty = threadIdx.x >> 7;
  const int sx = threadIdx.x & 63, sy = threadIdx.x >> 6;
  for (int tl = blockIdx.x; tl < tiles; tl += gridDim.x) {
    const int k0 = (tl / tilesN) * 64, n0 = (tl % tilesN) * 128;
    float v[16];
#pragma unroll
    for (int i = 0; i < 16; i++) v[i] = W[(size_t)(k0 + ty + 4 * i) * N + n0 + tx];
    if (g) {
#pragma unroll
      for (int i = 0; i < 16; i++) v[i] *= g[k0 + ty + 4 * i];
    }
    __syncthreads();
#pragma unroll
    for (int i = 0; i < 16; i++) t[(ty + 4 * i) * 129 + tx] = v[i];
    __syncthreads();
#pragma unroll
    for (int i = 0; i < 16; i++) {
      const int n = sy + 8 * i;
      WT[(size_t)(n0 + n) * K + k0 + sx] = f2bf(t[sx * 129 + n]);
    }
  }
}

__device__ __forceinline__ void phase0(const Params& p) {
  char* ws = p.ws;
  convT(p.in[8], 1024, 2816, p.in[7], (u16*)(ws + O_WIN0));
  convT(p.in[22], 1024, 1024, nullptr, (u16*)(ws + O_WOUT0));
  convT(p.in[38], 1024, 4096, p.in[37], (u16*)(ws + O_WF10));
  convT(p.in[39], 4096, 1024, nullptr, (u16*)(ws + O_WF20));
  convT(p.in[24], 1024, 2048, p.in[23], (u16*)(ws + O_WIN1));
  convT(p.in[36], 1024, 1024, nullptr, (u16*)(ws + O_WOUT1));
  convT(p.in[38] + (size_t)1024 * 4096, 1024, 4096, p.in[37] + 1024, (u16*)(ws + O_WF11));
  convT(p.in[39] + (size_t)1024 * 4096, 4096, 1024, nullptr, (u16*)(ws + O_WF21));
  convT(p.in[13], 64, 768, nullptr, (u16*)(ws + O_WLW));
  convT(p.in[15], 64, 768, nullptr, (u16*)(ws + O_WLA));
  convT(p.in[16], 128, 768, nullptr, (u16*)(ws + O_WLG));
  {
    u16* wm = (u16*)(ws + O_WM);
    const float* wsrc = p.in[27];
    for (int e = blockIdx.x * 512 + threadIdx.x; e < 4 * 128 * 128; e += gridDim.x * 512) {
      int i = (e >> 7) & 127, j = e & 127;
      wm[e] = (j <= i) ? f2bf(wsrc[e]) : (u16)0;
    }
  }
  {
    u16* wxt = (u16*)(ws + O_WXT);
    for (int e = blockIdx.x * 512 + threadIdx.x; e < 16 * 64 * 64; e += gridDim.x * 512) {
      const int m = e >> 12, d = (e >> 6) & 63, c = e & 63;
      const float* src = (m < 8) ? p.in[31] : p.in[33];
      wxt[e] = f2bf(src[(m & 7) * 4096 + c * 64 + d]);
    }
  }
  if (blockIdx.x == 0 && threadIdx.x < 64) ((int*)(ws + O_CNT))[threadIdx.x] = 0;
  if (blockIdx.x == 1) for (int e = threadIdx.x; e < 3456; e += 512) ((unsigned*)(ws + O_XBAR))[e] = 0u;
  for (int e = blockIdx.x * 512 + threadIdx.x; e < 512 * 256; e += gridDim.x * 512) ((float4*)(p.out + (size_t)NP * 1024))[e] = ((const float4*)p.in[1])[e];
  {
    u16* xb = (u16*)(ws + O_XB);
    float* part = (float*)(ws + O_PART);
    const int lane = threadIdx.x & 63, wave = threadIdx.x >> 6;
    for (int row = blockIdx.x * 8 + wave; row < MT; row += gridDim.x * 8) {
      const float* xr = xrow(p, row);
      float ss = 0.f;
#pragma unroll
      for (int i = 0; i < 4; i++) {
        float4 v = *(const float4*)(xr + i * 256 + lane * 4);
        ss += v.x * v.x + v.y * v.y + v.z * v.z + v.w * v.w;
        ushort4 o;
        o.x = f2bf(v.x); o.y = f2bf(v.y); o.z = f2bf(v.z); o.w = f2bf(v.w);
        *(ushort4*)(xb + (size_t)row * 1024 + i * 256 + lane * 4) = o;
      }
      ss = wsum64(ss);
      if (lane < 16) part[(size_t)row * 16 + lane] = (lane == 0) ? ss : 0.f;
    }
  }
}

enum { EPI_SCALE = 0, EPI_PLAIN = 1, EPI_FF1 = 2, EPI_RES = 3, EPI_POST = 4 };

template <int EPI>
__device__ __forceinline__ void gemm_epi(const Params& p, const f32x16 acc0, const f32x16 acc1, int mi, int wm, int wn, int lane,
                                         int m0, int nt, int c0, int c1, const float* sRs, u16* __restrict__ outb, int ldo,
                                         int resid_in) {
  float* part = (float*)(p.ws + O_PART);
  float* xf = p.out;
    const int rbase = wm * 64 + mi * 32 + 4 * (lane >> 5);
    if (EPI == EPI_SCALE || EPI == EPI_PLAIN || EPI == EPI_FF1) {
#pragma unroll
      for (int i = 0; i < 16; i++) {
        const int rl = rbase + (i & 3) + 8 * (i >> 2);
        const int row = m0 + rl;
        float v0 = acc0[i], v1 = acc1[i];
        if (EPI != EPI_PLAIN) { float rs = sRs[rl]; v0 *= rs; v1 *= rs; }
        if (EPI == EPI_FF1) { v0 = fmaxf(v0, 0.f); v1 = fmaxf(v1, 0.f); v0 *= v0; v1 *= v1; }
        outb[(size_t)row * ldo + c0] = f2bf(v0);
        outb[(size_t)row * ldo + c1] = f2bf(v1);
      }
    } else if (EPI == EPI_RES) {
#pragma unroll
      for (int i = 0; i < 16; i++) {
        const int rl = rbase + (i & 3) + 8 * (i >> 2);
        const int row = m0 + rl;
        const float* res = resid_in ? xrow(p, row) : (xf + (size_t)row * 1024);
        float v0 = res[c0] + acc0[i], v1 = res[c1] + acc1[i];
        xf[(size_t)row * 1024 + c0] = v0;
        xf[(size_t)row * 1024 + c1] = v1;
        outb[(size_t)row * 1024 + c0] = f2bf(v0);
        outb[(size_t)row * 1024 + c1] = f2bf(v1);
        float s = hsum32(v0 * v0 + v1 * v1);
        if ((lane & 31) == 0) part[(size_t)row * 16 + nt * 2 + wn] = s;
      }
    } else {
      const int hh = nt * 2 + wn;
      const u16* P = (const u16*)(p.ws + O_P);
      u16* Y = (u16*)(p.ws + O_Y);
      const float* bs = (const float*)(p.ws + O_BS);
      const int ch0 = hh * 64 + (lane & 31), ch1 = ch0 + 32;
      const float gg0 = p.in[20][ch0], gg1 = p.in[20][ch1];
      const float gb0 = p.in[21][ch0], gb1 = p.in[21][ch1];
      const float mu0 = p.in[11][1536 + ch0], mu1 = p.in[11][1536 + ch1];
#pragma unroll 8
      for (int i = 0; i < 16; i++) {
        const int rl = rbase + (i & 3) + 8 * (i >> 2);
        const int row = m0 + rl;
        float o0 = bf2f(Y[(size_t)row * 1024 + 256 + ch0]);
        float o1 = bf2f(Y[(size_t)row * 1024 + 256 + ch1]);
        float mean = hsum32(o0 + o1) * (1.0f / 64.0f);
        float d0 = o0 - mean, d1 = o1 - mean;
        float var = hsum32(d0 * d0 + d1 * d1) * (1.0f / 64.0f);
        float rstd = rsqrtf(var + 64e-5f);
        float pv0 = bf2f(P[(size_t)row * 2816 + 256 + 1536 + ch0]);
        float pv1 = bf2f(P[(size_t)row * 2816 + 256 + 1536 + ch1]);
        float pp0 = prevP(p, P, row, 1536 + ch0), pp1 = prevP(p, P, row, 1536 + ch1);
        float vv0 = pv0 + (pp0 - pv0) * mu0, vv1 = pv1 + (pp1 - pv1) * mu1;
        float b = bs[((size_t)row * 12 + hh) * 4 + 2];
        float y0 = (d0 * rstd * gg0 + gb0 + b * vv0) * acc0[i];
        float y1 = (d1 * rstd * gg1 + gb1 + b * vv1) * acc1[i];
        Y[(size_t)row * 1024 + 256 + ch0] = f2bf(y0);
        Y[(size_t)row * 1024 + 256 + ch1] = f2bf(y1);
      }
    }
}

template <int EPI>
__device__ __forceinline__ void gemm_phase(const Params& p, const u16* __restrict__ A, int lda, const u16* __restrict__ BT, int ldb,
                           int K, int N, u16* __restrict__ outb, int ldo, int resid_in, int boff) {
  constexpr int LS = 72;
  constexpr int SA = 256 * LS, SB = 128 * LS, STG = SA + SB;
  u16* sm = (u16*)smem;
  float* sRs = (float*)(sm + 2 * STG);
  const int tid = threadIdx.x, lane = tid & 63, wave = tid >> 6;
  const int wm = wave >> 1, wn = wave & 1;
  const int lrow = tid >> 3, lch = tid & 7;
  const int NT = N / 128;
  const int tiles = (MT / 256) * NT;
  const int KTALL = K / 64;
  float* part = (float*)(p.ws + O_PART);
  int bstart = (int)blockIdx.x - boff;
  if (bstart < 0) bstart += gridDim.x;
  const size_t a64 = (size_t)64 * lda, b64 = (size_t)64 * ldb;
  const int G = gridDim.x;
  int t_full = tiles, split = 1;
  if (EPI == EPI_RES) {
    const int tail = tiles % G;
    if (tail > 0 && (G % tail) == 0 && (KTALL % (G / tail)) == 0) { t_full = tiles - tail; split = (G / tail) > 4 ? 4 : (G / tail); }
  }
  const int units = t_full + (tiles - t_full) * split;
  for (int un = bstart; un < units; un += G) {
    int tl = un, kbeg = 0, KT = KTALL;
    bool part_unit = false;
    if (un >= t_full) { const int v = un - t_full; tl = t_full + v / split; KT = KTALL / split; kbeg = (v % split) * KT; part_unit = true; }
    int mt = tl / NT, nt = tl % NT;
    if (EPI == EPI_RES && NT == 8 && G == 256 && !part_unit) {
      const int rr = tl >> 8, bb = tl & 255;
      const int xx = bb & 7, jj = bb >> 3;
      mt = rr * 32 + xx * 4 + (jj >> 3);
      nt = jj & 7;
    } else if ((EPI == EPI_FF1 || EPI == EPI_SCALE) && G == 256 && (NT == 32 || NT == 16) && tl < (tiles & ~255)) {
      const int rr = tl >> 8, bb = tl & 255;
      const int xx = bb & 7, jj = bb >> 3;
      if (NT == 32) { mt = rr * 8 + (xx >> 2) * 4 + (jj >> 3); nt = (xx & 3) * 8 + (jj & 7); }
      else { mt = rr * 16 + (xx >> 1) * 4 + (jj >> 3); nt = (xx & 1) * 8 + (jj & 7); }
    }
    const int m0 = mt * 256, n0 = nt * 128;
    const u16* gA = A + (size_t)(m0 + lrow) * lda + lch * 8 + (size_t)kbeg * 64;
    const u16* gB = BT + (size_t)(n0 + lrow) * ldb + lch * 8 + (size_t)kbeg * 64;
    uint4 xa0, xa1, xa2, xa3, xb0, xb1;
    uint4 ya0, ya1, ya2, ya3, yb0, yb1;
#define LOADX(kt_) { const u16* qa = gA + (kt_) * 64; const u16* qb = gB + (kt_) * 64; \
    xa0 = *(const uint4*)qa; xa1 = *(const uint4*)(qa + a64); xa2 = *(const uint4*)(qa + 2 * a64); xa3 = *(const uint4*)(qa + 3 * a64); \
    xb0 = *(const uint4*)qb; xb1 = *(const uint4*)(qb + b64); }
#define LOADY(kt_) { const u16* qa = gA + (kt_) * 64; const u16* qb = gB + (kt_) * 64; \
    ya0 = *(const uint4*)qa; ya1 = *(const uint4*)(qa + a64); ya2 = *(const uint4*)(qa + 2 * a64); ya3 = *(const uint4*)(qa + 3 * a64); \
    yb0 = *(const uint4*)qb; yb1 = *(const uint4*)(qb + b64); }
#define WRITEX(st_) { u16* wa = sm + (st_) * STG + lrow * LS + lch * 8; u16* wb = wa + SA; \
    *(uint4*)wa = xa0; *(uint4*)(wa + 64 * LS) = xa1; *(uint4*)(wa + 128 * LS) = xa2; *(uint4*)(wa + 192 * LS) = xa3; \
    *(uint4*)wb = xb0; *(uint4*)(wb + 64 * LS) = xb1; }
#define WRITEY(st_) { u16* wa = sm + (st_) * STG + lrow * LS + lch * 8; u16* wb = wa + SA; \
    *(uint4*)wa = ya0; *(uint4*)(wa + 64 * LS) = ya1; *(uint4*)(wa + 128 * LS) = ya2; *(uint4*)(wa + 192 * LS) = ya3; \
    *(uint4*)wb = yb0; *(uint4*)(wb + 64 * LS) = yb1; }
#define COMPUTE(st_) { const u16* ab = sm + (st_) * STG + (wm * 64 + (lane & 31)) * LS + (lane >> 5) * 8; \
    const u16* bb = sm + (st_) * STG + SA + (wn * 64 + (lane & 31)) * LS + (lane >> 5) * 8; \
    _Pragma("unroll") for (int ks = 0; ks < 4; ks++) { \
      bf16x8 fa0 = *(const bf16x8*)(ab + ks * 16); bf16x8 fa1 = *(const bf16x8*)(ab + 32 * LS + ks * 16); \
      bf16x8 fb0 = *(const bf16x8*)(bb + ks * 16); bf16x8 fb1 = *(const bf16x8*)(bb + 32 * LS + ks * 16); \
      acc00 = __builtin_amdgcn_mfma_f32_32x32x16_bf16(fa0, fb0, acc00, 0, 0, 0); \
      acc01 = __builtin_amdgcn_mfma_f32_32x32x16_bf16(fa0, fb1, acc01, 0, 0, 0); \
      acc10 = __builtin_amdgcn_mfma_f32_32x32x16_bf16(fa1, fb0, acc10, 0, 0, 0); \
      acc11 = __builtin_amdgcn_mfma_f32_32x32x16_bf16(fa1, fb1, acc11, 0, 0, 0); } }
    LOADX(0);
    if (KT > 1) LOADY(1);
    __syncthreads();
    if (EPI == EPI_SCALE || EPI == EPI_FF1) {
      if (tid < 256) {
        const float4* pp = (const float4*)(part + (size_t)(m0 + tid) * 16);
        float4 a = pp[0], b = pp[1], c = pp[2], d = pp[3];
        float s = (a.x + a.y + a.z + a.w) + (b.x + b.y + b.z + b.w) + (c.x + c.y + c.z + c.w) + (d.x + d.y + d.z + d.w);
        sRs[tid] = rsqrtf(s * (1.0f / 1024.0f) + 1e-6f);
      }
    }
    WRITEX(0);
    if (KT > 2) LOADX(2);
    RAW_BARRIER();
    f32x16 acc00, acc01, acc10, acc11;
#pragma unroll
    for (int i = 0; i < 16; i++) { acc00[i] = 0.f; acc01[i] = 0.f; acc10[i] = 0.f; acc11[i] = 0.f; }
    for (int kt = 0; kt < KT; kt += 2) {
      if (kt + 1 < KT) WRITEY(1);
      if (kt + 3 < KT) LOADY(kt + 3);
      COMPUTE(0);
      RAW_BARRIER();
      if (kt + 1 >= KT) break;
      if (kt + 2 < KT) WRITEX(0);
      if (kt + 4 < KT) LOADX(kt + 4);
      COMPUTE(1);
      RAW_BARRIER();
    }
#undef LOADX
#undef LOADY
#undef WRITEX
#undef WRITEY
#undef COMPUTE
    const int c0 = n0 + wn * 64 + (lane & 31);
    const int c1 = c0 + 32;
    if (EPI == EPI_RES && part_unit) {
      float* xfp = p.out;
#pragma unroll
      for (int i = 0; i < 16; i++) {
        const int rl = wm * 64 + 4 * (lane >> 5) + (i & 3) + 8 * (i >> 2);
        float* r0p = xfp + (size_t)(m0 + rl) * 1024;
        float* r1p = r0p + (size_t)32 * 1024;
        atomicAdd(r0p + c0, acc00[i]); atomicAdd(r0p + c1, acc01[i]);
        atomicAdd(r1p + c0, acc10[i]); atomicAdd(r1p + c1, acc11[i]);
      }
    } else {
      gemm_epi<EPI>(p, acc00, acc01, 0, wm, wn, lane, m0, nt, c0, c1, sRs, outb, ldo, resid_in);
      gemm_epi<EPI>(p, acc10, acc11, 1, wm, wn, lane, m0, nt, c0, c1, sRs, outb, ldo, resid_in);
    }
  }
}

__device__ __forceinline__ void pool_item(const Params& p, int it) {
  const u16* P = (const u16*)(p.ws + O_P);
  u16* Y = (u16*)(p.ws + O_Y);
  float* hist = (float*)smem;
  float* dS = hist + 47 * 256;
  const int tid = threadIdx.x;
  const int col = tid & 255, hf = tid >> 8;
  const int gi = col >> 6, dd = col & 63;
  const int w = 2 << gi;
  const float* pw = p.in[9] + gi * 4096 + dd;
  const float sc = p.in[10][col];
  {
    int r0, t0, nrows, pos0;
    const float* st = nullptr;
    const float* shs = nullptr;
    if (it < 512) { r0 = it * 32; t0 = r0 & 2047; nrows = 32; pos0 = t0; }
    else { const int b = it - 512; r0 = NP + b * 4; t0 = 0; nrows = 4; pos0 = 16384; st = p.in[2] + (size_t)b * 3840; shs = p.in[3] + (size_t)b * 2560; }
    __syncthreads();
    const int nh = 15 + nrows;
#pragma unroll 8
    for (int hr = hf; hr < nh; hr += 2) {
      const int t = t0 - 15 + hr;
      float v = 0.f;
      if (t >= 0) v = bf2f(P[(size_t)(r0 - t0 + t) * 2816 + col]);
      else if (st) v = st[(15 + t) * 256 + col];
      hist[hr * 256 + col] = v;
    }
    __syncthreads();
    const int q0 = hf * 16;
    for (int q = 0; q < 16; q++) {
      const int tk = q0 + q;
      if (tk < nrows) {
        float s = 0.f;
        for (int i = 0; i < w; i++) s += hist[(15 + tk - i) * 256 + col];
        const float cnt = (float)min(w, pos0 + tk + 1);
        dS[tk * 256 + col] = s / cnt - hist[(15 + tk) * 256 + col];
      }
    }
    __syncthreads();
    float acc[16];
#pragma unroll
    for (int q = 0; q < 16; q++) acc[q] = 0.f;
    if (q0 < nrows) {
#pragma unroll 4
      for (int c = 0; c < 64; c += 4) {
        float w0 = pw[(c + 0) * 64], w1 = pw[(c + 1) * 64], w2 = pw[(c + 2) * 64], w3 = pw[(c + 3) * 64];
#pragma unroll
        for (int q = 0; q < 16; q++) {
          float4 d = *(const float4*)(dS + (q0 + q) * 256 + gi * 64 + c);
          acc[q] += d.x * w0 + d.y * w1 + d.z * w2 + d.w * w3;
        }
      }
    }
#pragma unroll
    for (int q = 0; q < 16; q++) {
      if (q0 + q < nrows) Y[(size_t)(r0 + q0 + q) * 1024 + col] = f2bf(acc[q] * sc);
    }
  }
}

__device__ __forceinline__ void pool_phase(const Params& p) {
  const u16* P = (const u16*)(p.ws + O_P);
  u16* LIN = (u16*)(p.ws + O_LIN);
  const int tid = threadIdx.x;
  const int col = tid & 255, hf = tid >> 8;
  const float mu = p.in[11][2304 + col];
  for (int it = blockIdx.x; it < 512 + 128; it += gridDim.x) {
    int r0, t0, nrows;
    const float* shs = nullptr;
    if (it < 512) { r0 = it * 32; t0 = r0 & 2047; nrows = 32; }
    else { const int b = it - 512; r0 = NP + b * 4; t0 = 0; nrows = 4; shs = p.in[3] + (size_t)b * 2560; }
    const int q0 = hf * 16;
    if (q0 < nrows) {
      const int nq = min(16, nrows - q0);
      float pv[17];
      {
        const int rowp = r0 + q0 - 1;
        float v0;
        if (t0 + q0 == 0) v0 = shs ? shs[2304 + col] : 0.f;
        else v0 = bf2f(P[(size_t)rowp * 2816 + 2560 + col]);
        pv[0] = v0;
      }
#pragma unroll
      for (int q = 0; q < 16; q++) pv[q + 1] = (q < nq) ? bf2f(P[(size_t)(r0 + q0 + q) * 2816 + 2560 + col]) : 0.f;
#pragma unroll
      for (int q = 0; q < 16; q++) {
        if (q < nq) {
          float xs = pv[q + 1] + (pv[q] - pv[q + 1]) * mu;
          float v = (col < 64) ? tanhf_(xs) : ((col < 128) ? xs : sigmoidf_(xs));
          LIN[(size_t)(r0 + q0 + q) * 256 + col] = f2bf(v);
        }
      }
    }
  }
  const int gt = blockIdx.x * 512 + tid, gs = gridDim.x * 512;
  for (int e = gt; e < 8 * 15 * 256; e += gs) {
    int b = e / 3840, r = (e / 256) % 15, c = e & 255;
    p.out[OUT_PPOOL + e] = bf2f(P[(size_t)(b * 2048 + 2033 + r) * 2816 + c]);
  }
  for (int e = gt; e < 128 * 15 * 256; e += gs) {
    int b = e / 3840, r = (e / 256) % 15, c = e & 255;
    float v;
    if (r < 11) v = p.in[2][(size_t)b * 3840 + (r + 4) * 256 + c];
    else v = bf2f(P[(size_t)(NP + b * 4 + (r - 11)) * 2816 + c]);
    p.out[OUT_SPOOL + e] = v;
  }
  for (int e = gt; e < 8 * 2560; e += gs) {
    int b = e / 2560, c = e % 2560;
    p.out[OUT_PSHIFT + e] = bf2f(P[(size_t)(b * 2048 + 2047) * 2816 + 256 + c]);
  }
  for (int e = gt; e < 128 * 2560; e += gs) {
    int b = e / 2560, c = e % 2560;
    p.out[OUT_SSHIFT + e] = bf2f(P[(size_t)(NP + b * 4 + 3) * 2816 + 256 + c]);
  }
}

__device__ __forceinline__ void rwkv_prep_phase(const Params& p) {
  const u16* P = (const u16*)(p.ws + O_P);
  u16* APRE = (u16*)(p.ws + O_APRE);
  u16* WPRE = (u16*)(p.ws + O_WPRE);
  float* SC = (float*)(p.ws + O_BS);
  const int lane = threadIdx.x & 63, wave = __builtin_amdgcn_readfirstlane(threadIdx.x >> 6);
  for (int row = blockIdx.x * 8 + wave; row < MT; row += gridDim.x * 8) {
    const u16* Pr = P + (size_t)row * 2816 + 256;
#pragma unroll 12
    for (int h = 0; h < 12; h++) {
      const int ch = h * 64 + lane;
      float pr = bf2f(Pr[ch]), pk = bf2f(Pr[768 + ch]);
      float qr = prevP(p, P, row, ch), qk = prevP(p, P, row, 768 + ch);
      float wl = p.in[12][ch] + bf2f(WPRE[(size_t)row * 768 + ch]);
      float r = pr + (qr - pr) * p.in[11][ch], k = pk + (qk - pk) * p.in[11][768 + ch];
      float a = sigmoidf_(p.in[14][ch] + bf2f(APRE[(size_t)row * 768 + ch]));
      a = bf2f(f2bf(a));
      float omd = 1.0f - __expf(-0.6065306597126334f * sigmoidf_(wl));
      float kkr = k * p.in[17][ch];
      float n2 = wsum64(kkr * kkr);
      float inv = frcp_(fmaxf(__builtin_amdgcn_sqrtf(n2), 1e-12f));
      float kap = kkr * inv;
      float kp = k * (1.0f + (a - 1.0f) * p.in[18][ch]);
      float al = kap * a;
      float ar = wsum64(al * r);
      float kr = wsum64(kp * r);
      float bsum = wsum64(r * kp * p.in[19][ch]);
      APRE[(size_t)row * 768 + ch] = f2bf(a);
      WPRE[(size_t)row * 768 + ch] = f2bf(omd);
      if (lane == 0) *(float4*)(SC + ((size_t)row * 12 + h) * 4) = make_float4(ar, kr, bsum, inv);
    }
  }
}

constexpr int TC = 16;
typedef float v2f __attribute__((ext_vector_type(2)));
typedef float v4f __attribute__((ext_vector_type(4)));

struct StRaw {
  unsigned cr[2], ck[2], cv[2];
  unsigned qr[2], qk[2], qv[2];
  unsigned wp[2], ap[2];
  float inv[2], sc2[2];
  v2f s_r, s_k, s_v;
  float m;
};
struct StConst { v2f mur, muk, muv, kk_, ka_; };

__device__ __forceinline__ v2f bfpair(unsigned u) {
  v2f r;
  r.x = __uint_as_float(u << 16);
  r.y = __uint_as_float(u & 0xffff0000u);
  return r;
}

template <bool SAMPLE>
__device__ __forceinline__ void st_load(const Params& p, StRaw& R, int row0, int b, int h, int c, int sw, int lane) {
  const u16* P = (const u16*)(p.ws + O_P);
  const u16* WPRE = (const u16*)(p.ws + O_WPRE);
  const u16* APRE = (const u16*)(p.ws + O_APRE);
  const float* SC = (const float*)(p.ws + O_BS);
  const int l2 = lane & 31, tp = lane >> 5;
  const int ch = h * 64 + 2 * l2;
  const int t0 = c * TC + sw * 4;
  R.m = (t0 + tp == 0) ? 0.f : 1.f;
  if (SAMPLE) {
    const float* sp = p.in[3] + (size_t)b * 2560 + ch;
    R.s_r = *(const v2f*)sp; R.s_k = *(const v2f*)(sp + 768); R.s_v = *(const v2f*)(sp + 1536);
  }
#pragma unroll
  for (int ps = 0; ps < 2; ps++) {
    const int t = t0 + 2 * ps + tp;
    const int tq = t > 0 ? t - 1 : 0;
    const u16* Pc = P + (size_t)(row0 + t) * 2816 + 256 + ch;
    const u16* Pq = P + (size_t)(row0 + tq) * 2816 + 256 + ch;
    R.cr[ps] = *(const unsigned*)Pc; R.ck[ps] = *(const unsigned*)(Pc + 768); R.cv[ps] = *(const unsigned*)(Pc + 1536);
    R.qr[ps] = *(const unsigned*)Pq; R.qk[ps] = *(const unsigned*)(Pq + 768); R.qv[ps] = *(const unsigned*)(Pq + 1536);
    const size_t row = row0 + t;
    R.wp[ps] = *(const unsigned*)(WPRE + row * 768 + ch);
    R.ap[ps] = *(const unsigned*)(APRE + row * 768 + ch);
    R.inv[ps] = SC[(row * 12 + h) * 4 + 3];
    R.sc2[ps] = SC[(row * 12 + h) * 4 + (lane & 1)];
  }
}

template <bool SAMPLE>
__device__ __forceinline__ void st_compute(const StConst& K, const StRaw& R, int sw, int lane, float* ops, float* scal) {
  const int l2 = lane & 31, tp = lane >> 5;
#pragma unroll
  for (int ps = 0; ps < 2; ps++) {
    const int tt = sw * 4 + 2 * ps + tp;
    v2f pr = bfpair(R.cr[ps]), pk = bfpair(R.ck[ps]), pv = bfpair(R.cv[ps]);
    v2f qr = bfpair(R.qr[ps]), qk = bfpair(R.qk[ps]), qv = bfpair(R.qv[ps]);
    if (ps == 0) {
      if (SAMPLE) { if (R.m == 0.f) { qr = R.s_r; qk = R.s_k; qv = R.s_v; } }
      else { const v2f mm = {R.m, R.m}; qr *= mm; qk *= mm; qv *= mm; }
    }
    const v2f r = pr + (qr - pr) * K.mur;
    const v2f k = pk + (qk - pk) * K.muk;
    const v2f v = pv + (qv - pv) * K.muv;
    const v2f one = {1.0f, 1.0f};
    const v2f dec = one - bfpair(R.wp[ps]);
    const v2f a = bfpair(R.ap[ps]);
    const v2f iv = {R.inv[ps], R.inv[ps]};
    const v2f kap = k * K.kk_ * iv;
    const v2f kp = k * (one + (a - one) * K.ka_);
    float* o6 = ops + tt * 384 + 2 * l2;
    *(v2f*)(o6) = dec; *(v2f*)(o6 + 64) = kap * a; *(v2f*)(o6 + 128) = kp; *(v2f*)(o6 + 192) = kap; *(v2f*)(o6 + 256) = dec * r; *(v2f*)(o6 + 320) = v;
    if (l2 < 2) scal[tt * 2 + l2] = R.sc2[ps];
  }
}

struct ScD { v4f a0, a1, q0, q1; };
struct ScU { v4f w0, w1, l0, l1, k0, k1; float v; v2f sc; };
__device__ __forceinline__ void scd_load(ScD& O, const float* o6, int j8) {
  O.a0 = *(const v4f*)(o6 + 192 + j8); O.a1 = *(const v4f*)(o6 + 192 + j8 + 4);
  O.q0 = *(const v4f*)(o6 + 256 + j8); O.q1 = *(const v4f*)(o6 + 256 + j8 + 4);
}
__device__ __forceinline__ void scu_load(ScU& O, const float* o6, const float* sb, int tt, int j8, int srow) {
  O.w0 = *(const v4f*)(o6 + j8); O.w1 = *(const v4f*)(o6 + j8 + 4);
  O.l0 = *(const v4f*)(o6 + 64 + j8); O.l1 = *(const v4f*)(o6 + 64 + j8 + 4);
  O.k0 = *(const v4f*)(o6 + 128 + j8); O.k1 = *(const v4f*)(o6 + 128 + j8 + 4);
  O.v = o6[320 + srow];
  O.sc = *(const v2f*)(sb + tt * 2);
}
__device__ __forceinline__ void sc_step(const ScD& D, const ScU& U, v2f& s0, v2f& s1, v2f& s2, v2f& s3, float* obuf, int tt, int lane) {
  v2f pd2 = s0 * D.a0.lo;
  v2f qd2 = s0 * D.q0.lo;
  pd2 = s1 * D.a0.hi + pd2; qd2 = s1 * D.q0.hi + qd2;
  pd2 = s2 * D.a1.lo + pd2; qd2 = s2 * D.q1.lo + qd2;
  pd2 = s3 * D.a1.hi + pd2; qd2 = s3 * D.q1.hi + qd2;
  float pd = reduce8(pd2.x + pd2.y);
  float qd = reduce8(qd2.x + qd2.y);
  const float v = U.v;
  const float o = qd - pd * U.sc.x + v * U.sc.y;
  const v2f vv = {v, v};
  const v2f np = {-pd, -pd};
  s0 = s0 * U.w0.lo + (np * U.l0.lo + vv * U.k0.lo);
  s1 = s1 * U.w0.hi + (np * U.l0.hi + vv * U.k0.hi);
  s2 = s2 * U.w1.lo + (np * U.l1.lo + vv * U.k1.lo);
  s3 = s3 * U.w1.hi + (np * U.l1.hi + vv * U.k1.hi);
  obuf[tt * 8 + (lane >> 3)] = o;
}

template <int STEPS>
__device__ __forceinline__ void scan_steps(v2f& s0, v2f& s1, v2f& s2, v2f& s3, const float* ob, const float* sb, int j8, int srow,
                                           float* obuf, int lane) {
  ScD A, B, C;
  ScU P, Q;
  scd_load(A, ob, j8);
  scu_load(P, ob, sb, 0, j8, srow);
  scd_load(B, ob + 384, j8);
#define SC_STEP(DX_, DZ_, UX_, UZ_, tt_) { \
    if ((tt_) + 1 < STEPS) scu_load(UZ_, ob + ((tt_) + 1) * 384, sb, (tt_) + 1, j8, srow); \
    if ((tt_) + 2 < STEPS) scd_load(DZ_, ob + ((tt_) + 2) * 384, j8); \
    asm volatile("" ::: "memory"); sc_step(DX_, UX_, s0, s1, s2, s3, obuf, (tt_), lane); asm volatile("" ::: "memory"); }
  SC_STEP(A, C, P, Q, 0) SC_STEP(B, A, Q, P, 1) SC_STEP(C, B, P, Q, 2) SC_STEP(A, C, Q, P, 3)
  if (STEPS > 4) {
    SC_STEP(B, A, P, Q, 4) SC_STEP(C, B, Q, P, 5) SC_STEP(A, C, P, Q, 6) SC_STEP(B, A, Q, P, 7)
    SC_STEP(C, B, P, Q, 8) SC_STEP(A, C, Q, P, 9) SC_STEP(B, A, P, Q, 10) SC_STEP(C, B, Q, P, 11)
    SC_STEP(A, C, P, Q, 12) SC_STEP(B, A, Q, P, 13) SC_STEP(C, B, P, Q, 14) SC_STEP(A, C, Q, P, 15)
  }
#undef SC_STEP
}

__device__ __forceinline__ void scan_phase(const Params& p, int cidx, int task_lo, int task_hi) {
  float* ops = (float*)smem;
  float* scal = ops + 2 * TC * 384;
  float* obufs = scal + 2 * TC * 2;
  u16* Y = (u16*)(p.ws + O_Y);
  int* counter = (int*)(p.ws + O_CNT) + cidx;
  const int tid = threadIdx.x, lane = tid & 63, wave = __builtin_amdgcn_readfirstlane(tid >> 6);
  {
    if (tid < 4) s_simdcnt[tid] = 0;
    __syncthreads();
    if (lane == 0) {
      const int simd = (int)__builtin_amdgcn_s_getreg(2308) & 3;
      const int r = atomicAdd(&s_simdcnt[simd], 1);
      s_role[wave] = simd | (r << 4);
    }
    __syncthreads();
    if (tid == 0) {
      int ns = 0;
      for (int w = 0; w < 8; w++) ns += ((s_role[w] >> 4) == 0);
      int st = 0;
      for (int w = 0; w < 8; w++) {
        int v;
        if (ns == 4) v = ((s_role[w] >> 4) == 0) ? (s_role[w] & 3) : (4 + st++);
        else v = w;
        s_role2[w] = v;
      }
    }
    __syncthreads();
  }
  const int rolew = __builtin_amdgcn_readfirstlane(s_role2[wave]);
  const bool stat = (gridDim.x == 256 && task_lo == 0);
  bool first = true;
  while (true) {
    __syncthreads();
    if (tid == 0) s_task = (stat && first && blockIdx.x < 192) ? -1 : atomicAdd(counter, 1);
    __syncthreads();
    const int tq = __builtin_amdgcn_readfirstlane(s_task);
    first = false;
    const int task = (tq < 0) ? ((int)(blockIdx.x & 7) * 24 + (int)(blockIdx.x >> 3)) : (tq + (stat ? 192 : task_lo));
    if (task >= task_hi) break;
    int b, h, half, row0, T;
    bool sample;
    if (task < 192) { b = task / 24; h = (task % 24) >> 1; half = task & 1; row0 = b * 2048; T = 2048; sample = false; }
    else { int u = task - 192; b = u / 24; h = (u % 24) >> 1; half = u & 1; row0 = NP + b * 4; T = 4; sample = true; }
    const int nch = (T + TC - 1) / TC;
    const int sbase = half * 32 + (rolew & 3) * 8;
    const int srow = sbase + (lane >> 3);
    const int j8 = (lane & 7) * 8;
    float* obuf = obufs + (rolew & 3) * 128;
    if (rolew < 4) {
      v2f s0 = {0.f, 0.f}, s1 = s0, s2 = s0, s3 = s0;
      if (sample) {
        const float* sp = p.in[4] + ((size_t)(b * 12 + h) * 64 + srow) * 64 + j8;
        v4f x0 = *(const v4f*)sp, x1 = *(const v4f*)(sp + 4);
        s0 = x0.lo; s1 = x0.hi; s2 = x1.lo; s3 = x1.hi;
      }
      RAW_BARRIER();
      for (int c = 0; c < nch; c++) {
        const int buf = c & 1;
        const float* ob = ops + buf * TC * 384;
        const float* sb = scal + buf * TC * 2;
        if (sample) scan_steps<4>(s0, s1, s2, s3, ob, sb, j8, srow, obuf, lane);
        else scan_steps<TC>(s0, s1, s2, s3, ob, sb, j8, srow, obuf, lane);
        const int tt = lane >> 2, pr = lane & 3;
        if (tt < T) {
          v2f ov = *(const v2f*)(obuf + tt * 8 + 2 * pr);
          unsigned pk = (unsigned)f2bf(ov.x) | ((unsigned)f2bf(ov.y) << 16);
          *(unsigned*)(Y + (size_t)(row0 + c * TC + tt) * 1024 + 256 + h * 64 + sbase + 2 * pr) = pk;
        }
        RAW_BARRIER();
      }
      float* dp = p.out + (sample ? OUT_SWKV : OUT_PWKV) + ((size_t)(b * 12 + h) * 64 + srow) * 64 + j8;
      *(float4*)dp = make_float4(s0.x, s0.y, s1.x, s1.y);
      *(float4*)(dp + 4) = make_float4(s2.x, s2.y, s3.x, s3.y);
    } else {
      const int sw = rolew - 4;
      const int ch = h * 64 + 2 * (lane & 31);
      StConst K;
      K.mur = *(const v2f*)(p.in[11] + ch); K.muk = *(const v2f*)(p.in[11] + 768 + ch); K.muv = *(const v2f*)(p.in[11] + 1536 + ch);
      K.kk_ = *(const v2f*)(p.in[17] + ch); K.ka_ = *(const v2f*)(p.in[18] + ch);
      if (sample) {
        if (sw == 0) {
          StRaw RS;
          st_load<true>(p, RS, row0, b, h, 0, 0, lane);
          st_compute<true>(K, RS, 0, lane, ops, scal);
        }
        RAW_BARRIER();
        RAW_BARRIER();
      } else {
        StRaw RA, RB;
        st_load<false>(p, RA, row0, b, h, 0, sw, lane);
        st_compute<false>(K, RA, sw, lane, ops, scal);
        st_load<false>(p, RA, row0, b, h, 1, sw, lane);
        st_load<false>(p, RB, row0, b, h, 2, sw, lane);
        RAW_BARRIER();
        for (int c = 0; c < nch; c += 2) {
          st_compute<false>(K, RA, sw, lane, ops + TC * 384, scal + TC * 2);
          st_load<false>(p, RA, row0, b, h, (c + 3 < nch) ? c + 3 : c + 1, sw, lane);
          RAW_BARRIER();
          st_compute<false>(K, RB, sw, lane, ops, scal);
          st_load<false>(p, RB, row0, b, h, (c + 4 < nch) ? c + 4 : c + 2 < nch ? c + 2 : c, sw, lane);
          RAW_BARRIER();
        }
      }
    }
  }
}

__device__ __forceinline__ void pool_queue(const Params& p) {
  int* counter = (int*)(p.ws + O_CNT) + 2;
  while (true) {
    __syncthreads();
    if (threadIdx.x == 0) s_task = atomicAdd(counter, 1);
    __syncthreads();
    const int it = __builtin_amdgcn_readfirstlane(s_task);
    if (it >= 640) break;
    pool_item(p, it);
  }
}

__device__ __forceinline__ void mix1_phase(const Params& p) {
  const u16* Q = (const u16*)(p.ws + O_P);
  u16* Y = (u16*)(p.ws + O_Y);
  const u16* WM = (const u16*)(p.ws + O_WM);
  const int tid = threadIdx.x, lane = tid & 63, wave = tid >> 6;
  constexpr int N_GP = 512, N_GS = 128, N_LRU = MT / 16;
  for (int it = blockIdx.x; it < N_GP + N_GS + N_LRU; it += gridDim.x) {
    __syncthreads();
    if (it < N_GP) {
      const int h = it & 3, ck = (it >> 2) & 15, b = it >> 6;
      const int r0 = b * 2048 + ck * 128;
      u16* vT = (u16*)smem;
      {
        const u16* qb = Q + (size_t)(r0 + wave * 16) * 2048 + 512 + lane * 8;
        float lg[8], lb[8];
        if ((lane >> 4) == h) {
#pragma unroll
          for (int e = 0; e < 8; e++) { lg[e] = p.in[25][h * 128 + (lane & 15) * 8 + e]; lb[e] = p.in[26][h * 128 + (lane & 15) * 8 + e]; }
        } else {
#pragma unroll
          for (int e = 0; e < 8; e++) { lg[e] = 0.f; lb[e] = 0.f; }
        }
        uint4 cur0 = *(const uint4*)(qb), cur1 = *(const uint4*)(qb + 2048), cur2 = *(const uint4*)(qb + 2 * 2048), cur3 = *(const uint4*)(qb + 3 * 2048);
        for (int bt = 0; bt < 4; bt++) {
          uint4 nx0 = cur0, nx1 = cur1, nx2 = cur2, nx3 = cur3;
          if (bt < 3) {
            const u16* qn = qb + (size_t)(bt + 1) * 4 * 2048;
            nx0 = *(const uint4*)(qn); nx1 = *(const uint4*)(qn + 2048); nx2 = *(const uint4*)(qn + 2 * 2048); nx3 = *(const uint4*)(qn + 3 * 2048);
          }
#pragma unroll
          for (int u = 0; u < 4; u++) {
            const uint4 raw = (u == 0) ? cur0 : (u == 1) ? cur1 : (u == 2) ? cur2 : cur3;
            const int j = wave * 16 + bt * 4 + u;
            const u16* rp = (const u16*)&raw;
            float z[8];
            float sm = 0.f;
#pragma unroll
            for (int e = 0; e < 8; e++) { z[e] = geluf_(bf2f(rp[e])); sm += z[e]; }
            const float mean = wsum64(sm) * (1.0f / 512.0f);
            float s2 = 0.f;
#pragma unroll
            for (int e = 0; e < 8; e++) { z[e] -= mean; s2 += z[e] * z[e]; }
            const float rstd = rsqrtf(wsum64(s2) * (1.0f / 512.0f) + 1e-5f);
            if ((lane >> 4) == h) {
#pragma unroll
              for (int e = 0; e < 8; e++) {
                const int d = (lane & 15) * 8 + e;
                vT[d * 136 + j] = f2bf(z[e] * rstd * lg[e] + lb[e]);
              }
            }
          }
          cur0 = nx0; cur1 = nx1; cur2 = nx2; cur3 = nx3;
        }
      }
      __syncthreads();
      const int wm = wave >> 1, wn = wave & 1;
      f32x16 acc0, acc1;
#pragma unroll
      for (int i = 0; i < 16; i++) { acc0[i] = 0.f; acc1[i] = 0.f; }
      const u16* ag = WM + (size_t)h * 16384 + (size_t)(wm * 32 + (lane & 31)) * 128 + (lane >> 5) * 8;
      const u16* bb = vT + (wn * 64 + (lane & 31)) * 136 + (lane >> 5) * 8;
      const int nks = 2 * (wm + 1);
      for (int ks = 0; ks < nks; ks++) {
        bf16x8 a = *(const bf16x8*)(ag + ks * 16);
        bf16x8 b0 = *(const bf16x8*)(bb + ks * 16);
        bf16x8 b1 = *(const bf16x8*)(bb + 32 * 136 + ks * 16);
        acc0 = __builtin_amdgcn_mfma_f32_32x32x16_bf16(a, b0, acc0, 0, 0, 0);
        acc1 = __builtin_amdgcn_mfma_f32_32x32x16_bf16(a, b1, acc1, 0, 0, 0);
      }
      const int d0 = h * 128 + wn * 64 + (lane & 31), d1 = d0 + 32;
#pragma unroll 4
      for (int i = 0; i < 16; i++) {
        const int il = wm * 32 + (i & 3) + 8 * (i >> 2) + 4 * (lane >> 5);
        const int row = r0 + il;
        const float bsv = p.in[28][h * 128 + il];
        float u0 = geluf_(bf2f(Q[(size_t)row * 2048 + d0]));
        float u1 = geluf_(bf2f(Q[(size_t)row * 2048 + d1]));
        Y[(size_t)row * 1024 + d0] = f2bf(u0 * (acc0[i] + bsv));
        Y[(size_t)row * 1024 + d1] = f2bf(u1 * (acc1[i] + bsv));
      }
    } else if (it < N_GP + N_GS) {
      const int b = it - N_GP;
      const int r0 = NP + b * 4;
      float* vs = (float*)smem;
      if (wave < 4) {
        const int row = r0 + wave;
        uint4 raw = *(const uint4*)(Q + (size_t)row * 2048 + 512 + lane * 8);
        const u16* rp = (const u16*)&raw;
        float z[8];
        float s = 0.f;
#pragma unroll
        for (int e = 0; e < 8; e++) { z[e] = geluf_(bf2f(rp[e])); s += z[e]; }
        const float mean = wsum64(s) * (1.0f / 512.0f);
        float s2 = 0.f;
#pragma unroll
        for (int e = 0; e < 8; e++) { z[e] -= mean; s2 += z[e] * z[e]; }
        const float rstd = rsqrtf(wsum64(s2) * (1.0f / 512.0f) + 1e-5f);
#pragma unroll
        for (int e = 0; e < 8; e++) {
          const int d = lane * 8 + e;
          float vn = z[e] * rstd * p.in[25][d] + p.in[26][d];
          vs[wave * 512 + d] = vn;
          p.out[OUT_SGV + (size_t)(b * 4 + wave) * 512 + d] = vn;
        }
      }
      __syncthreads();
      {
        const int ch = tid, hh = ch >> 7;
        for (int i = 0; i < 4; i++) {
          float mix = p.in[28][hh * 128 + i];
          for (int j = 0; j <= i; j++) mix += p.in[27][(size_t)(hh * 128 + i) * 128 + j] * vs[j * 512 + ch];
          float u = geluf_(bf2f(Q[(size_t)(r0 + i) * 2048 + ch]));
          Y[(size_t)(r0 + i) * 1024 + ch] = f2bf(u * mix);
        }
      }
    } else {
      const int li = it - N_GP - N_GS;
      const int r0 = li * 16;
      u16* xcb = (u16*)smem;
      float* gxs = (float*)(smem + 16 * 520 * 2);
      float* gas = gxs + 16 * 512;
      const int ch = tid;
      float* CA = (float*)(p.ws + O_CA);
      float* HL = (float*)(p.ws + O_HL);
      float* SEG = (float*)(p.ws + O_SEG);
      const float cw0 = p.in[29][ch], cw1 = p.in[29][512 + ch], cw2 = p.in[29][1024 + ch], cw3 = p.in[29][1536 + ch];
      const float cb = p.in[30][ch];
      {
        float xr[19];
#pragma unroll
        for (int q = 0; q < 19; q++) {
          const int row = r0 - 3 + q;
          float v = 0.f;
          bool valid;
          int tq;
          if (r0 < NP) { tq = (r0 & 2047) - 3 + q; valid = tq >= 0; }
          else { valid = true; tq = 0; }
          if (r0 < NP) { if (valid) v = bf2f(Q[(size_t)row * 2048 + 1536 + ch]); }
          else v = bf2f(Q[(size_t)(row < NP ? NP : row) * 2048 + 1536 + ch]);
          xr[q] = v;
        }
#pragma unroll
        for (int q = 0; q < 16; q++) {
          float x0 = xr[q], x1 = xr[q + 1], x2 = xr[q + 2], x3 = xr[q + 3];
          if (r0 >= NP) {
            const int rs = r0 - NP + q;
            const int t = rs & 3;
            const float* st = p.in[5] + (size_t)(rs >> 2) * 1536 + ch;
            if (t < 3) x0 = st[t * 512];
            if (t < 2) x1 = st[(t + 1) * 512];
            if (t < 1) x2 = st[(t + 2) * 512];
          }
          const float xc = cb + cw0 * x0 + cw1 * x1 + cw2 * x2 + cw3 * x3;
          xcb[q * 520 + ch] = f2bf(xc);
        }
      }
      __syncthreads();
      {
        const u16* WXT = (const u16*)(p.ws + O_WXT);
        const int n = wave;
        typedef __attribute__((ext_vector_type(4))) float f32x4;
        f32x4 ac[8];
#pragma unroll
        for (int i = 0; i < 8; i++) { ac[i][0] = 0.f; ac[i][1] = 0.f; ac[i][2] = 0.f; ac[i][3] = 0.f; }
#pragma unroll
        for (int kh = 0; kh < 2; kh++) {
          const bf16x8 af = *(const bf16x8*)(xcb + (lane & 15) * 520 + n * 64 + kh * 32 + (lane >> 4) * 8);
          bf16x8 bfr[8];
#pragma unroll
          for (int i = 0; i < 8; i++) {
            const int w = i >> 2, dt = i & 3;
            bfr[i] = *(const bf16x8*)(WXT + ((size_t)((w * 8 + n) * 64 + dt * 16 + (lane & 15))) * 64 + kh * 32 + (lane >> 4) * 8);
          }
#pragma unroll
          for (int i = 0; i < 8; i++) ac[i] = __builtin_amdgcn_mfma_f32_16x16x32_bf16(af, bfr[i], ac[i], 0, 0, 0);
        }
#pragma unroll
        for (int i = 0; i < 8; i++) {
          const int w = i >> 2, dt = i & 3;
          float* dst = (w ? gas : gxs) + n * 64 + dt * 16 + (lane & 15);
#pragma unroll
          for (int r = 0; r < 4; r++) dst[((lane >> 4) * 4 + r) * 512] = ac[i][r];
        }
      }
      __syncthreads();
      const float bx = p.in[32][ch], ba = p.in[34][ch];
      const float lam = p.in[35][ch];
      const float spl = fmaxf(-lam, 0.f) + log1pf(__expf(-fabsf(lam)));
      float hl = 0.f, ca = 1.f;
#pragma unroll 4
      for (int q = 0; q < 16; q++) {
        const int row = r0 + q;
        if (row >= NP) {
          int rs = row - NP;
          if ((rs & 3) == 0) { hl = p.in[6][(size_t)(rs >> 2) * 512 + ch]; ca = 1.f; }
        }
        float gx = sigmoidf_(gxs[q * 512 + ch] + bx), ga = sigmoidf_(gas[q * 512 + ch] + ba);
        float la = -8.0f * ga * spl;
        float a = __expf(la);
        float bb = __builtin_amdgcn_sqrtf(fmaxf(1.0f - a * a, 0.f)) * gx * bf2f(xcb[q * 520 + ch]);
        hl = a * hl + bb;
        ca = ca * a;
        CA[(size_t)row * 512 + ch] = ca;
        HL[(size_t)row * 512 + ch] = hl;
      }
      SEG[(size_t)li * 1024 + ch] = ca;
      SEG[(size_t)li * 1024 + 512 + ch] = hl;
    }
  }
}

__device__ __forceinline__ void lru_fix_phase(const Params& p, const XcdBarrier& xb) {
  const u16* Q = (const u16*)(p.ws + O_P);
  u16* Y = (u16*)(p.ws + O_Y);
  const float* CA = (const float*)(p.ws + O_CA);
  const float* HL = (const float*)(p.ws + O_HL);
  const float* SEG = (const float*)(p.ws + O_SEG);
  const int ch = threadIdx.x;
  const bool blocked = (gridDim.x == 256);
  for (int k = 0; k < (blocked ? 1 : 0); k++) {
    const int li0 = blockIdx.x * 4;
    const int b = li0 >> 7, s0 = li0 & 127;
    const float* sg = SEG + (size_t)(b * 128) * 1024 + ch;
    float carry = 0.f;
#pragma unroll 8
    for (int q = 0; q < s0; q++) carry = sg[(size_t)q * 1024] * carry + sg[(size_t)q * 1024 + 512];
    for (int u = 0; u < 4; u++) {
      const int li = li0 + u;
      const int r0 = li * 16;
#pragma unroll 8
      for (int q = 0; q < 16; q++) {
        const int row = r0 + q;
        float hv = HL[(size_t)row * 512 + ch] + CA[(size_t)row * 512 + ch] * carry;
        float gate = geluf_(bf2f(Q[(size_t)row * 2048 + 1024 + ch]));
        Y[(size_t)row * 1024 + 512 + ch] = f2bf(hv * gate);
        if ((row & 2047) == 2047) p.out[OUT_PLRU + (size_t)(row >> 11) * 512 + ch] = hv;
      }
      carry = sg[(size_t)(s0 + u) * 1024] * carry + sg[(size_t)(s0 + u) * 1024 + 512];
    }
  }
  for (int li = (blocked ? 1024 : 0) + blockIdx.x; li < MT / 16; li += gridDim.x) {
    const int r0 = li * 16;
    float carry = 0.f;
    if (r0 < NP) {
      const int b = r0 >> 11, sN = (r0 & 2047) >> 4;
      const float* sg = SEG + (size_t)(b * 128) * 1024 + ch;
      for (int q = 0; q < sN; q++) carry = sg[(size_t)q * 1024] * carry + sg[(size_t)q * 1024 + 512];
    }
#pragma unroll 8
    for (int q = 0; q < 16; q++) {
      const int row = r0 + q;
      float hv = HL[(size_t)row * 512 + ch] + CA[(size_t)row * 512 + ch] * carry;
      float gate = geluf_(bf2f(Q[(size_t)row * 2048 + 1024 + ch]));
      Y[(size_t)row * 1024 + 512 + ch] = f2bf(hv * gate);
      if (row < NP) {
        if ((row & 2047) == 2047) p.out[OUT_PLRU + (size_t)(row >> 11) * 512 + ch] = hv;
      } else {
        int rs = row - NP;
        if ((rs & 3) == 3) p.out[OUT_SLRU + (size_t)(rs >> 2) * 512 + ch] = hv;
      }
    }
  }
  const int gt = blockIdx.x * 512 + threadIdx.x, gs = gridDim.x * 512;
  for (int e = gt; e < 8 * 3 * 512; e += gs) {
    int b = e / 1536, i = (e / 512) % 3, c = e & 511;
    p.out[OUT_PCONV + e] = bf2f(Q[(size_t)(b * 2048 + 2045 + i) * 2048 + 1536 + c]);
  }
  for (int e = gt; e < 128 * 3 * 512; e += gs) {
    int b = e / 1536, i = (e / 512) % 3, c = e & 511;
    p.out[OUT_SCONV + e] = bf2f(Q[(size_t)(NP + b * 4 + 1 + i) * 2048 + 1536 + c]);
  }
}

__device__ __forceinline__ void res_fix_phase(const Params& p) {
  u16* xb = (u16*)(p.ws + O_XB);
  float* part = (float*)(p.ws + O_PART);
  const int lane = threadIdx.x & 63, wave = threadIdx.x >> 6;
  for (int row = NP + blockIdx.x * 8 + wave; row < MT; row += gridDim.x * 8) {
    const float* xr = p.out + (size_t)row * 1024;
    float ss = 0.f;
#pragma unroll
    for (int i = 0; i < 4; i++) {
      float4 v = *(const float4*)(xr + i * 256 + lane * 4);
      ss += v.x * v.x + v.y * v.y + v.z * v.z + v.w * v.w;
      ushort4 o;
      o.x = f2bf(v.x); o.y = f2bf(v.y); o.z = f2bf(v.z); o.w = f2bf(v.w);
      *(ushort4*)(xb + (size_t)row * 1024 + i * 256 + lane * 4) = o;
    }
    ss = wsum64(ss);
    if (lane < 16) part[(size_t)row * 16 + lane] = (lane == 0) ? ss : 0.f;
  }
}

__device__ __forceinline__ void final_phase(const Params& p) {
  const float* part = (const float*)(p.ws + O_PART);
  const float* g = p.in[40];
  const int lane = threadIdx.x & 63, wave = threadIdx.x >> 6;
  for (int row = blockIdx.x * 8 + wave; row < MT; row += gridDim.x * 8) {
    float s = (lane < 16) ? part[(size_t)row * 16 + lane] : 0.f;
    s = wsum64(s);
    const float rs = rsqrtf(s * (1.0f / 1024.0f) + 1e-6f);
    float* xr = p.out + (size_t)row * 1024;
#pragma unroll
    for (int i = 0; i < 4; i++) {
      float4 v = *(float4*)(xr + i * 256 + lane * 4);
      float4 gg = *(const float4*)(g + i * 256 + lane * 4);
      v.x *= rs * gg.x; v.y *= rs * gg.y; v.z *= rs * gg.z; v.w *= rs * gg.w;
      *(float4*)(xr + i * 256 + lane * 4) = v;
    }
  }
}


constexpr int NPHASE = 22;
enum { K_P0 = 0, K_G_SCALE, K_G_PLAIN, K_G_FF1, K_G_RES, K_G_POST, K_POOL, K_SCAN, K_MIX1, K_LRUFIX, K_FINAL };

#define PH(n, sync_) if (plo <= (n) && (n) <= phi) { if ((n) > plo && (sync_)) { if ((n) == 1) { grid.sync(); xb = xcd_barrier_post((unsigned*)(ws + O_XBAR), (volatile LAS unsigned*)&xb_words); } else xcd_barrier(xb); }
#define PHEND }
#define WSB(o) ((const u16*)(ws + (o)))
#define WSO(o) ((u16*)(ws + (o)))
__global__ void __launch_bounds__(512) mega(Params p, int plo, int phi) {
  cg::grid_group grid = cg::this_grid();
  char* ws = p.ws;
  __shared__ uint4 xb_words;
  if (threadIdx.x == 0) xb_words = make_uint4(0u, 0u, 0u, 0u);
  __syncthreads();
  XcdBarrier xb; xb.bar = (unsigned*)(ws + O_XBAR); xb.x = 0; xb.st = (volatile LAS unsigned*)&xb_words;
  PH(0, 1) phase0(p); PHEND
  PH(1, 1) gemm_phase<EPI_SCALE>(p, WSB(O_XB), 1024, WSB(O_WIN0), 1024, 1024, 2816, WSO(O_P), 2816, 0, 0); PHEND
  PH(2, 1) pool_phase(p); PHEND
  PH(3, 1) gemm_phase<EPI_PLAIN>(p, WSB(O_LIN), 256, WSB(O_WLW), 64, 64, 768, WSO(O_WPRE), 768, 0, 0); PHEND
  PH(4, 0) gemm_phase<EPI_PLAIN>(p, WSB(O_LIN + 128), 256, WSB(O_WLA), 64, 64, 768, WSO(O_APRE), 768, 0, 140); PHEND
  PH(5, 1) rwkv_prep_phase(p); PHEND
  PH(6, 1) scan_phase(p, 0, 0, 3264); pool_queue(p); PHEND
  PH(7, 1) gemm_phase<EPI_POST>(p, WSB(O_LIN + 256), 256, WSB(O_WLG), 128, 128, 768, nullptr, 0, 0, 0); PHEND
  PH(8, 1) gemm_phase<EPI_RES>(p, WSB(O_Y), 1024, WSB(O_WOUT0), 1024, 1024, 1024, WSO(O_XB), 1024, 1, 0); PHEND
  PH(9, 1) res_fix_phase(p); PHEND
  PH(10, 1) gemm_phase<EPI_FF1>(p, WSB(O_XB), 1024, WSB(O_WF10), 1024, 1024, 4096, WSO(O_H), 4096, 0, 0); PHEND
  PH(11, 1) gemm_phase<EPI_RES>(p, WSB(O_H), 4096, WSB(O_WF20), 4096, 4096, 1024, WSO(O_XB), 1024, 0, 0); PHEND
  PH(12, 1) res_fix_phase(p); PHEND
  PH(13, 1) gemm_phase<EPI_SCALE>(p, WSB(O_XB), 1024, WSB(O_WIN1), 1024, 1024, 2048, WSO(O_P), 2048, 0, 0); PHEND
  PH(14, 1) mix1_phase(p); PHEND
  PH(15, 1) lru_fix_phase(p, xb); PHEND
  PH(16, 1) gemm_phase<EPI_RES>(p, WSB(O_Y), 1024, WSB(O_WOUT1), 1024, 1024, 1024, WSO(O_XB), 1024, 0, 0); PHEND
  PH(17, 1) res_fix_phase(p); PHEND
  PH(18, 1) gemm_phase<EPI_FF1>(p, WSB(O_XB), 1024, WSB(O_WF11), 1024, 1024, 4096, WSO(O_H), 4096, 0, 0); PHEND
  PH(19, 1) gemm_phase<EPI_RES>(p, WSB(O_H), 4096, WSB(O_WF21), 4096, 4096, 1024, WSO(O_XB), 1024, 0, 0); PHEND
  PH(20, 1) res_fix_phase(p); PHEND
  PH(21, 1) final_phase(p); PHEND
}

extern "C" void kernel_launch(void* const* d_in, const int* in_sizes, int n_in, void* d_out, int out_size, void* d_ws,
                              size_t ws_size, hipStream_t stream) {
  static int grid_blocks = 0;
  if (!grid_blocks) {
    int dev = 0, cus = 0, per_cu = 0;
    hipGetDevice(&dev);
    hipDeviceGetAttribute(&cus, hipDeviceAttributeMultiprocessorCount, dev);
    hipOccupancyMaxActiveBlocksPerMultiprocessor(&per_cu, mega, 512, 0);
    if (per_cu < 1) per_cu = 1;
    grid_blocks = cus;
    if (grid_blocks > cus * per_cu) grid_blocks = cus * per_cu;
    if (ws_size < WS_NEED) fprintf(stderr, "workspace too small: %zu < %zu\n", ws_size, (size_t)WS_NEED);
  }
  Params p{};
  for (int i = 0; i < 41; i++) p.in[i] = (const float*)d_in[i];
  p.out = (float*)d_out;
  p.ws = (char*)d_ws;
  int plo = 0, phi = NPHASE - 1;
  void* args[] = {&p, &plo, &phi};
  hipError_t e = hipLaunchCooperativeKernel((void*)mega, dim3(grid_blocks), dim3(512), args, 0, stream);
  if (e != hipSuccess) fprintf(stderr, "cooperative launch failed: %s (grid %d)\n", hipGetErrorString(e), grid_blocks);
}
```

```cpp
#include <hip/hip_runtime.h>
#include <hip/hip_cooperative_groups.h>
#include <cstdio>
namespace cg = cooperative_groups;

typedef unsigned short u16;
typedef __attribute__((ext_vector_type(8))) short bf16x8;
typedef __attribute__((ext_vector_type(16))) float f32x16;

constexpr int MT = 16896;
constexpr int NP = 16384;

struct Params {
  const float* in[41];
  float* out;
  char* ws;
};

constexpr size_t OUT_Y = 0;
constexpr size_t OUT_PPOOL = (size_t)MT * 1024;
constexpr size_t OUT_PSHIFT = OUT_PPOOL + 8 * 15 * 256;
constexpr size_t OUT_PWKV = OUT_PSHIFT + 8 * 2560;
constexpr size_t OUT_PCONV = OUT_PWKV + 8 * 12 * 4096;
constexpr size_t OUT_PLRU = OUT_PCONV + 8 * 3 * 512;
constexpr size_t OUT_SPOOL = OUT_PLRU + 8 * 512;
constexpr size_t OUT_SSHIFT = OUT_SPOOL + 128 * 15 * 256;
constexpr size_t OUT_SWKV = OUT_SSHIFT + 128 * 2560;
constexpr size_t OUT_SCONV = OUT_SWKV + (size_t)128 * 12 * 4096;
constexpr size_t OUT_SLRU = OUT_SCONV + 128 * 3 * 512;
constexpr size_t OUT_SGV = OUT_SLRU + 128 * 512;

constexpr size_t O_WIN0 = 0;
constexpr size_t O_WOUT0 = O_WIN0 + 2816ull * 1024 * 2;
constexpr size_t O_WF10 = O_WOUT0 + 1024ull * 1024 * 2;
constexpr size_t O_WF20 = O_WF10 + 4096ull * 1024 * 2;
constexpr size_t O_WIN1 = O_WF20 + 4096ull * 1024 * 2;
constexpr size_t O_WOUT1 = O_WIN1 + 2048ull * 1024 * 2;
constexpr size_t O_WF11 = O_WOUT1 + 1024ull * 1024 * 2;
constexpr size_t O_WF21 = O_WF11 + 4096ull * 1024 * 2;
constexpr size_t O_WLW = O_WF21 + 4096ull * 1024 * 2;
constexpr size_t O_WLA = O_WLW + 768 * 64 * 2;
constexpr size_t O_WLG = O_WLA + 768 * 64 * 2;
constexpr size_t O_WM = O_WLG + 768 * 128 * 2;
constexpr size_t O_CNT = O_WM + 4 * 128 * 128 * 2;
constexpr size_t O_PART = O_CNT + 256;
constexpr size_t O_XB = O_PART + (size_t)MT * 16 * 4;
constexpr size_t O_Y = O_XB + (size_t)MT * 1024 * 2;
constexpr size_t O_AR = O_Y + (size_t)MT * 1024 * 2;
constexpr size_t O_P = O_AR;
constexpr size_t O_LIN = O_P + (size_t)MT * 2816 * 2;
constexpr size_t O_WPRE = O_LIN + (size_t)MT * 256 * 2;
constexpr size_t O_APRE = O_XB;
constexpr size_t O_BS = O_APRE + (size_t)MT * 768 * 2;
constexpr size_t O_CA = O_AR + (size_t)MT * 2048 * 2;
constexpr size_t O_HL = O_CA + (size_t)MT * 512 * 4;
constexpr size_t O_SEG = O_HL + (size_t)MT * 512 * 4;
constexpr size_t O_H = O_AR;
constexpr size_t O_XBAR = O_SEG + (size_t)1056 * 1024 * 4;
constexpr size_t O_CAR = O_XBAR + 16384;
constexpr size_t O_WXT = O_CAR + (size_t)1024 * 512 * 4;
constexpr size_t WS_NEED = O_WXT + 131072;

__device__ __forceinline__ u16 f2bf(float f) {
  __bf16 h = (__bf16)f;
  return __builtin_bit_cast(u16, h);
}
__device__ __forceinline__ float bf2f(u16 h) { return __uint_as_float(((unsigned)h) << 16); }
__device__ __forceinline__ float frcp_(float x) { return __builtin_amdgcn_rcpf(x); }
__device__ __forceinline__ float sigmoidf_(float x) { return frcp_(1.0f + __expf(-x)); }
__device__ __forceinline__ float tanhf_(float x) {
  float e = __expf(2.0f * x);
  return 1.0f - 2.0f * frcp_(1.0f + e);
}
__device__ __forceinline__ float geluf_(float x) {
  float y = 0.7978845608028654f * (x + 0.044715f * x * x * x);
  return 0.5f * x * (1.0f + tanhf_(y));
}
template <int CTRL>
__device__ __forceinline__ float dppmov(float v) {
  return __int_as_float(__builtin_amdgcn_update_dpp(0, __float_as_int(v), CTRL, 0xF, 0xF, true));
}
__device__ __forceinline__ float reduce8(float v) {
  v += dppmov<0xB1>(v);
  v += dppmov<0x4E>(v);
  v += dppmov<0x141>(v);
  return v;
}
__device__ __forceinline__ float row16sum(float v) {
  v += dppmov<0xB1>(v);
  v += dppmov<0x4E>(v);
  v += dppmov<0x141>(v);
  v += dppmov<0x140>(v);
  return v;
}
__device__ __forceinline__ float wsum64(float v) {
  v = row16sum(v);
  v += __int_as_float(__builtin_amdgcn_update_dpp(0, __float_as_int(v), 0x142, 0xA, 0xF, false));
  v += __int_as_float(__builtin_amdgcn_update_dpp(0, __float_as_int(v), 0x143, 0xC, 0xF, false));
  return __int_as_float(__builtin_amdgcn_readlane(__float_as_int(v), 63));
}
__device__ __forceinline__ float hsum32(float v) {
  v = row16sum(v);
  return v + __shfl_xor(v, 16);
}
__device__ __forceinline__ const float* xrow(const Params& p, int row) {
  return row < NP ? p.in[0] + (size_t)row * 1024 : p.in[1] + (size_t)(row - NP) * 1024;
}
__device__ __forceinline__ float prevP(const Params& p, const u16* P, int row, int c) {
  const int rp = row > 0 ? row - 1 : 0;
  float v = bf2f(P[(size_t)rp * 2816 + 256 + c]);
  const bool start = (row < NP) ? ((row & 2047) == 0) : (((row - NP) & 3) == 0);
  if (start) v = (row < NP) ? 0.f : p.in[3][(size_t)((row - NP) >> 2) * 2560 + c];
  return v;
}

__shared__ __attribute__((aligned(16))) unsigned char smem[114688];
#define RAW_BARRIER() do { asm volatile("s_waitcnt lgkmcnt(0)" ::: "memory"); __builtin_amdgcn_s_barrier(); asm volatile("" ::: "memory"); } while (0)
__shared__ int s_task;
__shared__ int s_simdcnt[4];
__shared__ int s_role[8];
__shared__ int s_role2[8];

#define XB_TMO      128
#define XB_XCNT(j)  (256  + 64 * (j))
#define XB_XSUB(j)  (1280 + 64 * (j))
#define XB_XGEN(j)  (2304 + 64 * (j))
#define XB_TOP      3328
#define XB_TOPGEN   3392
#define XCD_BAR_WORDS 3456
#define XB_SPIN_CAP (1u << 18)
#define LAS __attribute__((address_space(3)))

__device__ __forceinline__ unsigned xb_ld(unsigned* p)              { return __hip_atomic_load(p, __ATOMIC_RELAXED, __HIP_MEMORY_SCOPE_AGENT); }
__device__ __forceinline__ unsigned xb_add(unsigned* p, unsigned v) { return __hip_atomic_fetch_add(p, v, __ATOMIC_RELAXED, __HIP_MEMORY_SCOPE_AGENT); }
__device__ __forceinline__ unsigned xb_xcc_id() { return (unsigned)__builtin_amdgcn_s_getreg((3 << 11) | 20) & 0xFu; }
#define XB_SPIN(cond, bar) do { unsigned _sp = 0; while (cond) { __builtin_amdgcn_s_sleep(1); \
    if ((++_sp & 255u) == 0u) { if (xb_ld(&(bar)[XB_TMO])) break; if (_sp > XB_SPIN_CAP) { atomicAdd(&(bar)[XB_TMO], 1u); break; } } } } while (0)

struct XcdBarrier {
    unsigned* bar; unsigned x;
    volatile LAS unsigned* st;
};

__device__ __forceinline__ XcdBarrier xcd_barrier_post(unsigned* bar, volatile LAS unsigned* st) {
    XcdBarrier b; b.bar = bar; b.x = xb_xcc_id(); b.st = st;
    if (threadIdx.x == 0) (void)xb_add(&bar[XB_XCNT(b.x)], 1u);
    return b;
}
__device__ __forceinline__ void xcd_barrier_complete(unsigned* bar, unsigned x, unsigned& nloc, unsigned& nx) {
    const unsigned G = gridDim.x * gridDim.y * gridDim.z;
    unsigned sum, cnt, mine, sp = 0u;
    for (;;) {
        sum = 0u; cnt = 0u; mine = 0u;
#pragma unroll
        for (unsigned j = 0; j < 16; ++j) { const unsigned c = xb_ld(&bar[XB_XCNT(j)]); sum += c; cnt += (c > 0u) ? 1u : 0u; mine = (j == x) ? c : mine; }
        if (sum == G) break;
        __builtin_amdgcn_s_sleep(1);
        if ((++sp & 255u) == 0u) { if (xb_ld(&bar[XB_TMO])) break; if (sp > XB_SPIN_CAP) { atomicAdd(&bar[XB_TMO], 1u); break; } }
    }
    nloc = mine > 0u ? mine : 1u; nx = cnt > 0u ? cnt : 1u;
}

__device__ __forceinline__ void xcd_barrier(const XcdBarrier& b) {
    asm volatile("s_waitcnt vmcnt(0)" ::: "memory");
    __syncthreads();
    if (threadIdx.x == 0) {
        unsigned* bar = b.bar;
        __builtin_amdgcn_s_waitcnt(0);
        unsigned nloc = b.st[0], nx = b.st[1];
        if (nloc == 0u) { xcd_barrier_complete(bar, b.x, nloc, nx); b.st[0] = nloc; b.st[1] = nx; }
        const unsigned old = xb_add(&bar[XB_XSUB(b.x)], 1u);
        const unsigned gen = old / nloc;
        if (old + 1u == (gen + 1u) * nloc) {
            __builtin_amdgcn_fence(__ATOMIC_RELEASE, "agent");
            asm volatile("s_waitcnt vmcnt(0)" ::: "memory");
            const unsigned og = xb_add(&bar[XB_TOP], 1u);
            const unsigned tg = og / nx;
            if (og + 1u == (tg + 1u) * nx) xb_add(&bar[XB_TOPGEN], 1u);
            else XB_SPIN(xb_ld(&bar[XB_TOPGEN]) == tg, bar);
            __builtin_amdgcn_fence(__ATOMIC_ACQUIRE, "agent");
            xb_add(&bar[XB_XGEN(b.x)], 1u);
            asm volatile("s_waitcnt vmcnt(0)" ::: "memory");
        } else {
            XB_SPIN(xb_ld(&bar[XB_XGEN(b.x)]) == gen, bar);
            __builtin_amdgcn_fence(__ATOMIC_ACQUIRE, "agent");
            asm volatile("s_waitcnt vmcnt(0)" ::: "memory");
        }
    }
    __syncthreads();
}


__device__ __forceinline__ void convT(const float* __restrict__ W, int K, int N, const float* __restrict__ g, u16* __restrict__ WT) {
  float* t = (float*)smem;
  const int tilesN = N / 128, tiles = (K / 64) * tilesN;
  const int tx = threadIdx.x & 127, ty = threadIdx.x >> 7;
  const int sx = threadIdx.x & 63, sy = threadIdx.x >> 6;
  for (int tl = blockIdx.x; tl < tiles; tl += gridDim.x) {
    const int k0 = (tl / tilesN) * 64, n0 = (tl % tilesN) * 128;
    float v[16];
#pragma unroll
    for (int i = 0; i < 16; i++) v[i] = W[(size_t)(k0 + ty + 4 * i) * N + n0 + tx];
    if (g) {
#pragma unroll
      for (int i = 0; i < 16; i++) v[i] *= g[k0 + ty + 4 * i];
    }
    __syncthreads();
#pragma unroll
    for (int i = 0; i < 16; i++) t[(ty + 4 * i) * 129 + tx] = v[i];
    __syncthreads();
#pragma unroll
    for (int i = 0; i < 16; i++) {
      const int n = sy + 8 * i;
      WT[(size_t)(n0 + n) * K + k0 + sx] = f2bf(t[sx * 129 + n]);
    }
  }
}

__device__ __forceinline__ void phase0(const Params& p) {
  char* ws = p.ws;
  convT(p.in[8], 1024, 2816, p.in[7], (u16*)(ws + O_WIN0));
  convT(p.in[22], 1024, 1024, nullptr, (u16*)(ws + O_WOUT0));
  convT(p.in[38], 1024, 4096, p.in[37], (u16*)(ws + O_WF10));
  convT(p.in[39], 4096, 1024, nullptr, (u16*)(ws + O_WF20));
  convT(p.in[24], 1024, 2048, p.in[23], (u16*)(ws + O_WIN1));
  convT(p.in[36], 1024, 1024, nullptr, (u16*)(ws + O_WOUT1));
  convT(p.in[38] + (size_t)1024 * 4096, 1024, 4096, p.in[37] + 1024, (u16*)(ws + O_WF11));
  convT(p.in[39] + (size_t)1024 * 4096, 4096, 1024, nullptr, (u16*)(ws + O_WF21));
  convT(p.in[13], 64, 768, nullptr, (u16*)(ws + O_WLW));
  convT(p.in[15], 64, 768, nullptr, (u16*)(ws + O_WLA));
  convT(p.in[16], 128, 768, nullptr, (u16*)(ws + O_WLG));
  {
    u16* wm = (u16*)(ws + O_WM);
    const float* wsrc = p.in[27];
    for (int e = blockIdx.x * 512 + threadIdx.x; e < 4 * 128 * 128; e += gridDim.x * 512) {
      int i = (e >> 7) & 127, j = e & 127;
      wm[e] = (j <= i) ? f2bf(wsrc[e]) : (u16)0;
    }
  }
  {
    u16* wxt = (u16*)(ws + O_WXT);
    for (int e = blockIdx.x * 512 + threadIdx.x; e < 16 * 64 * 64; e += gridDim.x * 512) {
      const int m = e >> 12, d = (e >> 6) & 63, c = e & 63;
      const float* src = (m < 8) ? p.in[31] : p.in[33];
      wxt[e] = f2bf(src[(m & 7) * 4096 + c * 64 + d]);
    }
  }
  if (blockIdx.x == 0 && threadIdx.x < 64) ((int*)(ws + O_CNT))[threadIdx.x] = 0;
  if (blockIdx.x == 1) for (int e = threadIdx.x; e < 3456; e += 512) ((unsigned*)(ws + O_XBAR))[e] = 0u;
  for (int e = blockIdx.x * 512 + threadIdx.x; e < 512 * 256; e += gridDim.x * 512) ((float4*)(p.out + (size_t)NP * 1024))[e] = ((const float4*)p.in[1])[e];
  {
    u16* xb = (u16*)(ws + O_XB);
    float* part = (float*)(ws + O_PART);
    const int lane = threadIdx.x & 63, wave = threadIdx.x >> 6;
    for (int row = blockIdx.x * 8 + wave; row < MT; row += gridDim.x * 8) {
      const float* xr = xrow(p, row);
      float ss = 0.f;
#pragma unroll
      for (int i = 0; i < 4; i++) {
        float4 v = *(const float4*)(xr + i * 256 + lane * 4);
        ss += v.x * v.x + v.y * v.y + v.z * v.z + v.w * v.w;
        ushort4 o;
        o.x = f2bf(v.x); o.y = f2bf(v.y); o.z = f2bf(v.z); o.w = f2bf(v.w);
        *(ushort4*)(xb + (size_t)row * 1024 + i * 256 + lane * 4) = o;
      }
      ss = wsum64(ss);
      if (lane < 16) part[(size_t)row * 16 + lane] = (lane == 0) ? ss : 0.f;
    }
  }
}

enum { EPI_SCALE = 0, EPI_PLAIN = 1, EPI_FF1 = 2, EPI_RES = 3, EPI_POST = 4 };

template <int EPI>
__device__ __forceinline__ void gemm_epi(const Params& p, const f32x16 acc0, const f32x16 acc1, int mi, int wm, int wn, int lane,
                                         int m0, int nt, int c0, int c1, const float* sRs, u16* __restrict__ outb, int ldo,
                                         int resid_in) {
  float* part = (float*)(p.ws + O_PART);
  float* xf = p.out;
    const int rbase = wm * 64 + mi * 32 + 4 * (lane >> 5);
    if (EPI == EPI_SCALE || EPI == EPI_PLAIN || EPI == EPI_FF1) {
#pragma unroll
      for (int i = 0; i < 16; i++) {
        const int rl = rbase + (i & 3) + 8 * (i >> 2);
        const int row = m0 + rl;
        float v0 = acc0[i], v1 = acc1[i];
        if (EPI != EPI_PLAIN) { float rs = sRs[rl]; v0 *= rs; v1 *= rs; }
        if (EPI == EPI_FF1) { v0 = fmaxf(v0, 0.f); v1 = fmaxf(v1, 0.f); v0 *= v0; v1 *= v1; }
        outb[(size_t)row * ldo + c0] = f2bf(v0);
        outb[(size_t)row * ldo + c1] = f2bf(v1);
      }
    } else if (EPI == EPI_RES) {
#pragma unroll
      for (int i = 0; i < 16; i++) {
        const int rl = rbase + (i & 3) + 8 * (i >> 2);
        const int row = m0 + rl;
        const float* res = resid_in ? xrow(p, row) : (xf + (size_t)row * 1024);
        float v0 = res[c0] + acc0[i], v1 = res[c1] + acc1[i];
        xf[(size_t)row * 1024 + c0] = v0;
        xf[(size_t)row * 1024 + c1] = v1;
        outb[(size_t)row * 1024 + c0] = f2bf(v0);
        outb[(size_t)row * 1024 + c1] = f2bf(v1);
        float s = hsum32(v0 * v0 + v1 * v1);
        if ((lane & 31) == 0) part[(size_t)row * 16 + nt * 2 + wn] = s;
      }
    } else {
      const int hh = nt * 2 + wn;
      const u16* P = (const u16*)(p.ws + O_P);
      u16* Y = (u16*)(p.ws + O_Y);
      const float* bs = (const float*)(p.ws + O_BS);
      const int ch0 = hh * 64 + (lane & 31), ch1 = ch0 + 32;
      const float gg0 = p.in[20][ch0], gg1 = p.in[20][ch1];
      const float gb0 = p.in[21][ch0], gb1 = p.in[21][ch1];
      const float mu0 = p.in[11][1536 + ch0], mu1 = p.in[11][1536 + ch1];
#pragma unroll 8
      for (int i = 0; i < 16; i++) {
        const int rl = rbase + (i & 3) + 8 * (i >> 2);
        const int row = m0 + rl;
        float o0 = bf2f(Y[(size_t)row * 1024 + 256 + ch0]);
        float o1 = bf2f(Y[(size_t)row * 1024 + 256 + ch1]);
        float mean = hsum32(o0 + o1) * (1.0f / 64.0f);
        float d0 = o0 - mean, d1 = o1 - mean;
        float var = hsum32(d0 * d0 + d1 * d1) * (1.0f / 64.0f);
        float rstd = rsqrtf(var + 64e-5f);
        float pv0 = bf2f(P[(size_t)row * 2816 + 256 + 1536 + ch0]);
        float pv1 = bf2f(P[(size_t)row * 2816 + 256 + 1536 + ch1]);
        float pp0 = prevP(p, P, row, 1536 + ch0), pp1 = prevP(p, P, row, 1536 + ch1);
        float vv0 = pv0 + (pp0 - pv0) * mu0, vv1 = pv1 + (pp1 - pv1) * mu1;
        float b = bs[((size_t)row * 12 + hh) * 4 + 2];
        float y0 = (d0 * rstd * gg0 + gb0 + b * vv0) * acc0[i];
        float y1 = (d1 * rstd * gg1 + gb1 + b * vv1) * acc1[i];
        Y[(size_t)row * 1024 + 256 + ch0] = f2bf(y0);
        Y[(size_t)row * 1024 + 256 + ch1] = f2bf(y1);
      }
    }
}

template <int EPI>
__device__ __forceinline__ void gemm_phase(const Params& p, const u16* __restrict__ A, int lda, const u16* __restrict__ BT, int ldb,
                           int K, int N, u16* __restrict__ outb, int ldo, int resid_in, int boff) {
  constexpr int LS = 72;
  constexpr int SA = 256 * LS, SB = 128 * LS, STG = SA + SB;
  u16* sm = (u16*)smem;
  float* sRs = (float*)(sm + 2 * STG);
  const int tid = threadIdx.x, lane = tid & 63, wave = tid >> 6;
  const int wm = wave >> 1, wn = wave & 1;
  const int lrow = tid >> 3, lch = tid & 7;
  const int NT = N / 128;
  const int tiles = (MT / 256) * NT;
  const int KTALL = K / 64;
  float* part = (float*)(p.ws + O_PART);
  int bstart = (int)blockIdx.x - boff;
  if (bstart < 0) bstart += gridDim.x;
  const size_t a64 = (size_t)64 * lda, b64 = (size_t)64 * ldb;
  const int G = gridDim.x;
  int t_full = tiles, split = 1;
  if (EPI == EPI_RES) {
    const int tail = tiles % G;
    if (tail > 0 && (G % tail) == 0 && (KTALL % (G / tail)) == 0) { t_full = tiles - tail; const int smax = (KTALL >= 64) ? 8 : 4; split = (G / tail) > smax ? smax : (G / tail); }
  }
  const int units = t_full + (tiles - t_full) * split;
  for (int un = bstart; un < units; un += G) {
    int tl = un, kbeg = 0, KT = KTALL;
    bool part_unit = false;
    if (un >= t_full) { const int v = un - t_full; tl = t_full + v / split; KT = KTALL / split; kbeg = (v % split) * KT; part_unit = true; }
    int mt = tl / NT, nt = tl % NT;
    if (EPI == EPI_RES && NT == 8 && G == 256 && !part_unit) {
      const int rr = tl >> 8, bb = tl & 255;
      const int xx = bb & 7, jj = bb >> 3;
      mt = rr * 32 + xx * 4 + (jj >> 3);
      nt = jj & 7;
    } else if ((EPI == EPI_FF1 || EPI == EPI_SCALE) && G == 256 && (NT == 32 || NT == 16) && tl < (tiles & ~255)) {
      const int rr = tl >> 8, bb = tl & 255;
      const int xx = bb & 7, jj = bb >> 3;
      if (NT == 32) { mt = rr * 8 + (xx >> 2) * 4 + (jj >> 3); nt = (xx & 3) * 8 + (jj & 7); }
      else { mt = rr * 16 + (xx >> 1) * 4 + (jj >> 3); nt = (xx & 1) * 8 + (jj & 7); }
    }
    const int m0 = mt * 256, n0 = nt * 128;
    const u16* gA = A + (size_t)(m0 + lrow) * lda + lch * 8 + (size_t)kbeg * 64;
    const u16* gB = BT + (size_t)(n0 + lrow) * ldb + lch * 8 + (size_t)kbeg * 64;
    uint4 xa0, xa1, xa2, xa3, xb0, xb1;
    uint4 ya0, ya1, ya2, ya3, yb0, yb1;
#define LOADX(kt_) { const u16* qa = gA + (kt_) * 64; const u16* qb = gB + (kt_) * 64; \
    xa0 = *(const uint4*)qa; xa1 = *(const uint4*)(qa + a64); xa2 = *(const uint4*)(qa + 2 * a64); xa3 = *(const uint4*)(qa + 3 * a64); \
    xb0 = *(const uint4*)qb; xb1 = *(const uint4*)(qb + b64); }
#define LOADY(kt_) { const u16* qa = gA + (kt_) * 64; const u16* qb = gB + (kt_) * 64; \
    ya0 = *(const uint4*)qa; ya1 = *(const uint4*)(qa + a64); ya2 = *(const uint4*)(qa + 2 * a64); ya3 = *(const uint4*)(qa + 3 * a64); \
    yb0 = *(const uint4*)qb; yb1 = *(const uint4*)(qb + b64); }
#define WRITEX(st_) { u16* wa = sm + (st_) * STG + lrow * LS + lch * 8; u16* wb = wa + SA; \
    *(uint4*)wa = xa0; *(uint4*)(wa + 64 * LS) = xa1; *(uint4*)(wa + 128 * LS) = xa2; *(uint4*)(wa + 192 * LS) = xa3; \
    *(uint4*)wb = xb0; *(uint4*)(wb + 64 * LS) = xb1; }
#define WRITEY(st_) { u16* wa = sm + (st_) * STG + lrow * LS + lch * 8; u16* wb = wa + SA; \
    *(uint4*)wa = ya0; *(uint4*)(wa + 64 * LS) = ya1; *(uint4*)(wa + 128 * LS) = ya2; *(uint4*)(wa + 192 * LS) = ya3; \
    *(uint4*)wb = yb0; *(uint4*)(wb + 64 * LS) = yb1; }
#define COMPUTE(st_) { const u16* ab = sm + (st_) * STG + (wm * 64 + (lane & 31)) * LS + (lane >> 5) * 8; \
    const u16* bb = sm + (st_) * STG + SA + (wn * 64 + (lane & 31)) * LS + (lane >> 5) * 8; \
    _Pragma("unroll") for (int ks = 0; ks < 4; ks++) { \
      bf16x8 fa0 = *(const bf16x8*)(ab + ks * 16); bf16x8 fa1 = *(const bf16x8*)(ab + 32 * LS + ks * 16); \
      bf16x8 fb0 = *(const bf16x8*)(bb + ks * 16); bf16x8 fb1 = *(const bf16x8*)(bb + 32 * LS + ks * 16); \
      acc00 = __builtin_amdgcn_mfma_f32_32x32x16_bf16(fa0, fb0, acc00, 0, 0, 0); \
      acc01 = __builtin_amdgcn_mfma_f32_32x32x16_bf16(fa0, fb1, acc01, 0, 0, 0); \
      acc10 = __builtin_amdgcn_mfma_f32_32x32x16_bf16(fa1, fb0, acc10, 0, 0, 0); \
      acc11 = __builtin_amdgcn_mfma_f32_32x32x16_bf16(fa1, fb1, acc11, 0, 0, 0); } }
    LOADX(0);
    if (KT > 1) LOADY(1);
    __syncthreads();
    if (EPI == EPI_SCALE || EPI == EPI_FF1) {
      if (tid < 256) {
        const float4* pp = (const float4*)(part + (size_t)(m0 + tid) * 16);
        float4 a = pp[0], b = pp[1], c = pp[2], d = pp[3];
        float s = (a.x + a.y + a.z + a.w) + (b.x + b.y + b.z + b.w) + (c.x + c.y + c.z + c.w) + (d.x + d.y + d.z + d.w);
        sRs[tid] = rsqrtf(s * (1.0f / 1024.0f) + 1e-6f);
      }
    }
    WRITEX(0);
    if (KT > 2) LOADX(2);
    RAW_BARRIER();
    f32x16 acc00, acc01, acc10, acc11;
#pragma unroll
    for (int i = 0; i < 16; i++) { acc00[i] = 0.f; acc01[i] = 0.f; acc10[i] = 0.f; acc11[i] = 0.f; }
    for (int kt = 0; kt < KT; kt += 2) {
      if (kt + 1 < KT) WRITEY(1);
      if (kt + 3 < KT) LOADY(kt + 3);
      COMPUTE(0);
      RAW_BARRIER();
      if (kt + 1 >= KT) break;
      if (kt + 2 < KT) WRITEX(0);
      if (kt + 4 < KT) LOADX(kt + 4);
      COMPUTE(1);
      RAW_BARRIER();
    }
#undef LOADX
#undef LOADY
#undef WRITEX
#undef WRITEY
#undef COMPUTE
    const int c0 = n0 + wn * 64 + (lane & 31);
    const int c1 = c0 + 32;
    if (EPI == EPI_RES && part_unit) {
      float* xfp = p.out;
#pragma unroll
      for (int i = 0; i < 16; i++) {
        const int rl = wm * 64 + 4 * (lane >> 5) + (i & 3) + 8 * (i >> 2);
        float* r0p = xfp + (size_t)(m0 + rl) * 1024;
        float* r1p = r0p + (size_t)32 * 1024;
        atomicAdd(r0p + c0, acc00[i]); atomicAdd(r0p + c1, acc01[i]);
        atomicAdd(r1p + c0, acc10[i]); atomicAdd(r1p + c1, acc11[i]);
      }
    } else {
      gemm_epi<EPI>(p, acc00, acc01, 0, wm, wn, lane, m0, nt, c0, c1, sRs, outb, ldo, resid_in);
      gemm_epi<EPI>(p, acc10, acc11, 1, wm, wn, lane, m0, nt, c0, c1, sRs, outb, ldo, resid_in);
    }
  }
}

__device__ __forceinline__ void pool_item(const Params& p, int it) {
  const u16* P = (const u16*)(p.ws + O_P);
  u16* Y = (u16*)(p.ws + O_Y);
  float* hist = (float*)smem;
  float* dS = hist + 47 * 256;
  const int tid = threadIdx.x;
  const int col = tid & 255, hf = tid >> 8;
  const int gi = col >> 6, dd = col & 63;
  const int w = 2 << gi;
  const float* pw = p.in[9] + gi * 4096 + dd;
  const float sc = p.in[10][col];
  {
    int r0, t0, nrows, pos0;
    const float* st = nullptr;
    const float* shs = nullptr;
    if (it < 512) { r0 = it * 32; t0 = r0 & 2047; nrows = 32; pos0 = t0; }
    else { const int b = it - 512; r0 = NP + b * 4; t0 = 0; nrows = 4; pos0 = 16384; st = p.in[2] + (size_t)b * 3840; shs = p.in[3] + (size_t)b * 2560; }
    __syncthreads();
    const int nh = 15 + nrows;
#pragma unroll 8
    for (int hr = hf; hr < nh; hr += 2) {
      const int t = t0 - 15 + hr;
      float v = 0.f;
      if (t >= 0) v = bf2f(P[(size_t)(r0 - t0 + t) * 2816 + col]);
      else if (st) v = st[(15 + t) * 256 + col];
      hist[hr * 256 + col] = v;
    }
    __syncthreads();
    const int q0 = hf * 16;
    for (int q = 0; q < 16; q++) {
      const int tk = q0 + q;
      if (tk < nrows) {
        float s = 0.f;
        for (int i = 0; i < w; i++) s += hist[(15 + tk - i) * 256 + col];
        const float cnt = (float)min(w, pos0 + tk + 1);
        dS[tk * 256 + col] = s / cnt - hist[(15 + tk) * 256 + col];
      }
    }
    __syncthreads();
    float acc[16];
#pragma unroll
    for (int q = 0; q < 16; q++) acc[q] = 0.f;
    if (q0 < nrows) {
#pragma unroll 4
      for (int c = 0; c < 64; c += 4) {
        float w0 = pw[(c + 0) * 64], w1 = pw[(c + 1) * 64], w2 = pw[(c + 2) * 64], w3 = pw[(c + 3) * 64];
#pragma unroll
        for (int q = 0; q < 16; q++) {
          float4 d = *(const float4*)(dS + (q0 + q) * 256 + gi * 64 + c);
          acc[q] += d.x * w0 + d.y * w1 + d.z * w2 + d.w * w3;
        }
      }
    }
#pragma unroll
    for (int q = 0; q < 16; q++) {
      if (q0 + q < nrows) Y[(size_t)(r0 + q0 + q) * 1024 + col] = f2bf(acc[q] * sc);
    }
  }
}

__device__ __forceinline__ void pool_phase(const Params& p) {
  const u16* P = (const u16*)(p.ws + O_P);
  u16* LIN = (u16*)(p.ws + O_LIN);
  const int tid = threadIdx.x;
  const int col = tid & 255, hf = tid >> 8;
  const float mu = p.in[11][2304 + col];
  for (int it = blockIdx.x; it < 512 + 128; it += gridDim.x) {
    int r0, t0, nrows;
    const float* shs = nullptr;
    if (it < 512) { r0 = it * 32; t0 = r0 & 2047; nrows = 32; }
    else { const int b = it - 512; r0 = NP + b * 4; t0 = 0; nrows = 4; shs = p.in[3] + (size_t)b * 2560; }
    const int q0 = hf * 16;
    if (q0 < nrows) {
      const int nq = min(16, nrows - q0);
      float pv[17];
      {
        const int rowp = r0 + q0 - 1;
        float v0;
        if (t0 + q0 == 0) v0 = shs ? shs[2304 + col] : 0.f;
        else v0 = bf2f(P[(size_t)rowp * 2816 + 2560 + col]);
        pv[0] = v0;
      }
#pragma unroll
      for (int q = 0; q < 16; q++) pv[q + 1] = (q < nq) ? bf2f(P[(size_t)(r0 + q0 + q) * 2816 + 2560 + col]) : 0.f;
#pragma unroll
      for (int q = 0; q < 16; q++) {
        if (q < nq) {
          float xs = pv[q + 1] + (pv[q] - pv[q + 1]) * mu;
          float v = (col < 64) ? tanhf_(xs) : ((col < 128) ? xs : sigmoidf_(xs));
          LIN[(size_t)(r0 + q0 + q) * 256 + col] = f2bf(v);
        }
      }
    }
  }
  const int gt = blockIdx.x * 512 + tid, gs = gridDim.x * 512;
  for (int e = gt; e < 8 * 15 * 256; e += gs) {
    int b = e / 3840, r = (e / 256) % 15, c = e & 255;
    p.out[OUT_PPOOL + e] = bf2f(P[(size_t)(b * 2048 + 2033 + r) * 2816 + c]);
  }
  for (int e = gt; e < 128 * 15 * 256; e += gs) {
    int b = e / 3840, r = (e / 256) % 15, c = e & 255;
    float v;
    if (r < 11) v = p.in[2][(size_t)b * 3840 + (r + 4) * 256 + c];
    else v = bf2f(P[(size_t)(NP + b * 4 + (r - 11)) * 2816 + c]);
    p.out[OUT_SPOOL + e] = v;
  }
  for (int e = gt; e < 8 * 2560; e += gs) {
    int b = e / 2560, c = e % 2560;
    p.out[OUT_PSHIFT + e] = bf2f(P[(size_t)(b * 2048 + 2047) * 2816 + 256 + c]);
  }
  for (int e = gt; e < 128 * 2560; e += gs) {
    int b = e / 2560, c = e % 2560;
    p.out[OUT_SSHIFT + e] = bf2f(P[(size_t)(NP + b * 4 + 3) * 2816 + 256 + c]);
  }
}

__device__ __forceinline__ void rwkv_prep_phase(const Params& p) {
  const u16* P = (const u16*)(p.ws + O_P);
  u16* APRE = (u16*)(p.ws + O_APRE);
  u16* WPRE = (u16*)(p.ws + O_WPRE);
  float* SC = (float*)(p.ws + O_BS);
  const int lane = threadIdx.x & 63, wave = __builtin_amdgcn_readfirstlane(threadIdx.x >> 6);
  for (int row = blockIdx.x * 8 + wave; row < MT; row += gridDim.x * 8) {
    const u16* Pr = P + (size_t)row * 2816 + 256;
#pragma unroll 12
    for (int h = 0; h < 12; h++) {
      const int ch = h * 64 + lane;
      float pr = bf2f(Pr[ch]), pk = bf2f(Pr[768 + ch]);
      float qr = prevP(p, P, row, ch), qk = prevP(p, P, row, 768 + ch);
      float wl = p.in[12][ch] + bf2f(WPRE[(size_t)row * 768 + ch]);
      float r = pr + (qr - pr) * p.in[11][ch], k = pk + (qk - pk) * p.in[11][768 + ch];
      float a = sigmoidf_(p.in[14][ch] + bf2f(APRE[(size_t)row * 768 + ch]));
      a = bf2f(f2bf(a));
      float omd = 1.0f - __expf(-0.6065306597126334f * sigmoidf_(wl));
      float kkr = k * p.in[17][ch];
      float n2 = wsum64(kkr * kkr);
      float inv = frcp_(fmaxf(__builtin_amdgcn_sqrtf(n2), 1e-12f));
      float kap = kkr * inv;
      float kp = k * (1.0f + (a - 1.0f) * p.in[18][ch]);
      float al = kap * a;
      float ar = wsum64(al * r);
      float kr = wsum64(kp * r);
      float bsum = wsum64(r * kp * p.in[19][ch]);
      APRE[(size_t)row * 768 + ch] = f2bf(a);
      WPRE[(size_t)row * 768 + ch] = f2bf(omd);
      if (lane == 0) *(float4*)(SC + ((size_t)row * 12 + h) * 4) = make_float4(ar, kr, bsum, inv);
    }
  }
}

constexpr int TC = 16;
typedef float v2f __attribute__((ext_vector_type(2)));
typedef float v4f __attribute__((ext_vector_type(4)));

struct StRaw {
  unsigned cr[2], ck[2], cv[2];
  unsigned qr[2], qk[2], qv[2];
  unsigned wp[2], ap[2];
  float inv[2], sc2[2];
  v2f s_r, s_k, s_v;
  float m;
};
struct StConst { v2f mur, muk, muv, kk_, ka_; };

__device__ __forceinline__ v2f bfpair(unsigned u) {
  v2f r;
  r.x = __uint_as_float(u << 16);
  r.y = __uint_as_float(u & 0xffff0000u);
  return r;
}

template <bool SAMPLE>
__device__ __forceinline__ void st_load(const Params& p, StRaw& R, int row0, int b, int h, int c, int sw, int lane) {
  const u16* P = (const u16*)(p.ws + O_P);
  const u16* WPRE = (const u16*)(p.ws + O_WPRE);
  const u16* APRE = (const u16*)(p.ws + O_APRE);
  const float* SC = (const float*)(p.ws + O_BS);
  const int l2 = lane & 31, tp = lane >> 5;
  const int ch = h * 64 + 2 * l2;
  const int t0 = c * TC + sw * 4;
  R.m = (t0 + tp == 0) ? 0.f : 1.f;
  if (SAMPLE) {
    const float* sp = p.in[3] + (size_t)b * 2560 + ch;
    R.s_r = *(const v2f*)sp; R.s_k = *(const v2f*)(sp + 768); R.s_v = *(const v2f*)(sp + 1536);
  }
#pragma unroll
  for (int ps = 0; ps < 2; ps++) {
    const int t = t0 + 2 * ps + tp;
    const int tq = t > 0 ? t - 1 : 0;
    const u16* Pc = P + (size_t)(row0 + t) * 2816 + 256 + ch;
    const u16* Pq = P + (size_t)(row0 + tq) * 2816 + 256 + ch;
    R.cr[ps] = *(const unsigned*)Pc; R.ck[ps] = *(const unsigned*)(Pc + 768); R.cv[ps] = *(const unsigned*)(Pc + 1536);
    R.qr[ps] = *(const unsigned*)Pq; R.qk[ps] = *(const unsigned*)(Pq + 768); R.qv[ps] = *(const unsigned*)(Pq + 1536);
    const size_t row = row0 + t;
    R.wp[ps] = *(const unsigned*)(WPRE + row * 768 + ch);
    R.ap[ps] = *(const unsigned*)(APRE + row * 768 + ch);
    R.inv[ps] = SC[(row * 12 + h) * 4 + 3];
    R.sc2[ps] = SC[(row * 12 + h) * 4 + (lane & 1)];
  }
}

template <bool SAMPLE>
__device__ __forceinline__ void st_compute(const StConst& K, const StRaw& R, int sw, int lane, float* ops, float* scal) {
  const int l2 = lane & 31, tp = lane >> 5;
#pragma unroll
  for (int ps = 0; ps < 2; ps++) {
    const int tt = sw * 4 + 2 * ps + tp;
    v2f pr = bfpair(R.cr[ps]), pk = bfpair(R.ck[ps]), pv = bfpair(R.cv[ps]);
    v2f qr = bfpair(R.qr[ps]), qk = bfpair(R.qk[ps]), qv = bfpair(R.qv[ps]);
    if (ps == 0) {
      if (SAMPLE) { if (R.m == 0.f) { qr = R.s_r; qk = R.s_k; qv = R.s_v; } }
      else { const v2f mm = {R.m, R.m}; qr *= mm; qk *= mm; qv *= mm; }
    }
    const v2f r = pr + (qr - pr) * K.mur;
    const v2f k = pk + (qk - pk) * K.muk;
    const v2f v = pv + (qv - pv) * K.muv;
    const v2f one = {1.0f, 1.0f};
    const v2f dec = one - bfpair(R.wp[ps]);
    const v2f a = bfpair(R.ap[ps]);
    const v2f iv = {R.inv[ps], R.inv[ps]};
    const v2f kap = k * K.kk_ * iv;
    const v2f kp = k * (one + (a - one) * K.ka_);
    float* o6 = ops + tt * 384 + 2 * l2;
    *(v2f*)(o6) = dec; *(v2f*)(o6 + 64) = kap * a; *(v2f*)(o6 + 128) = kp; *(v2f*)(o6 + 192) = kap; *(v2f*)(o6 + 256) = dec * r; *(v2f*)(o6 + 320) = v;
    if (l2 < 2) scal[tt * 2 + l2] = R.sc2[ps];
  }
}

struct ScD { v4f a0, a1, q0, q1; };
struct ScU { v4f w0, w1, l0, l1, k0, k1; float v; v2f sc; };
__device__ __forceinline__ void scd_load(ScD& O, const float* o6, int j8) {
  O.a0 = *(const v4f*)(o6 + 192 + j8); O.a1 = *(const v4f*)(o6 + 192 + j8 + 4);
  O.q0 = *(const v4f*)(o6 + 256 + j8); O.q1 = *(const v4f*)(o6 + 256 + j8 + 4);
}
__device__ __forceinline__ void scu_load(ScU& O, const float* o6, const float* sb, int tt, int j8, int srow) {
  O.w0 = *(const v4f*)(o6 + j8); O.w1 = *(const v4f*)(o6 + j8 + 4);
  O.l0 = *(const v4f*)(o6 + 64 + j8); O.l1 = *(const v4f*)(o6 + 64 + j8 + 4);
  O.k0 = *(const v4f*)(o6 + 128 + j8); O.k1 = *(const v4f*)(o6 + 128 + j8 + 4);
  O.v = o6[320 + srow];
  O.sc = *(const v2f*)(sb + tt * 2);
}
__device__ __forceinline__ void sc_step(const ScD& D, const ScU& U, v2f& s0, v2f& s1, v2f& s2, v2f& s3, float* obuf, int tt, int lane) {
  v2f pd2 = s0 * D.a0.lo;
  v2f qd2 = s0 * D.q0.lo;
  pd2 = s1 * D.a0.hi + pd2; qd2 = s1 * D.q0.hi + qd2;
  pd2 = s2 * D.a1.lo + pd2; qd2 = s2 * D.q1.lo + qd2;
  pd2 = s3 * D.a1.hi + pd2; qd2 = s3 * D.q1.hi + qd2;
  float pd = reduce8(pd2.x + pd2.y);
  float qd = reduce8(qd2.x + qd2.y);
  const float v = U.v;
  const float o = qd - pd * U.sc.x + v * U.sc.y;
  const v2f vv = {v, v};
  const v2f np = {-pd, -pd};
  s0 = s0 * U.w0.lo + (np * U.l0.lo + vv * U.k0.lo);
  s1 = s1 * U.w0.hi + (np * U.l0.hi + vv * U.k0.hi);
  s2 = s2 * U.w1.lo + (np * U.l1.lo + vv * U.k1.lo);
  s3 = s3 * U.w1.hi + (np * U.l1.hi + vv * U.k1.hi);
  obuf[tt * 8 + (lane >> 3)] = o;
}

template <int STEPS>
__device__ __forceinline__ void scan_steps(v2f& s0, v2f& s1, v2f& s2, v2f& s3, const float* ob, const float* sb, int j8, int srow,
                                           float* obuf, int lane) {
  ScD A, B, C;
  ScU P, Q;
  scd_load(A, ob, j8);
  scu_load(P, ob, sb, 0, j8, srow);
  scd_load(B, ob + 384, j8);
#define SC_STEP(DX_, DZ_, UX_, UZ_, tt_) { \
    if ((tt_) + 1 < STEPS) scu_load(UZ_, ob + ((tt_) + 1) * 384, sb, (tt_) + 1, j8, srow); \
    if ((tt_) + 2 < STEPS) scd_load(DZ_, ob + ((tt_) + 2) * 384, j8); \
    asm volatile("" ::: "memory"); sc_step(DX_, UX_, s0, s1, s2, s3, obuf, (tt_), lane); asm volatile("" ::: "memory"); }
  SC_STEP(A, C, P, Q, 0) SC_STEP(B, A, Q, P, 1) SC_STEP(C, B, P, Q, 2) SC_STEP(A, C, Q, P, 3)
  if (STEPS > 4) {
    SC_STEP(B, A, P, Q, 4) SC_STEP(C, B, Q, P, 5) SC_STEP(A, C, P, Q, 6) SC_STEP(B, A, Q, P, 7)
    SC_STEP(C, B, P, Q, 8) SC_STEP(A, C, Q, P, 9) SC_STEP(B, A, P, Q, 10) SC_STEP(C, B, Q, P, 11)
    SC_STEP(A, C, P, Q, 12) SC_STEP(B, A, Q, P, 13) SC_STEP(C, B, P, Q, 14) SC_STEP(A, C, Q, P, 15)
  }
#undef SC_STEP
}

__device__ __forceinline__ void scan_phase(const Params& p, int cidx, int task_lo, int task_hi) {
  float* ops = (float*)smem;
  float* scal = ops + 2 * TC * 384;
  float* obufs = scal + 2 * TC * 2;
  u16* Y = (u16*)(p.ws + O_Y);
  int* counter = (int*)(p.ws + O_CNT) + cidx;
  const int tid = threadIdx.x, lane = tid & 63, wave = __builtin_amdgcn_readfirstlane(tid >> 6);
  {
    if (tid < 4) s_simdcnt[tid] = 0;
    __syncthreads();
    if (lane == 0) {
      const int simd = (int)__builtin_amdgcn_s_getreg(2308) & 3;
      const int r = atomicAdd(&s_simdcnt[simd], 1);
      s_role[wave] = simd | (r << 4);
    }
    __syncthreads();
    if (tid == 0) {
      int ns = 0;
      for (int w = 0; w < 8; w++) ns += ((s_role[w] >> 4) == 0);
      int st = 0;
      for (int w = 0; w < 8; w++) {
        int v;
        if (ns == 4) v = ((s_role[w] >> 4) == 0) ? (s_role[w] & 3) : (4 + st++);
        else v = w;
        s_role2[w] = v;
      }
    }
    __syncthreads();
  }
  const int rolew = __builtin_amdgcn_readfirstlane(s_role2[wave]);
  const bool stat = (gridDim.x == 256 && task_lo == 0);
  bool first = true;
  while (true) {
    __syncthreads();
    if (tid == 0) s_task = (stat && first && blockIdx.x < 192) ? -1 : atomicAdd(counter, 1);
    __syncthreads();
    const int tq = __builtin_amdgcn_readfirstlane(s_task);
    first = false;
    const int task = (tq < 0) ? ((int)(blockIdx.x & 7) * 24 + (int)(blockIdx.x >> 3)) : (tq + (stat ? 192 : task_lo));
    if (task >= task_hi) break;
    int b, h, half, row0, T;
    bool sample;
    if (task < 192) { b = task / 24; h = (task % 24) >> 1; half = task & 1; row0 = b * 2048; T = 2048; sample = false; }
    else { int u = task - 192; b = u / 24; h = (u % 24) >> 1; half = u & 1; row0 = NP + b * 4; T = 4; sample = true; }
    const int nch = (T + TC - 1) / TC;
    const int sbase = half * 32 + (rolew & 3) * 8;
    const int srow = sbase + (lane >> 3);
    const int j8 = (lane & 7) * 8;
    float* obuf = obufs + (rolew & 3) * 128;
    if (rolew < 4) {
      v2f s0 = {0.f, 0.f}, s1 = s0, s2 = s0, s3 = s0;
      if (sample) {
        const float* sp = p.in[4] + ((size_t)(b * 12 + h) * 64 + srow) * 64 + j8;
        v4f x0 = *(const v4f*)sp, x1 = *(const v4f*)(sp + 4);
        s0 = x0.lo; s1 = x0.hi; s2 = x1.lo; s3 = x1.hi;
      }
      RAW_BARRIER();
      for (int c = 0; c < nch; c++) {
        const int buf = c & 1;
        const float* ob = ops + buf * TC * 384;
        const float* sb = scal + buf * TC * 2;
        if (sample) scan_steps<4>(s0, s1, s2, s3, ob, sb, j8, srow, obuf, lane);
        else scan_steps<TC>(s0, s1, s2, s3, ob, sb, j8, srow, obuf, lane);
        const int tt = lane >> 2, pr = lane & 3;
        if (tt < T) {
          v2f ov = *(const v2f*)(obuf + tt * 8 + 2 * pr);
          unsigned pk = (unsigned)f2bf(ov.x) | ((unsigned)f2bf(ov.y) << 16);
          *(unsigned*)(Y + (size_t)(row0 + c * TC + tt) * 1024 + 256 + h * 64 + sbase + 2 * pr) = pk;
        }
        RAW_BARRIER();
      }
      float* dp = p.out + (sample ? OUT_SWKV : OUT_PWKV) + ((size_t)(b * 12 + h) * 64 + srow) * 64 + j8;
      *(float4*)dp = make_float4(s0.x, s0.y, s1.x, s1.y);
      *(float4*)(dp + 4) = make_float4(s2.x, s2.y, s3.x, s3.y);
    } else {
      const int sw = rolew - 4;
      const int ch = h * 64 + 2 * (lane & 31);
      StConst K;
      K.mur = *(const v2f*)(p.in[11] + ch); K.muk = *(const v2f*)(p.in[11] + 768 + ch); K.muv = *(const v2f*)(p.in[11] + 1536 + ch);
      K.kk_ = *(const v2f*)(p.in[17] + ch); K.ka_ = *(const v2f*)(p.in[18] + ch);
      if (sample) {
        if (sw == 0) {
          StRaw RS;
          st_load<true>(p, RS, row0, b, h, 0, 0, lane);
          st_compute<true>(K, RS, 0, lane, ops, scal);
        }
        RAW_BARRIER();
        RAW_BARRIER();
      } else {
        StRaw RA, RB;
        st_load<false>(p, RA, row0, b, h, 0, sw, lane);
        st_compute<false>(K, RA, sw, lane, ops, scal);
        st_load<false>(p, RA, row0, b, h, 1, sw, lane);
        st_load<false>(p, RB, row0, b, h, 2, sw, lane);
        RAW_BARRIER();
        for (int c = 0; c < nch; c += 2) {
          st_compute<false>(K, RA, sw, lane, ops + TC * 384, scal + TC * 2);
          st_load<false>(p, RA, row0, b, h, (c + 3 < nch) ? c + 3 : c + 1, sw, lane);
          RAW_BARRIER();
          st_compute<false>(K, RB, sw, lane, ops, scal);
          st_load<false>(p, RB, row0, b, h, (c + 4 < nch) ? c + 4 : c + 2 < nch ? c + 2 : c, sw, lane);
          RAW_BARRIER();
        }
      }
    }
  }
}

__device__ __forceinline__ void pool_queue(const Params& p) {
  int* counter = (int*)(p.ws + O_CNT) + 2;
  while (true) {
    __syncthreads();
    if (threadIdx.x == 0) s_task = atomicAdd(counter, 1);
    __syncthreads();
    const int it = __builtin_amdgcn_readfirstlane(s_task);
    if (it >= 640) break;
    pool_item(p, it);
  }
}

__device__ __forceinline__ void mix1_phase(const Params& p) {
  const u16* Q = (const u16*)(p.ws + O_P);
  u16* Y = (u16*)(p.ws + O_Y);
  const u16* WM = (const u16*)(p.ws + O_WM);
  const int tid = threadIdx.x, lane = tid & 63, wave = tid >> 6;
  constexpr int N_GP = 512, N_GS = 128, N_LRU = MT / 16;
  for (int it = blockIdx.x; it < N_GP + N_GS + N_LRU; it += gridDim.x) {
    __syncthreads();
    if (it < N_GP) {
      const int h = it & 3, ck = (it >> 2) & 15, b = it >> 6;
      const int r0 = b * 2048 + ck * 128;
      u16* vT = (u16*)smem;
      {
        const u16* qb = Q + (size_t)(r0 + wave * 16) * 2048 + 512 + lane * 8;
        float lg[8], lb[8];
        if ((lane >> 4) == h) {
#pragma unroll
          for (int e = 0; e < 8; e++) { lg[e] = p.in[25][h * 128 + (lane & 15) * 8 + e]; lb[e] = p.in[26][h * 128 + (lane & 15) * 8 + e]; }
        } else {
#pragma unroll
          for (int e = 0; e < 8; e++) { lg[e] = 0.f; lb[e] = 0.f; }
        }
        uint4 cur0 = *(const uint4*)(qb), cur1 = *(const uint4*)(qb + 2048), cur2 = *(const uint4*)(qb + 2 * 2048), cur3 = *(const uint4*)(qb + 3 * 2048);
        for (int bt = 0; bt < 4; bt++) {
          uint4 nx0 = cur0, nx1 = cur1, nx2 = cur2, nx3 = cur3;
          if (bt < 3) {
            const u16* qn = qb + (size_t)(bt + 1) * 4 * 2048;
            nx0 = *(const uint4*)(qn); nx1 = *(const uint4*)(qn + 2048); nx2 = *(const uint4*)(qn + 2 * 2048); nx3 = *(const uint4*)(qn + 3 * 2048);
          }
#pragma unroll
          for (int u = 0; u < 4; u++) {
            const uint4 raw = (u == 0) ? cur0 : (u == 1) ? cur1 : (u == 2) ? cur2 : cur3;
            const int j = wave * 16 + bt * 4 + u;
            const u16* rp = (const u16*)&raw;
            float z[8];
            float sm = 0.f;
#pragma unroll
            for (int e = 0; e < 8; e++) { z[e] = geluf_(bf2f(rp[e])); sm += z[e]; }
            const float mean = wsum64(sm) * (1.0f / 512.0f);
            float s2 = 0.f;
#pragma unroll
            for (int e = 0; e < 8; e++) { z[e] -= mean; s2 += z[e] * z[e]; }
            const float rstd = rsqrtf(wsum64(s2) * (1.0f / 512.0f) + 1e-5f);
            if ((lane >> 4) == h) {
#pragma unroll
              for (int e = 0; e < 8; e++) {
                const int d = (lane & 15) * 8 + e;
                vT[d * 136 + j] = f2bf(z[e] * rstd * lg[e] + lb[e]);
              }
            }
          }
          cur0 = nx0; cur1 = nx1; cur2 = nx2; cur3 = nx3;
        }
      }
      __syncthreads();
      const int wm = wave >> 1, wn = wave & 1;
      f32x16 acc0, acc1;
#pragma unroll
      for (int i = 0; i < 16; i++) { acc0[i] = 0.f; acc1[i] = 0.f; }
      const u16* ag = WM + (size_t)h * 16384 + (size_t)(wm * 32 + (lane & 31)) * 128 + (lane >> 5) * 8;
      const u16* bb = vT + (wn * 64 + (lane & 31)) * 136 + (lane >> 5) * 8;
      const int nks = 2 * (wm + 1);
      for (int ks = 0; ks < nks; ks++) {
        bf16x8 a = *(const bf16x8*)(ag + ks * 16);
        bf16x8 b0 = *(const bf16x8*)(bb + ks * 16);
        bf16x8 b1 = *(const bf16x8*)(bb + 32 * 136 + ks * 16);
        acc0 = __builtin_amdgcn_mfma_f32_32x32x16_bf16(a, b0, acc0, 0, 0, 0);
        acc1 = __builtin_amdgcn_mfma_f32_32x32x16_bf16(a, b1, acc1, 0, 0, 0);
      }
      const int d0 = h * 128 + wn * 64 + (lane & 31), d1 = d0 + 32;
#pragma unroll 4
      for (int i = 0; i < 16; i++) {
        const int il = wm * 32 + (i & 3) + 8 * (i >> 2) + 4 * (lane >> 5);
        const int row = r0 + il;
        const float bsv = p.in[28][h * 128 + il];
        float u0 = geluf_(bf2f(Q[(size_t)row * 2048 + d0]));
        float u1 = geluf_(bf2f(Q[(size_t)row * 2048 + d1]));
        Y[(size_t)row * 1024 + d0] = f2bf(u0 * (acc0[i] + bsv));
        Y[(size_t)row * 1024 + d1] = f2bf(u1 * (acc1[i] + bsv));
      }
    } else if (it < N_GP + N_GS) {
      const int b = it - N_GP;
      const int r0 = NP + b * 4;
      float* vs = (float*)smem;
      if (wave < 4) {
        const int row = r0 + wave;
        uint4 raw = *(const uint4*)(Q + (size_t)row * 2048 + 512 + lane * 8);
        const u16* rp = (const u16*)&raw;
        float z[8];
        float s = 0.f;
#pragma unroll
        for (int e = 0; e < 8; e++) { z[e] = geluf_(bf2f(rp[e])); s += z[e]; }
        const float mean = wsum64(s) * (1.0f / 512.0f);
        float s2 = 0.f;
#pragma unroll
        for (int e = 0; e < 8; e++) { z[e] -= mean; s2 += z[e] * z[e]; }
        const float rstd = rsqrtf(wsum64(s2) * (1.0f / 512.0f) + 1e-5f);
#pragma unroll
        for (int e = 0; e < 8; e++) {
          const int d = lane * 8 + e;
          float vn = z[e] * rstd * p.in[25][d] + p.in[26][d];
          vs[wave * 512 + d] = vn;
          p.out[OUT_SGV + (size_t)(b * 4 + wave) * 512 + d] = vn;
        }
      }
      __syncthreads();
      {
        const int ch = tid, hh = ch >> 7;
        for (int i = 0; i < 4; i++) {
          float mix = p.in[28][hh * 128 + i];
          for (int j = 0; j <= i; j++) mix += p.in[27][(size_t)(hh * 128 + i) * 128 + j] * vs[j * 512 + ch];
          float u = geluf_(bf2f(Q[(size_t)(r0 + i) * 2048 + ch]));
          Y[(size_t)(r0 + i) * 1024 + ch] = f2bf(u * mix);
        }
      }
    } else {
      const int li = it - N_GP - N_GS;
      const int r0 = li * 16;
      u16* xcb = (u16*)smem;
      float* gxs = (float*)(smem + 16 * 520 * 2);
      float* gas = gxs + 16 * 512;
      const int ch = tid;
      float* CA = (float*)(p.ws + O_CA);
      float* HL = (float*)(p.ws + O_HL);
      float* SEG = (float*)(p.ws + O_SEG);
      const float cw0 = p.in[29][ch], cw1 = p.in[29][512 + ch], cw2 = p.in[29][1024 + ch], cw3 = p.in[29][1536 + ch];
      const float cb = p.in[30][ch];
      {
        float xr[19];
#pragma unroll
        for (int q = 0; q < 19; q++) {
          const int row = r0 - 3 + q;
          float v = 0.f;
          bool valid;
          int tq;
          if (r0 < NP) { tq = (r0 & 2047) - 3 + q; valid = tq >= 0; }
          else { valid = true; tq = 0; }
          if (r0 < NP) { if (valid) v = bf2f(Q[(size_t)row * 2048 + 1536 + ch]); }
          else v = bf2f(Q[(size_t)(row < NP ? NP : row) * 2048 + 1536 + ch]);
          xr[q] = v;
        }
#pragma unroll
        for (int q = 0; q < 16; q++) {
          float x0 = xr[q], x1 = xr[q + 1], x2 = xr[q + 2], x3 = xr[q + 3];
          if (r0 >= NP) {
            const int rs = r0 - NP + q;
            const int t = rs & 3;
            const float* st = p.in[5] + (size_t)(rs >> 2) * 1536 + ch;
            if (t < 3) x0 = st[t * 512];
            if (t < 2) x1 = st[(t + 1) * 512];
            if (t < 1) x2 = st[(t + 2) * 512];
          }
          const float xc = cb + cw0 * x0 + cw1 * x1 + cw2 * x2 + cw3 * x3;
          xcb[q * 520 + ch] = f2bf(xc);
        }
      }
      __syncthreads();
      {
        const u16* WXT = (const u16*)(p.ws + O_WXT);
        const int n = wave;
        typedef __attribute__((ext_vector_type(4))) float f32x4;
        f32x4 ac[8];
#pragma unroll
        for (int i = 0; i < 8; i++) { ac[i][0] = 0.f; ac[i][1] = 0.f; ac[i][2] = 0.f; ac[i][3] = 0.f; }
#pragma unroll
        for (int kh = 0; kh < 2; kh++) {
          const bf16x8 af = *(const bf16x8*)(xcb + (lane & 15) * 520 + n * 64 + kh * 32 + (lane >> 4) * 8);
          bf16x8 bfr[8];
#pragma unroll
          for (int i = 0; i < 8; i++) {
            const int w = i >> 2, dt = i & 3;
            bfr[i] = *(const bf16x8*)(WXT + ((size_t)((w * 8 + n) * 64 + dt * 16 + (lane & 15))) * 64 + kh * 32 + (lane >> 4) * 8);
          }
#pragma unroll
          for (int i = 0; i < 8; i++) ac[i] = __builtin_amdgcn_mfma_f32_16x16x32_bf16(af, bfr[i], ac[i], 0, 0, 0);
        }
#pragma unroll
        for (int i = 0; i < 8; i++) {
          const int w = i >> 2, dt = i & 3;
          float* dst = (w ? gas : gxs) + n * 64 + dt * 16 + (lane & 15);
#pragma unroll
          for (int r = 0; r < 4; r++) dst[((lane >> 4) * 4 + r) * 512] = ac[i][r];
        }
      }
      __syncthreads();
      const float bx = p.in[32][ch], ba = p.in[34][ch];
      const float lam = p.in[35][ch];
      const float spl = fmaxf(-lam, 0.f) + log1pf(__expf(-fabsf(lam)));
      float hl = 0.f, ca = 1.f;
#pragma unroll 4
      for (int q = 0; q < 16; q++) {
        const int row = r0 + q;
        if (row >= NP) {
          int rs = row - NP;
          if ((rs & 3) == 0) { hl = p.in[6][(size_t)(rs >> 2) * 512 + ch]; ca = 1.f; }
        }
        float gx = sigmoidf_(gxs[q * 512 + ch] + bx), ga = sigmoidf_(gas[q * 512 + ch] + ba);
        float la = -8.0f * ga * spl;
        float a = __expf(la);
        float bb = __builtin_amdgcn_sqrtf(fmaxf(1.0f - a * a, 0.f)) * gx * bf2f(xcb[q * 520 + ch]);
        hl = a * hl + bb;
        ca = ca * a;
        CA[(size_t)row * 512 + ch] = ca;
        HL[(size_t)row * 512 + ch] = hl;
      }
      SEG[(size_t)li * 1024 + ch] = ca;
      SEG[(size_t)li * 1024 + 512 + ch] = hl;
    }
  }
}

__device__ __forceinline__ void lru_fix_phase(const Params& p, const XcdBarrier& xb) {
  const u16* Q = (const u16*)(p.ws + O_P);
  u16* Y = (u16*)(p.ws + O_Y);
  const float* CA = (const float*)(p.ws + O_CA);
  const float* HL = (const float*)(p.ws + O_HL);
  const float* SEG = (const float*)(p.ws + O_SEG);
  const int ch = threadIdx.x;
  const bool blocked = (gridDim.x == 256);
  for (int k = 0; k < (blocked ? 1 : 0); k++) {
    const int li0 = blockIdx.x * 4;
    const int b = li0 >> 7, s0 = li0 & 127;
    const float* sg = SEG + (size_t)(b * 128) * 1024 + ch;
    float carry = 0.f;
#pragma unroll 8
    for (int q = 0; q < s0; q++) carry = sg[(size_t)q * 1024] * carry + sg[(size_t)q * 1024 + 512];
    for (int u = 0; u < 4; u++) {
      const int li = li0 + u;
      const int r0 = li * 16;
#pragma unroll 8
      for (int q = 0; q < 16; q++) {
        const int row = r0 + q;
        float hv = HL[(size_t)row * 512 + ch] + CA[(size_t)row * 512 + ch] * carry;
        float gate = geluf_(bf2f(Q[(size_t)row * 2048 + 1024 + ch]));
        Y[(size_t)row * 1024 + 512 + ch] = f2bf(hv * gate);
        if ((row & 2047) == 2047) p.out[OUT_PLRU + (size_t)(row >> 11) * 512 + ch] = hv;
      }
      carry = sg[(size_t)(s0 + u) * 1024] * carry + sg[(size_t)(s0 + u) * 1024 + 512];
    }
  }
  for (int li = (blocked ? 1024 : 0) + blockIdx.x; li < MT / 16; li += gridDim.x) {
    const int r0 = li * 16;
    float carry = 0.f;
    if (r0 < NP) {
      const int b = r0 >> 11, sN = (r0 & 2047) >> 4;
      const float* sg = SEG + (size_t)(b * 128) * 1024 + ch;
      for (int q = 0; q < sN; q++) carry = sg[(size_t)q * 1024] * carry + sg[(size_t)q * 1024 + 512];
    }
#pragma unroll 8
    for (int q = 0; q < 16; q++) {
      const int row = r0 + q;
      float hv = HL[(size_t)row * 512 + ch] + CA[(size_t)row * 512 + ch] * carry;
      float gate = geluf_(bf2f(Q[(size_t)row * 2048 + 1024 + ch]));
      Y[(size_t)row * 1024 + 512 + ch] = f2bf(hv * gate);
      if (row < NP) {
        if ((row & 2047) == 2047) p.out[OUT_PLRU + (size_t)(row >> 11) * 512 + ch] = hv;
      } else {
        int rs = row - NP;
        if ((rs & 3) == 3) p.out[OUT_SLRU + (size_t)(rs >> 2) * 512 + ch] = hv;
      }
    }
  }
  const int gt = blockIdx.x * 512 + threadIdx.x, gs = gridDim.x * 512;
  for (int e = gt; e < 8 * 3 * 512; e += gs) {
    int b = e / 1536, i = (e / 512) % 3, c = e & 511;
    p.out[OUT_PCONV + e] = bf2f(Q[(size_t)(b * 2048 + 2045 + i) * 2048 + 1536 + c]);
  }
  for (int e = gt; e < 128 * 3 * 512; e += gs) {
    int b = e / 1536, i = (e / 512) % 3, c = e & 511;
    p.out[OUT_SCONV + e] = bf2f(Q[(size_t)(NP + b * 4 + 1 + i) * 2048 + 1536 + c]);
  }
}

__device__ __forceinline__ void res_fix_phase(const Params& p) {
  u16* xb = (u16*)(p.ws + O_XB);
  float* part = (float*)(p.ws + O_PART);
  const int lane = threadIdx.x & 63, wave = threadIdx.x >> 6;
  for (int row = NP + blockIdx.x * 8 + wave; row < MT; row += gridDim.x * 8) {
    const float* xr = p.out + (size_t)row * 1024;
    float ss = 0.f;
#pragma unroll
    for (int i = 0; i < 4; i++) {
      float4 v = *(const float4*)(xr + i * 256 + lane * 4);
      ss += v.x * v.x + v.y * v.y + v.z * v.z + v.w * v.w;
      ushort4 o;
      o.x = f2bf(v.x); o.y = f2bf(v.y); o.z = f2bf(v.z); o.w = f2bf(v.w);
      *(ushort4*)(xb + (size_t)row * 1024 + i * 256 + lane * 4) = o;
    }
    ss = wsum64(ss);
    if (lane < 16) part[(size_t)row * 16 + lane] = (lane == 0) ? ss : 0.f;
  }
}

__device__ __forceinline__ void final_phase(const Params& p) {
  const float* part = (const float*)(p.ws + O_PART);
  const float* g = p.in[40];
  const int lane = threadIdx.x & 63, wave = threadIdx.x >> 6;
  for (int row = blockIdx.x * 8 + wave; row < MT; row += gridDim.x * 8) {
    float s = (lane < 16) ? part[(size_t)row * 16 + lane] : 0.f;
    s = wsum64(s);
    const float rs = rsqrtf(s * (1.0f / 1024.0f) + 1e-6f);
    float* xr = p.out + (size_t)row * 1024;
#pragma unroll
    for (int i = 0; i < 4; i++) {
      float4 v = *(float4*)(xr + i * 256 + lane * 4);
      float4 gg = *(const float4*)(g + i * 256 + lane * 4);
      v.x *= rs * gg.x; v.y *= rs * gg.y; v.z *= rs * gg.z; v.w *= rs * gg.w;
      *(float4*)(xr + i * 256 + lane * 4) = v;
    }
  }
}


constexpr int NPHASE = 22;
enum { K_P0 = 0, K_G_SCALE, K_G_PLAIN, K_G_FF1, K_G_RES, K_G_POST, K_POOL, K_SCAN, K_MIX1, K_LRUFIX, K_FINAL };

#define PH(n, sync_) if (plo <= (n) && (n) <= phi) { if ((n) > plo && (sync_)) { if ((n) == 1) { grid.sync(); xb = xcd_barrier_post((unsigned*)(ws + O_XBAR), (volatile LAS unsigned*)&xb_words); } else xcd_barrier(xb); }
#define PHEND }
#define WSB(o) ((const u16*)(ws + (o)))
#define WSO(o) ((u16*)(ws + (o)))
__global__ void __launch_bounds__(512) mega(Params p, int plo, int phi) {
  cg::grid_group grid = cg::this_grid();
  char* ws = p.ws;
  __shared__ uint4 xb_words;
  if (threadIdx.x == 0) xb_words = make_uint4(0u, 0u, 0u, 0u);
  __syncthreads();
  XcdBarrier xb; xb.bar = (unsigned*)(ws + O_XBAR); xb.x = 0; xb.st = (volatile LAS unsigned*)&xb_words;
  PH(0, 1) phase0(p); PHEND
  PH(1, 1) gemm_phase<EPI_SCALE>(p, WSB(O_XB), 1024, WSB(O_WIN0), 1024, 1024, 2816, WSO(O_P), 2816, 0, 0); PHEND
  PH(2, 1) pool_phase(p); PHEND
  PH(3, 1) gemm_phase<EPI_PLAIN>(p, WSB(O_LIN), 256, WSB(O_WLW), 64, 64, 768, WSO(O_WPRE), 768, 0, 0); PHEND
  PH(4, 0) gemm_phase<EPI_PLAIN>(p, WSB(O_LIN + 128), 256, WSB(O_WLA), 64, 64, 768, WSO(O_APRE), 768, 0, 140); PHEND
  PH(5, 1) rwkv_prep_phase(p); PHEND
  PH(6, 1) scan_phase(p, 0, 0, 3264); pool_queue(p); PHEND
  PH(7, 1) gemm_phase<EPI_POST>(p, WSB(O_LIN + 256), 256, WSB(O_WLG), 128, 128, 768, nullptr, 0, 0, 0); PHEND
  PH(8, 1) gemm_phase<EPI_RES>(p, WSB(O_Y), 1024, WSB(O_WOUT0), 1024, 1024, 1024, WSO(O_XB), 1024, 1, 0); PHEND
  PH(9, 1) res_fix_phase(p); PHEND
  PH(10, 1) gemm_phase<EPI_FF1>(p, WSB(O_XB), 1024, WSB(O_WF10), 1024, 1024, 4096, WSO(O_H), 4096, 0, 0); PHEND
  PH(11, 1) gemm_phase<EPI_RES>(p, WSB(O_H), 4096, WSB(O_WF20), 4096, 4096, 1024, WSO(O_XB), 1024, 0, 0); PHEND
  PH(12, 1) res_fix_phase(p); PHEND
  PH(13, 1) gemm_phase<EPI_SCALE>(p, WSB(O_XB), 1024, WSB(O_WIN1), 1024, 1024, 2048, WSO(O_P), 2048, 0, 0); PHEND
  PH(14, 1) mix1_phase(p); PHEND
  PH(15, 1) lru_fix_phase(p, xb); PHEND
  PH(16, 1) gemm_phase<EPI_RES>(p, WSB(O_Y), 1024, WSB(O_WOUT1), 1024, 1024, 1024, WSO(O_XB), 1024, 0, 0); PHEND
  PH(17, 1) res_fix_phase(p); PHEND
  PH(18, 1) gemm_phase<EPI_FF1>(p, WSB(O_XB), 1024, WSB(O_WF11), 1024, 1024, 4096, WSO(O_H), 4096, 0, 0); PHEND
  PH(19, 1) gemm_phase<EPI_RES>(p, WSB(O_H), 4096, WSB(O_WF21), 4096, 4096, 1024, WSO(O_XB), 1024, 0, 0); PHEND
  PH(20, 1) res_fix_phase(p); PHEND
  PH(21, 1) final_phase(p); PHEND
}

extern "C" void kernel_launch(void* const* d_in, const int* in_sizes, int n_in, void* d_out, int out_size, void* d_ws,
                              size_t ws_size, hipStream_t stream) {
  static int grid_blocks = 0;
  if (!grid_blocks) {
    int dev = 0, cus = 0, per_cu = 0;
    hipGetDevice(&dev);
    hipDeviceGetAttribute(&cus, hipDeviceAttributeMultiprocessorCount, dev);
    hipOccupancyMaxActiveBlocksPerMultiprocessor(&per_cu, mega, 512, 0);
    if (per_cu < 1) per_cu = 1;
    grid_blocks = cus;
    if (grid_blocks > cus * per_cu) grid_blocks = cus * per_cu;
    if (ws_size < WS_NEED) fprintf(stderr, "workspace too small: %zu < %zu\n", ws_size, (size_t)WS_NEED);
  }
  Params p{};
  for (int i = 0; i < 41; i++) p.in[i] = (const float*)d_in[i];
  p.out = (float*)d_out;
  p.ws = (char*)d_ws;
  int plo = 0, phi = NPHASE - 1;
  void* args[] = {&p, &plo, &phi};
  hipError_t e = hipLaunchCooperativeKernel((void*)mega, dim3(grid_blocks), dim3(512), args, 0, stream);
  if (e != hipSuccess) fprintf(stderr, "cooperative launch failed: %s (grid %d)\n", hipGetErrorString(e), grid_blocks);
}
```

```cpp
#include <hip/hip_runtime.h>
#include <hip/hip_cooperative_groups.h>
#include <cstdio>
namespace cg = cooperative_groups;

typedef unsigned short u16;
typedef __attribute__((ext_vector_type(8))) short bf16x8;
typedef __attribute__((ext_vector_type(16))) float f32x16;

constexpr int MT = 16896;
constexpr int NP = 16384;

struct Params {
  const float* in[41];
  float* out;
  char* ws;
};

constexpr size_t OUT_Y = 0;
constexpr size_t OUT_PPOOL = (size_t)MT * 1024;
constexpr size_t OUT_PSHIFT = OUT_PPOOL + 8 * 15 * 256;
constexpr size_t OUT_PWKV = OUT_PSHIFT + 8 * 2560;
constexpr size_t OUT_PCONV = OUT_PWKV + 8 * 12 * 4096;
constexpr size_t OUT_PLRU = OUT_PCONV + 8 * 3 * 512;
constexpr size_t OUT_SPOOL = OUT_PLRU + 8 * 512;
constexpr size_t OUT_SSHIFT = OUT_SPOOL + 128 * 15 * 256;
constexpr size_t OUT_SWKV = OUT_SSHIFT + 128 * 2560;
constexpr size_t OUT_SCONV = OUT_SWKV + (size_t)128 * 12 * 4096;
constexpr size_t OUT_SLRU = OUT_SCONV + 128 * 3 * 512;
constexpr size_t OUT_SGV = OUT_SLRU + 128 * 512;

constexpr size_t O_WIN0 = 0;
constexpr size_t O_WOUT0 = O_WIN0 + 2816ull * 1024 * 2;
constexpr size_t O_WF10 = O_WOUT0 + 1024ull * 1024 * 2;
constexpr size_t O_WF20 = O_WF10 + 4096ull * 1024 * 2;
constexpr size_t O_WIN1 = O_WF20 + 4096ull * 1024 * 2;
constexpr size_t O_WOUT1 = O_WIN1 + 2048ull * 1024 * 2;
constexpr size_t O_WF11 = O_WOUT1 + 1024ull * 1024 * 2;
constexpr size_t O_WF21 = O_WF11 + 4096ull * 1024 * 2;
constexpr size_t O_WLW = O_WF21 + 4096ull * 1024 * 2;
constexpr size_t O_WLA = O_WLW + 768 * 64 * 2;
constexpr size_t O_WLG = O_WLA + 768 * 64 * 2;
constexpr size_t O_WM = O_WLG + 768 * 128 * 2;
constexpr size_t O_CNT = O_WM + 4 * 128 * 128 * 2;
constexpr size_t O_PART = O_CNT + 256;
constexpr size_t O_XB = O_PART + (size_t)MT * 16 * 4;
constexpr size_t O_Y = O_XB + (size_t)MT * 1024 * 2;
constexpr size_t O_AR = O_Y + (size_t)MT * 1024 * 2;
constexpr size_t O_P = O_AR;
constexpr size_t O_LIN = O_P + (size_t)MT * 2816 * 2;
constexpr size_t O_WPRE = O_LIN + (size_t)MT * 256 * 2;
constexpr size_t O_APRE = O_XB;
constexpr size_t O_BS = O_APRE + (size_t)MT * 768 * 2;
constexpr size_t O_CA = O_AR + (size_t)MT * 2048 * 2;
constexpr size_t O_HL = O_CA + (size_t)MT * 512 * 4;
constexpr size_t O_SEG = O_HL + (size_t)MT * 512 * 4;
constexpr size_t O_H = O_AR;
constexpr size_t O_XBAR = O_SEG + (size_t)1056 * 1024 * 4;
constexpr size_t O_CAR = O_XBAR + 16384;
constexpr size_t O_WXT = O_CAR + (size_t)1024 * 512 * 4;
constexpr size_t WS_NEED = O_WXT + 131072;

__device__ __forceinline__ u16 f2bf(float f) {
  __bf16 h = (__bf16)f;
  return __builtin_bit_cast(u16, h);
}
__device__ __forceinline__ float bf2f(u16 h) { return __uint_as_float(((unsigned)h) << 16); }
__device__ __forceinline__ float frcp_(float x) { return __builtin_amdgcn_rcpf(x); }
__device__ __forceinline__ float sigmoidf_(float x) { return frcp_(1.0f + __expf(-x)); }
__device__ __forceinline__ float tanhf_(float x) {
  float e = __expf(2.0f * x);
  return 1.0f - 2.0f * frcp_(1.0f + e);
}
__device__ __forceinline__ float geluf_(float x) {
  float y = 0.7978845608028654f * (x + 0.044715f * x * x * x);
  return 0.5f * x * (1.0f + tanhf_(y));
}
template <int CTRL>
__device__ __forceinline__ float dppmov(float v) {
  return __int_as_float(__builtin_amdgcn_update_dpp(0, __float_as_int(v), CTRL, 0xF, 0xF, true));
}
__device__ __forceinline__ float reduce8(float v) {
  v += dppmov<0xB1>(v);
  v += dppmov<0x4E>(v);
  v += dppmov<0x141>(v);
  return v;
}
__device__ __forceinline__ float row16sum(float v) {
  v += dppmov<0xB1>(v);
  v += dppmov<0x4E>(v);
  v += dppmov<0x141>(v);
  v += dppmov<0x140>(v);
  return v;
}
__device__ __forceinline__ float wsum64(float v) {
  v = row16sum(v);
  v += __int_as_float(__builtin_amdgcn_update_dpp(0, __float_as_int(v), 0x142, 0xA, 0xF, false));
  v += __int_as_float(__builtin_amdgcn_update_dpp(0, __float_as_int(v), 0x143, 0xC, 0xF, false));
  return __int_as_float(__builtin_amdgcn_readlane(__float_as_int(v), 63));
}
__device__ __forceinline__ float hsum32(float v) {
  v = row16sum(v);
  return v + __shfl_xor(v, 16);
}
__device__ __forceinline__ const float* xrow(const Params& p, int row) {
  return row < NP ? p.in[0] + (size_t)row * 1024 : p.in[1] + (size_t)(row - NP) * 1024;
}
__device__ __forceinline__ float prevP(const Params& p, const u16* P, int row, int c) {
  const int rp = row > 0 ? row - 1 : 0;
  float v = bf2f(P[(size_t)rp * 2816 + 256 + c]);
  const bool start = (row < NP) ? ((row & 2047) == 0) : (((row - NP) & 3) == 0);
  if (start) v = (row < NP) ? 0.f : p.in[3][(size_t)((row - NP) >> 2) * 2560 + c];
  return v;
}

__shared__ __attribute__((aligned(16))) unsigned char smem[114688];
#define RAW_BARRIER() do { asm volatile("s_waitcnt lgkmcnt(0)" ::: "memory"); __builtin_amdgcn_s_barrier(); asm volatile("" ::: "memory"); } while (0)
__shared__ int s_task;
__shared__ int s_simdcnt[4];
__shared__ int s_role[8];
__shared__ int s_role2[8];

#define XB_TMO      128
#define XB_XCNT(j)  (256  + 64 * (j))
#define XB_XSUB(j)  (1280 + 64 * (j))
#define XB_XGEN(j)  (2304 + 64 * (j))
#define XB_TOP      3328
#define XB_TOPGEN   3392
#define XCD_BAR_WORDS 3456
#define XB_SPIN_CAP (1u << 18)
#define LAS __attribute__((address_space(3)))

__device__ __forceinline__ unsigned xb_ld(unsigned* p)              { return __hip_atomic_load(p, __ATOMIC_RELAXED, __HIP_MEMORY_SCOPE_AGENT); }
__device__ __forceinline__ unsigned xb_add(unsigned* p, unsigned v) { return __hip_atomic_fetch_add(p, v, __ATOMIC_RELAXED, __HIP_MEMORY_SCOPE_AGENT); }
__device__ __forceinline__ unsigned xb_xcc_id() { return (unsigned)__builtin_amdgcn_s_getreg((3 << 11) | 20) & 0xFu; }
#define XB_SPIN(cond, bar) do { unsigned _sp = 0; while (cond) { __builtin_amdgcn_s_sleep(1); \
    if ((++_sp & 255u) == 0u) { if (xb_ld(&(bar)[XB_TMO])) break; if (_sp > XB_SPIN_CAP) { atomicAdd(&(bar)[XB_TMO], 1u); break; } } } } while (0)

struct XcdBarrier {
    unsigned* bar; unsigned x;
    volatile LAS unsigned* st;
};

__device__ __forceinline__ XcdBarrier xcd_barrier_post(unsigned* bar, volatile LAS unsigned* st) {
    XcdBarrier b; b.bar = bar; b.x = xb_xcc_id(); b.st = st;
    if (threadIdx.x == 0) (void)xb_add(&bar[XB_XCNT(b.x)], 1u);
    return b;
}
__device__ __forceinline__ void xcd_barrier_complete(unsigned* bar, unsigned x, unsigned& nloc, unsigned& nx) {
    const unsigned G = gridDim.x * gridDim.y * gridDim.z;
    unsigned sum, cnt, mine, sp = 0u;
    for (;;) {
        sum = 0u; cnt = 0u; mine = 0u;
#pragma unroll
        for (unsigned j = 0; j < 16; ++j) { const unsigned c = xb_ld(&bar[XB_XCNT(j)]); sum += c; cnt += (c > 0u) ? 1u : 0u; mine = (j == x) ? c : mine; }
        if (sum == G) break;
        __builtin_amdgcn_s_sleep(1);
        if ((++sp & 255u) == 0u) { if (xb_ld(&bar[XB_TMO])) break; if (sp > XB_SPIN_CAP) { atomicAdd(&bar[XB_TMO], 1u); break; } }
    }
    nloc = mine > 0u ? mine : 1u; nx = cnt > 0u ? cnt : 1u;
}

__device__ __forceinline__ void xcd_barrier(const XcdBarrier& b) {
    asm volatile("s_waitcnt vmcnt(0)" ::: "memory");
    __syncthreads();
    if (threadIdx.x == 0) {
        unsigned* bar = b.bar;
        __builtin_amdgcn_s_waitcnt(0);
        unsigned nloc = b.st[0], nx = b.st[1];
        if (nloc == 0u) { xcd_barrier_complete(bar, b.x, nloc, nx); b.st[0] = nloc; b.st[1] = nx; }
        const unsigned old = xb_add(&bar[XB_XSUB(b.x)], 1u);
        const unsigned gen = old / nloc;
        if (old + 1u == (gen + 1u) * nloc) {
            __builtin_amdgcn_fence(__ATOMIC_RELEASE, "agent");
            asm volatile("s_waitcnt vmcnt(0)" ::: "memory");
            const unsigned og = xb_add(&bar[XB_TOP], 1u);
            const unsigned tg = og / nx;
            if (og + 1u == (tg + 1u) * nx) xb_add(&bar[XB_TOPGEN], 1u);
            else XB_SPIN(xb_ld(&bar[XB_TOPGEN]) == tg, bar);
            __builtin_amdgcn_fence(__ATOMIC_ACQUIRE, "agent");
            xb_add(&bar[XB_XGEN(b.x)], 1u);
            asm volatile("s_waitcnt vmcnt(0)" ::: "memory");
        } else {
            XB_SPIN(xb_ld(&bar[XB_XGEN(b.x)]) == gen, bar);
            __builtin_amdgcn_fence(__ATOMIC_ACQUIRE, "agent");
            asm volatile("s_waitcnt vmcnt(0)" ::: "memory");
        }
    }
    __syncthreads();
}


__device__ __forceinline__ void convT(const float* __restrict__ W, int K, int N, const float* __restrict__ g, u16* __restrict__ WT) {
  float* t = (float*)smem;
  const int tilesN = N / 128, tiles = (K / 64) * tilesN;
  const int tx = threadIdx.x & 127, ty = threadIdx.x >> 7;
  const int sx = threadIdx.x & 63, sy = threadIdx.x >> 6;
  for (int tl = blockIdx.x; tl < tiles; tl += gridDim.x) {
    const int k0 = (tl / tilesN) * 64, n0 = (tl % tilesN) * 128;
    float v[16];
#pragma unroll
    for (int i = 0; i < 16; i++) v[i] = W[(size_t)(k0 + ty + 4 * i) * N + n0 + tx];
    if (g) {
#pragma unroll
      for (int i = 0; i < 16; i++) v[i] *= g[k0 + ty + 4 * i];
    }
    __syncthreads();
#pragma unroll
    for (int i = 0; i < 16; i++) t[(ty + 4 * i) * 129 + tx] = v[i];
    __syncthreads();
#pragma unroll
    for (int i = 0; i < 16; i++) {
      const int n = sy + 8 * i;
      WT[(size_t)(n0 + n) * K + k0 + sx] = f2bf(t[sx * 129 + n]);
    }
  }
}

__device__ __forceinline__ void phase0(const Params& p) {
  char* ws = p.ws;
  convT(p.in[8], 1024, 2816, p.in[7], (u16*)(ws + O_WIN0));
  convT(p.in[22], 1024, 1024, nullptr, (u16*)(ws + O_WOUT0));
  convT(p.in[38], 1024, 4096, p.in[37], (u16*)(ws + O_WF10));
  convT(p.in[39], 4096, 1024, nullptr, (u16*)(ws + O_WF20));
  convT(p.in[24], 1024, 2048, p.in[23], (u16*)(ws + O_WIN1));
  convT(p.in[36], 1024, 1024, nullptr, (u16*)(ws + O_WOUT1));
  convT(p.in[38] + (size_t)1024 * 4096, 1024, 4096, p.in[37] + 1024, (u16*)(ws + O_WF11));
  convT(p.in[39] + (size_t)1024 * 4096, 4096, 1024, nullptr, (u16*)(ws + O_WF21));
  convT(p.in[13], 64, 768, nullptr, (u16*)(ws + O_WLW));
  convT(p.in[15], 64, 768, nullptr, (u16*)(ws + O_WLA));
  convT(p.in[16], 128, 768, nullptr, (u16*)(ws + O_WLG));
  {
    u16* wm = (u16*)(ws + O_WM);
    const float* wsrc = p.in[27];
    for (int e = blockIdx.x * 512 + threadIdx.x; e < 4 * 128 * 128; e += gridDim.x * 512) {
      int i = (e >> 7) & 127, j = e & 127;
      wm[e] = (j <= i) ? f2bf(wsrc[e]) : (u16)0;
    }
  }
  {
    u16* wxt = (u16*)(ws + O_WXT);
    for (int e = blockIdx.x * 512 + threadIdx.x; e < 16 * 64 * 64; e += gridDim.x * 512) {
      const int m = e >> 12, d = (e >> 6) & 63, c = e & 63;
      const float* src = (m < 8) ? p.in[31] : p.in[33];
      wxt[e] = f2bf(src[(m & 7) * 4096 + c * 64 + d]);
    }
  }
  if (blockIdx.x == 0 && threadIdx.x < 64) ((int*)(ws + O_CNT))[threadIdx.x] = 0;
  if (blockIdx.x == 1) for (int e = threadIdx.x; e < 3456; e += 512) ((unsigned*)(ws + O_XBAR))[e] = 0u;
  for (int e = blockIdx.x * 512 + threadIdx.x; e < 512 * 256; e += gridDim.x * 512) ((float4*)(p.out + (size_t)NP * 1024))[e] = ((const float4*)p.in[1])[e];
  {
    u16* xb = (u16*)(ws + O_XB);
    float* part = (float*)(ws + O_PART);
    const int lane = threadIdx.x & 63, wave = threadIdx.x >> 6;
    for (int row = blockIdx.x * 8 + wave; row < MT; row += gridDim.x * 8) {
      const float* xr = xrow(p, row);
      float ss = 0.f;
#pragma unroll
      for (int i = 0; i < 4; i++) {
        float4 v = *(const float4*)(xr + i * 256 + lane * 4);
        ss += v.x * v.x + v.y * v.y + v.z * v.z + v.w * v.w;
        ushort4 o;
        o.x = f2bf(v.x); o.y = f2bf(v.y); o.z = f2bf(v.z); o.w = f2bf(v.w);
        *(ushort4*)(xb + (size_t)row * 1024 + i * 256 + lane * 4) = o;
      }
      ss = wsum64(ss);
      if (lane < 16) part[(size_t)row * 16 + lane] = (lane == 0) ? ss : 0.f;
    }
  }
}

enum { EPI_SCALE = 0, EPI_PLAIN = 1, EPI_FF1 = 2, EPI_RES = 3, EPI_POST = 4 };

template <int EPI>
__device__ __forceinline__ void gemm_epi(const Params& p, const f32x16 acc0, const f32x16 acc1, int mi, int wm, int wn, int lane,
                                         int m0, int nt, int c0, int c1, const float* sRs, u16* __restrict__ outb, int ldo,
                                         int resid_in) {
  float* part = (float*)(p.ws + O_PART);
  float* xf = p.out;
    const int rbase = wm * 64 + mi * 32 + 4 * (lane >> 5);
    if (EPI == EPI_SCALE || EPI == EPI_PLAIN || EPI == EPI_FF1) {
#pragma unroll
      for (int i = 0; i < 16; i++) {
        const int rl = rbase + (i & 3) + 8 * (i >> 2);
        const int row = m0 + rl;
        float v0 = acc0[i], v1 = acc1[i];
        if (EPI != EPI_PLAIN) { float rs = sRs[rl]; v0 *= rs; v1 *= rs; }
        if (EPI == EPI_FF1) { v0 = fmaxf(v0, 0.f); v1 = fmaxf(v1, 0.f); v0 *= v0; v1 *= v1; }
        outb[(size_t)row * ldo + c0] = f2bf(v0);
        outb[(size_t)row * ldo + c1] = f2bf(v1);
      }
    } else if (EPI == EPI_RES) {
#pragma unroll
      for (int i = 0; i < 16; i++) {
        const int rl = rbase + (i & 3) + 8 * (i >> 2);
        const int row = m0 + rl;
        float v0 = acc0[i], v1 = acc1[i];
        xf[(size_t)row * 1024 + c0] = v0;
        xf[(size_t)row * 1024 + c1] = v1;
        outb[(size_t)row * 1024 + c0] = f2bf(v0);
        outb[(size_t)row * 1024 + c1] = f2bf(v1);
        float s = hsum32(v0 * v0 + v1 * v1);
        if ((lane & 31) == 0) part[(size_t)row * 16 + nt * 2 + wn] = s;
      }
    } else {
      const int hh = nt * 2 + wn;
      const u16* P = (const u16*)(p.ws + O_P);
      u16* Y = (u16*)(p.ws + O_Y);
      const float* bs = (const float*)(p.ws + O_BS);
      const int ch0 = hh * 64 + (lane & 31), ch1 = ch0 + 32;
      const float gg0 = p.in[20][ch0], gg1 = p.in[20][ch1];
      const float gb0 = p.in[21][ch0], gb1 = p.in[21][ch1];
      const float mu0 = p.in[11][1536 + ch0], mu1 = p.in[11][1536 + ch1];
#pragma unroll 8
      for (int i = 0; i < 16; i++) {
        const int rl = rbase + (i & 3) + 8 * (i >> 2);
        const int row = m0 + rl;
        float o0 = bf2f(Y[(size_t)row * 1024 + 256 + ch0]);
        float o1 = bf2f(Y[(size_t)row * 1024 + 256 + ch1]);
        float mean = hsum32(o0 + o1) * (1.0f / 64.0f);
        float d0 = o0 - mean, d1 = o1 - mean;
        float var = hsum32(d0 * d0 + d1 * d1) * (1.0f / 64.0f);
        float rstd = rsqrtf(var + 64e-5f);
        float pv0 = bf2f(P[(size_t)row * 2816 + 256 + 1536 + ch0]);
        float pv1 = bf2f(P[(size_t)row * 2816 + 256 + 1536 + ch1]);
        float pp0 = prevP(p, P, row, 1536 + ch0), pp1 = prevP(p, P, row, 1536 + ch1);
        float vv0 = pv0 + (pp0 - pv0) * mu0, vv1 = pv1 + (pp1 - pv1) * mu1;
        float b = bs[((size_t)row * 12 + hh) * 4 + 2];
        float y0 = (d0 * rstd * gg0 + gb0 + b * vv0) * acc0[i];
        float y1 = (d1 * rstd * gg1 + gb1 + b * vv1) * acc1[i];
        Y[(size_t)row * 1024 + 256 + ch0] = f2bf(y0);
        Y[(size_t)row * 1024 + 256 + ch1] = f2bf(y1);
      }
    }
}

template <int EPI>
__device__ __forceinline__ void gemm_phase(const Params& p, const u16* __restrict__ A, int lda, const u16* __restrict__ BT, int ldb,
                           int K, int N, u16* __restrict__ outb, int ldo, int resid_in, int boff) {
  constexpr int LS = 72;
  constexpr int SA = 256 * LS, SB = 128 * LS, STG = SA + SB;
  u16* sm = (u16*)smem;
  float* sRs = (float*)(sm + 2 * STG);
  const int tid = threadIdx.x, lane = tid & 63, wave = tid >> 6;
  const int wm = wave >> 1, wn = wave & 1;
  const int lrow = tid >> 3, lch = tid & 7;
  const int NT = N / 128;
  const int tiles = (MT / 256) * NT;
  const int KTALL = K / 64;
  float* part = (float*)(p.ws + O_PART);
  int bstart = (int)blockIdx.x - boff;
  if (bstart < 0) bstart += gridDim.x;
  const size_t a64 = (size_t)64 * lda, b64 = (size_t)64 * ldb;
  const int G = gridDim.x;
  int t_full = tiles, split = 1;
  if (EPI == EPI_RES) {
    const int tail = tiles % G;
    if (tail > 0 && (G % tail) == 0 && (KTALL % (G / tail)) == 0) { t_full = tiles - tail; const int smax = (KTALL >= 64) ? 8 : 4; split = (G / tail) > smax ? smax : (G / tail); }
  }
  const int units = t_full + (tiles - t_full) * split;
  for (int un = bstart; un < units; un += G) {
    int tl = un, kbeg = 0, KT = KTALL;
    bool part_unit = false;
    if (un >= t_full) { const int v = un - t_full; tl = t_full + v / split; KT = KTALL / split; kbeg = (v % split) * KT; part_unit = true; }
    int mt = tl / NT, nt = tl % NT;
    if (EPI == EPI_RES && NT == 8 && G == 256 && !part_unit) {
      const int rr = tl >> 8, bb = tl & 255;
      const int xx = bb & 7, jj = bb >> 3;
      mt = rr * 32 + xx * 4 + (jj >> 3);
      nt = jj & 7;
    } else if ((EPI == EPI_FF1 || EPI == EPI_SCALE) && G == 256 && (NT == 32 || NT == 16) && tl < (tiles & ~255)) {
      const int rr = tl >> 8, bb = tl & 255;
      const int xx = bb & 7, jj = bb >> 3;
      if (NT == 32) { mt = rr * 8 + (xx >> 2) * 4 + (jj >> 3); nt = (xx & 3) * 8 + (jj & 7); }
      else { mt = rr * 16 + (xx >> 1) * 4 + (jj >> 3); nt = (xx & 1) * 8 + (jj & 7); }
    }
    const int m0 = mt * 256, n0 = nt * 128;
    const u16* gA = A + (size_t)(m0 + lrow) * lda + lch * 8 + (size_t)kbeg * 64;
    const u16* gB = BT + (size_t)(n0 + lrow) * ldb + lch * 8 + (size_t)kbeg * 64;
    uint4 xa0, xa1, xa2, xa3, xb0, xb1;
    uint4 ya0, ya1, ya2, ya3, yb0, yb1;
#define LOADX(kt_) { const u16* qa = gA + (kt_) * 64; const u16* qb = gB + (kt_) * 64; \
    xa0 = *(const uint4*)qa; xa1 = *(const uint4*)(qa + a64); xa2 = *(const uint4*)(qa + 2 * a64); xa3 = *(const uint4*)(qa + 3 * a64); \
    xb0 = *(const uint4*)qb; xb1 = *(const uint4*)(qb + b64); }
#define LOADY(kt_) { const u16* qa = gA + (kt_) * 64; const u16* qb = gB + (kt_) * 64; \
    ya0 = *(const uint4*)qa; ya1 = *(const uint4*)(qa + a64); ya2 = *(const uint4*)(qa + 2 * a64); ya3 = *(const uint4*)(qa + 3 * a64); \
    yb0 = *(const uint4*)qb; yb1 = *(const uint4*)(qb + b64); }
#define WRITEX(st_) { u16* wa = sm + (st_) * STG + lrow * LS + lch * 8; u16* wb = wa + SA; \
    *(uint4*)wa = xa0; *(uint4*)(wa + 64 * LS) = xa1; *(uint4*)(wa + 128 * LS) = xa2; *(uint4*)(wa + 192 * LS) = xa3; \
    *(uint4*)wb = xb0; *(uint4*)(wb + 64 * LS) = xb1; }
#define WRITEY(st_) { u16* wa = sm + (st_) * STG + lrow * LS + lch * 8; u16* wb = wa + SA; \
    *(uint4*)wa = ya0; *(uint4*)(wa + 64 * LS) = ya1; *(uint4*)(wa + 128 * LS) = ya2; *(uint4*)(wa + 192 * LS) = ya3; \
    *(uint4*)wb = yb0; *(uint4*)(wb + 64 * LS) = yb1; }
#define COMPUTE(st_) { const u16* ab = sm + (st_) * STG + (wm * 64 + (lane & 31)) * LS + (lane >> 5) * 8; \
    const u16* bb = sm + (st_) * STG + SA + (wn * 64 + (lane & 31)) * LS + (lane >> 5) * 8; \
    _Pragma("unroll") for (int ks = 0; ks < 4; ks++) { \
      bf16x8 fa0 = *(const bf16x8*)(ab + ks * 16); bf16x8 fa1 = *(const bf16x8*)(ab + 32 * LS + ks * 16); \
      bf16x8 fb0 = *(const bf16x8*)(bb + ks * 16); bf16x8 fb1 = *(const bf16x8*)(bb + 32 * LS + ks * 16); \
      acc00 = __builtin_amdgcn_mfma_f32_32x32x16_bf16(fa0, fb0, acc00, 0, 0, 0); \
      acc01 = __builtin_amdgcn_mfma_f32_32x32x16_bf16(fa0, fb1, acc01, 0, 0, 0); \
      acc10 = __builtin_amdgcn_mfma_f32_32x32x16_bf16(fa1, fb0, acc10, 0, 0, 0); \
      acc11 = __builtin_amdgcn_mfma_f32_32x32x16_bf16(fa1, fb1, acc11, 0, 0, 0); } }
    LOADX(0);
    if (KT > 1) LOADY(1);
    f32x16 acc00, acc01, acc10, acc11;
    if (EPI == EPI_RES && !part_unit) {
      const int cc0 = n0 + wn * 64 + (lane & 31);
      float* xfq = p.out;
#pragma unroll
      for (int i = 0; i < 16; i++) {
        const int row = m0 + wm * 64 + 4 * (lane >> 5) + (i & 3) + 8 * (i >> 2);
        const float* ra = resid_in ? xrow(p, row) : (xfq + (size_t)row * 1024);
        const float* rb = resid_in ? xrow(p, row + 32) : (xfq + (size_t)(row + 32) * 1024);
        acc00[i] = ra[cc0]; acc01[i] = ra[cc0 + 32];
        acc10[i] = rb[cc0]; acc11[i] = rb[cc0 + 32];
      }
    } else {
#pragma unroll
      for (int i = 0; i < 16; i++) { acc00[i] = 0.f; acc01[i] = 0.f; acc10[i] = 0.f; acc11[i] = 0.f; }
    }
    __syncthreads();
    if (EPI == EPI_SCALE || EPI == EPI_FF1) {
      if (tid < 256) {
        const float4* pp = (const float4*)(part + (size_t)(m0 + tid) * 16);
        float4 a = pp[0], b = pp[1], c = pp[2], d = pp[3];
        float s = (a.x + a.y + a.z + a.w) + (b.x + b.y + b.z + b.w) + (c.x + c.y + c.z + c.w) + (d.x + d.y + d.z + d.w);
        sRs[tid] = rsqrtf(s * (1.0f / 1024.0f) + 1e-6f);
      }
    }
    WRITEX(0);
    if (KT > 2) LOADX(2);
    RAW_BARRIER();
    for (int kt = 0; kt < KT; kt += 2) {
      if (kt + 1 < KT) WRITEY(1);
      if (kt + 3 < KT) LOADY(kt + 3);
      COMPUTE(0);
      RAW_BARRIER();
      if (kt + 1 >= KT) break;
      if (kt + 2 < KT) WRITEX(0);
      if (kt + 4 < KT) LOADX(kt + 4);
      COMPUTE(1);
      RAW_BARRIER();
    }
#undef LOADX
#undef LOADY
#undef WRITEX
#undef WRITEY
#undef COMPUTE
    const int c0 = n0 + wn * 64 + (lane & 31);
    const int c1 = c0 + 32;
    if (EPI == EPI_RES && part_unit) {
      float* xfp = p.out;
#pragma unroll
      for (int i = 0; i < 16; i++) {
        const int rl = wm * 64 + 4 * (lane >> 5) + (i & 3) + 8 * (i >> 2);
        float* r0p = xfp + (size_t)(m0 + rl) * 1024;
        float* r1p = r0p + (size_t)32 * 1024;
        atomicAdd(r0p + c0, acc00[i]); atomicAdd(r0p + c1, acc01[i]);
        atomicAdd(r1p + c0, acc10[i]); atomicAdd(r1p + c1, acc11[i]);
      }
    } else {
      gemm_epi<EPI>(p, acc00, acc01, 0, wm, wn, lane, m0, nt, c0, c1, sRs, outb, ldo, resid_in);
      gemm_epi<EPI>(p, acc10, acc11, 1, wm, wn, lane, m0, nt, c0, c1, sRs, outb, ldo, resid_in);
    }
  }
}

__device__ __forceinline__ void pool_item(const Params& p, int it) {
  const u16* P = (const u16*)(p.ws + O_P);
  u16* Y = (u16*)(p.ws + O_Y);
  float* hist = (float*)smem;
  float* dS = hist + 47 * 256;
  const int tid = threadIdx.x;
  const int col = tid & 255, hf = tid >> 8;
  const int gi = col >> 6, dd = col & 63;
  const int w = 2 << gi;
  const float* pw = p.in[9] + gi * 4096 + dd;
  const float sc = p.in[10][col];
  {
    int r0, t0, nrows, pos0;
    const float* st = nullptr;
    const float* shs = nullptr;
    if (it < 512) { r0 = it * 32; t0 = r0 & 2047; nrows = 32; pos0 = t0; }
    else { const int b = it - 512; r0 = NP + b * 4; t0 = 0; nrows = 4; pos0 = 16384; st = p.in[2] + (size_t)b * 3840; shs = p.in[3] + (size_t)b * 2560; }
    __syncthreads();
    const int nh = 15 + nrows;
#pragma unroll 8
    for (int hr = hf; hr < nh; hr += 2) {
      const int t = t0 - 15 + hr;
      float v = 0.f;
      if (t >= 0) v = bf2f(P[(size_t)(r0 - t0 + t) * 2816 + col]);
      else if (st) v = st[(15 + t) * 256 + col];
      hist[hr * 256 + col] = v;
    }
    __syncthreads();
    const int q0 = hf * 16;
    for (int q = 0; q < 16; q++) {
      const int tk = q0 + q;
      if (tk < nrows) {
        float s = 0.f;
        for (int i = 0; i < w; i++) s += hist[(15 + tk - i) * 256 + col];
        const float cnt = (float)min(w, pos0 + tk + 1);
        dS[tk * 256 + col] = s / cnt - hist[(15 + tk) * 256 + col];
      }
    }
    __syncthreads();
    float acc[16];
#pragma unroll
    for (int q = 0; q < 16; q++) acc[q] = 0.f;
    if (q0 < nrows) {
#pragma unroll 4
      for (int c = 0; c < 64; c += 4) {
        float w0 = pw[(c + 0) * 64], w1 = pw[(c + 1) * 64], w2 = pw[(c + 2) * 64], w3 = pw[(c + 3) * 64];
#pragma unroll
        for (int q = 0; q < 16; q++) {
          float4 d = *(const float4*)(dS + (q0 + q) * 256 + gi * 64 + c);
          acc[q] += d.x * w0 + d.y * w1 + d.z * w2 + d.w * w3;
        }
      }
    }
#pragma unroll
    for (int q = 0; q < 16; q++) {
      if (q0 + q < nrows) Y[(size_t)(r0 + q0 + q) * 1024 + col] = f2bf(acc[q] * sc);
    }
  }
}

__device__ __forceinline__ void pool_phase(const Params& p) {
  const u16* P = (const u16*)(p.ws + O_P);
  u16* LIN = (u16*)(p.ws + O_LIN);
  const int tid = threadIdx.x;
  const int col = tid & 255, hf = tid >> 8;
  const float mu = p.in[11][2304 + col];
  for (int it = blockIdx.x; it < 512 + 128; it += gridDim.x) {
    int r0, t0, nrows;
    const float* shs = nullptr;
    if (it < 512) { r0 = it * 32; t0 = r0 & 2047; nrows = 32; }
    else { const int b = it - 512; r0 = NP + b * 4; t0 = 0; nrows = 4; shs = p.in[3] + (size_t)b * 2560; }
    const int q0 = hf * 16;
    if (q0 < nrows) {
      const int nq = min(16, nrows - q0);
      float pv[17];
      {
        const int rowp = r0 + q0 - 1;
        float v0;
        if (t0 + q0 == 0) v0 = shs ? shs[2304 + col] : 0.f;
        else v0 = bf2f(P[(size_t)rowp * 2816 + 2560 + col]);
        pv[0] = v0;
      }
#pragma unroll
      for (int q = 0; q < 16; q++) pv[q + 1] = (q < nq) ? bf2f(P[(size_t)(r0 + q0 + q) * 2816 + 2560 + col]) : 0.f;
#pragma unroll
      for (int q = 0; q < 16; q++) {
        if (q < nq) {
          float xs = pv[q + 1] + (pv[q] - pv[q + 1]) * mu;
          float v = (col < 64) ? tanhf_(xs) : ((col < 128) ? xs : sigmoidf_(xs));
          LIN[(size_t)(r0 + q0 + q) * 256 + col] = f2bf(v);
        }
      }
    }
  }
  const int gt = blockIdx.x * 512 + tid, gs = gridDim.x * 512;
  for (int e = gt; e < 8 * 15 * 256; e += gs) {
    int b = e / 3840, r = (e / 256) % 15, c = e & 255;
    p.out[OUT_PPOOL + e] = bf2f(P[(size_t)(b * 2048 + 2033 + r) * 2816 + c]);
  }
  for (int e = gt; e < 128 * 15 * 256; e += gs) {
    int b = e / 3840, r = (e / 256) % 15, c = e & 255;
    float v;
    if (r < 11) v = p.in[2][(size_t)b * 3840 + (r + 4) * 256 + c];
    else v = bf2f(P[(size_t)(NP + b * 4 + (r - 11)) * 2816 + c]);
    p.out[OUT_SPOOL + e] = v;
  }
  for (int e = gt; e < 8 * 2560; e += gs) {
    int b = e / 2560, c = e % 2560;
    p.out[OUT_PSHIFT + e] = bf2f(P[(size_t)(b * 2048 + 2047) * 2816 + 256 + c]);
  }
  for (int e = gt; e < 128 * 2560; e += gs) {
    int b = e / 2560, c = e % 2560;
    p.out[OUT_SSHIFT + e] = bf2f(P[(size_t)(NP + b * 4 + 3) * 2816 + 256 + c]);
  }
}

__device__ __forceinline__ void rwkv_prep_phase(const Params& p) {
  const u16* P = (const u16*)(p.ws + O_P);
  u16* APRE = (u16*)(p.ws + O_APRE);
  u16* WPRE = (u16*)(p.ws + O_WPRE);
  float* SC = (float*)(p.ws + O_BS);
  const int lane = threadIdx.x & 63, wave = __builtin_amdgcn_readfirstlane(threadIdx.x >> 6);
  for (int row = blockIdx.x * 8 + wave; row < MT; row += gridDim.x * 8) {
    const u16* Pr = P + (size_t)row * 2816 + 256;
#pragma unroll 12
    for (int h = 0; h < 12; h++) {
      const int ch = h * 64 + lane;
      float pr = bf2f(Pr[ch]), pk = bf2f(Pr[768 + ch]);
      float qr = prevP(p, P, row, ch), qk = prevP(p, P, row, 768 + ch);
      float wl = p.in[12][ch] + bf2f(WPRE[(size_t)row * 768 + ch]);
      float r = pr + (qr - pr) * p.in[11][ch], k = pk + (qk - pk) * p.in[11][768 + ch];
      float a = sigmoidf_(p.in[14][ch] + bf2f(APRE[(size_t)row * 768 + ch]));
      a = bf2f(f2bf(a));
      float omd = 1.0f - __expf(-0.6065306597126334f * sigmoidf_(wl));
      float kkr = k * p.in[17][ch];
      float n2 = wsum64(kkr * kkr);
      float inv = frcp_(fmaxf(__builtin_amdgcn_sqrtf(n2), 1e-12f));
      float kap = kkr * inv;
      float kp = k * (1.0f + (a - 1.0f) * p.in[18][ch]);
      float al = kap * a;
      float ar = wsum64(al * r);
      float kr = wsum64(kp * r);
      float bsum = wsum64(r * kp * p.in[19][ch]);
      APRE[(size_t)row * 768 + ch] = f2bf(a);
      WPRE[(size_t)row * 768 + ch] = f2bf(omd);
      if (lane == 0) *(float4*)(SC + ((size_t)row * 12 + h) * 4) = make_float4(ar, kr, bsum, inv);
    }
  }
}

constexpr int TC = 16;
typedef float v2f __attribute__((ext_vector_type(2)));
typedef float v4f __attribute__((ext_vector_type(4)));

struct StRaw {
  unsigned cr[2], ck[2], cv[2];
  unsigned qr[2], qk[2], qv[2];
  unsigned wp[2], ap[2];
  float inv[2], sc2[2];
  v2f s_r, s_k, s_v;
  float m;
};
struct StConst { v2f mur, muk, muv, kk_, ka_; };

__device__ __forceinline__ v2f bfpair(unsigned u) {
  v2f r;
  r.x = __uint_as_float(u << 16);
  r.y = __uint_as_float(u & 0xffff0000u);
  return r;
}

template <bool SAMPLE>
__device__ __forceinline__ void st_load(const Params& p, StRaw& R, int row0, int b, int h, int c, int sw, int lane) {
  const u16* P = (const u16*)(p.ws + O_P);
  const u16* WPRE = (const u16*)(p.ws + O_WPRE);
  const u16* APRE = (const u16*)(p.ws + O_APRE);
  const float* SC = (const float*)(p.ws + O_BS);
  const int l2 = lane & 31, tp = lane >> 5;
  const int ch = h * 64 + 2 * l2;
  const int t0 = c * TC + sw * 4;
  R.m = (t0 + tp == 0) ? 0.f : 1.f;
  if (SAMPLE) {
    const float* sp = p.in[3] + (size_t)b * 2560 + ch;
    R.s_r = *(const v2f*)sp; R.s_k = *(const v2f*)(sp + 768); R.s_v = *(const v2f*)(sp + 1536);
  }
#pragma unroll
  for (int ps = 0; ps < 2; ps++) {
    const int t = t0 + 2 * ps + tp;
    const int tq = t > 0 ? t - 1 : 0;
    const u16* Pc = P + (size_t)(row0 + t) * 2816 + 256 + ch;
    const u16* Pq = P + (size_t)(row0 + tq) * 2816 + 256 + ch;
    R.cr[ps] = *(const unsigned*)Pc; R.ck[ps] = *(const unsigned*)(Pc + 768); R.cv[ps] = *(const unsigned*)(Pc + 1536);
    R.qr[ps] = *(const unsigned*)Pq; R.qk[ps] = *(const unsigned*)(Pq + 768); R.qv[ps] = *(const unsigned*)(Pq + 1536);
    const size_t row = row0 + t;
    R.wp[ps] = *(const unsigned*)(WPRE + row * 768 + ch);
    R.ap[ps] = *(const unsigned*)(APRE + row * 768 + ch);
    R.inv[ps] = SC[(row * 12 + h) * 4 + 3];
    R.sc2[ps] = SC[(row * 12 + h) * 4 + (lane & 1)];
  }
}

template <bool SAMPLE>
__device__ __forceinline__ void st_compute(const StConst& K, const StRaw& R, int sw, int lane, float* ops, float* scal) {
  const int l2 = lane & 31, tp = lane >> 5;
#pragma unroll
  for (int ps = 0; ps < 2; ps++) {
    const int tt = sw * 4 + 2 * ps + tp;
    v2f pr = bfpair(R.cr[ps]), pk = bfpair(R.ck[ps]), pv = bfpair(R.cv[ps]);
    v2f qr = bfpair(R.qr[ps]), qk = bfpair(R.qk[ps]), qv = bfpair(R.qv[ps]);
    if (ps == 0) {
      if (SAMPLE) { if (R.m == 0.f) { qr = R.s_r; qk = R.s_k; qv = R.s_v; } }
      else { const v2f mm = {R.m, R.m}; qr *= mm; qk *= mm; qv *= mm; }
    }
    const v2f r = pr + (qr - pr) * K.mur;
    const v2f k = pk + (qk - pk) * K.muk;
    const v2f v = pv + (qv - pv) * K.muv;
    const v2f one = {1.0f, 1.0f};
    const v2f dec = one - bfpair(R.wp[ps]);
    const v2f a = bfpair(R.ap[ps]);
    const v2f iv = {R.inv[ps], R.inv[ps]};
    const v2f kap = k * K.kk_ * iv;
    const v2f kp = k * (one + (a - one) * K.ka_);
    float* o6 = ops + tt * 384 + 2 * l2;
    *(v2f*)(o6) = dec; *(v2f*)(o6 + 64) = kap * a; *(v2f*)(o6 + 128) = kp; *(v2f*)(o6 + 192) = kap; *(v2f*)(o6 + 256) = dec * r; *(v2f*)(o6 + 320) = v;
    if (l2 < 2) scal[tt * 2 + l2] = R.sc2[ps];
  }
}

struct ScD { v4f a0, a1, q0, q1; };
struct ScU { v4f w0, w1, l0, l1, k0, k1; float v; v2f sc; };
__device__ __forceinline__ void scd_load(ScD& O, const float* o6, int j8) {
  O.a0 = *(const v4f*)(o6 + 192 + j8); O.a1 = *(const v4f*)(o6 + 192 + j8 + 4);
  O.q0 = *(const v4f*)(o6 + 256 + j8); O.q1 = *(const v4f*)(o6 + 256 + j8 + 4);
}
__device__ __forceinline__ void scu_load(ScU& O, const float* o6, const float* sb, int tt, int j8, int srow) {
  O.w0 = *(const v4f*)(o6 + j8); O.w1 = *(const v4f*)(o6 + j8 + 4);
  O.l0 = *(const v4f*)(o6 + 64 + j8); O.l1 = *(const v4f*)(o6 + 64 + j8 + 4);
  O.k0 = *(const v4f*)(o6 + 128 + j8); O.k1 = *(const v4f*)(o6 + 128 + j8 + 4);
  O.v = o6[320 + srow];
  O.sc = *(const v2f*)(sb + tt * 2);
}
__device__ __forceinline__ void sc_step(const ScD& D, const ScU& U, v2f& s0, v2f& s1, v2f& s2, v2f& s3, float* obuf, int tt, int lane) {
  v2f pd2 = s0 * D.a0.lo;
  v2f qd2 = s0 * D.q0.lo;
  pd2 = s1 * D.a0.hi + pd2; qd2 = s1 * D.q0.hi + qd2;
  pd2 = s2 * D.a1.lo + pd2; qd2 = s2 * D.q1.lo + qd2;
  pd2 = s3 * D.a1.hi + pd2; qd2 = s3 * D.q1.hi + qd2;
  float pd = reduce8(pd2.x + pd2.y);
  float qd = reduce8(qd2.x + qd2.y);
  const float v = U.v;
  const float o = qd - pd * U.sc.x + v * U.sc.y;
  const v2f vv = {v, v};
  const v2f np = {-pd, -pd};
  s0 = s0 * U.w0.lo + (np * U.l0.lo + vv * U.k0.lo);
  s1 = s1 * U.w0.hi + (np * U.l0.hi + vv * U.k0.hi);
  s2 = s2 * U.w1.lo + (np * U.l1.lo + vv * U.k1.lo);
  s3 = s3 * U.w1.hi + (np * U.l1.hi + vv * U.k1.hi);
  obuf[tt * 8 + (lane >> 3)] = o;
}

template <int STEPS>
__device__ __forceinline__ void scan_steps(v2f& s0, v2f& s1, v2f& s2, v2f& s3, const float* ob, const float* sb, int j8, int srow,
                                           float* obuf, int lane) {
  ScD A, B, C;
  ScU P, Q;
  scd_load(A, ob, j8);
  scu_load(P, ob, sb, 0, j8, srow);
  scd_load(B, ob + 384, j8);
#define SC_STEP(DX_, DZ_, UX_, UZ_, tt_) { \
    if ((tt_) + 1 < STEPS) scu_load(UZ_, ob + ((tt_) + 1) * 384, sb, (tt_) + 1, j8, srow); \
    if ((tt_) + 2 < STEPS) scd_load(DZ_, ob + ((tt_) + 2) * 384, j8); \
    asm volatile("" ::: "memory"); sc_step(DX_, UX_, s0, s1, s2, s3, obuf, (tt_), lane); asm volatile("" ::: "memory"); }
  SC_STEP(A, C, P, Q, 0) SC_STEP(B, A, Q, P, 1) SC_STEP(C, B, P, Q, 2) SC_STEP(A, C, Q, P, 3)
  if (STEPS > 4) {
    SC_STEP(B, A, P, Q, 4) SC_STEP(C, B, Q, P, 5) SC_STEP(A, C, P, Q, 6) SC_STEP(B, A, Q, P, 7)
    SC_STEP(C, B, P, Q, 8) SC_STEP(A, C, Q, P, 9) SC_STEP(B, A, P, Q, 10) SC_STEP(C, B, Q, P, 11)
    SC_STEP(A, C, P, Q, 12) SC_STEP(B, A, Q, P, 13) SC_STEP(C, B, P, Q, 14) SC_STEP(A, C, Q, P, 15)
  }
#undef SC_STEP
}

__device__ __forceinline__ void scan_phase(const Params& p, int cidx, int task_lo, int task_hi) {
  float* ops = (float*)smem;
  float* scal = ops + 2 * TC * 384;
  float* obufs = scal + 2 * TC * 2;
  u16* Y = (u16*)(p.ws + O_Y);
  int* counter = (int*)(p.ws + O_CNT) + cidx;
  const int tid = threadIdx.x, lane = tid & 63, wave = __builtin_amdgcn_readfirstlane(tid >> 6);
  {
    if (tid < 4) s_simdcnt[tid] = 0;
    __syncthreads();
    if (lane == 0) {
      const int simd = (int)__builtin_amdgcn_s_getreg(2308) & 3;
      const int r = atomicAdd(&s_simdcnt[simd], 1);
      s_role[wave] = simd | (r << 4);
    }
    __syncthreads();
    if (tid == 0) {
      int ns = 0;
      for (int w = 0; w < 8; w++) ns += ((s_role[w] >> 4) == 0);
      int st = 0;
      for (int w = 0; w < 8; w++) {
        int v;
        if (ns == 4) v = ((s_role[w] >> 4) == 0) ? (s_role[w] & 3) : (4 + st++);
        else v = w;
        s_role2[w] = v;
      }
    }
    __syncthreads();
  }
  const int rolew = __builtin_amdgcn_readfirstlane(s_role2[wave]);
  const bool stat = (gridDim.x == 256 && task_lo == 0);
  bool first = true;
  while (true) {
    __syncthreads();
    if (tid == 0) s_task = (stat && first && blockIdx.x < 192) ? -1 : atomicAdd(counter, 1);
    __syncthreads();
    const int tq = __builtin_amdgcn_readfirstlane(s_task);
    first = false;
    const int task = (tq < 0) ? ((int)(blockIdx.x & 7) * 24 + (int)(blockIdx.x >> 3)) : (tq + (stat ? 192 : task_lo));
    if (task >= task_hi) break;
    int b, h, half, row0, T;
    bool sample;
    if (task < 192) { b = task / 24; h = (task % 24) >> 1; half = task & 1; row0 = b * 2048; T = 2048; sample = false; }
    else { int u = task - 192; b = u / 24; h = (u % 24) >> 1; half = u & 1; row0 = NP + b * 4; T = 4; sample = true; }
    const int nch = (T + TC - 1) / TC;
    const int sbase = half * 32 + (rolew & 3) * 8;
    const int srow = sbase + (lane >> 3);
    const int j8 = (lane & 7) * 8;
    float* obuf = obufs + (rolew & 3) * 128;
    if (rolew < 4) {
      v2f s0 = {0.f, 0.f}, s1 = s0, s2 = s0, s3 = s0;
      if (sample) {
        const float* sp = p.in[4] + ((size_t)(b * 12 + h) * 64 + srow) * 64 + j8;
        v4f x0 = *(const v4f*)sp, x1 = *(const v4f*)(sp + 4);
        s0 = x0.lo; s1 = x0.hi; s2 = x1.lo; s3 = x1.hi;
      }
      RAW_BARRIER();
      for (int c = 0; c < nch; c++) {
        const int buf = c & 1;
        const float* ob = ops + buf * TC * 384;
        const float* sb = scal + buf * TC * 2;
        if (sample) scan_steps<4>(s0, s1, s2, s3, ob, sb, j8, srow, obuf, lane);
        else scan_steps<TC>(s0, s1, s2, s3, ob, sb, j8, srow, obuf, lane);
        const int tt = lane >> 2, pr = lane & 3;
        if (tt < T) {
          v2f ov = *(const v2f*)(obuf + tt * 8 + 2 * pr);
          unsigned pk = (unsigned)f2bf(ov.x) | ((unsigned)f2bf(ov.y) << 16);
          *(unsigned*)(Y + (size_t)(row0 + c * TC + tt) * 1024 + 256 + h * 64 + sbase + 2 * pr) = pk;
        }
        RAW_BARRIER();
      }
      float* dp = p.out + (sample ? OUT_SWKV : OUT_PWKV) + ((size_t)(b * 12 + h) * 64 + srow) * 64 + j8;
      *(float4*)dp = make_float4(s0.x, s0.y, s1.x, s1.y);
      *(float4*)(dp + 4) = make_float4(s2.x, s2.y, s3.x, s3.y);
    } else {
      const int sw = rolew - 4;
      const int ch = h * 64 + 2 * (lane & 31);
      StConst K;
      K.mur = *(const v2f*)(p.in[11] + ch); K.muk = *(const v2f*)(p.in[11] + 768 + ch); K.muv = *(const v2f*)(p.in[11] + 1536 + ch);
      K.kk_ = *(const v2f*)(p.in[17] + ch); K.ka_ = *(const v2f*)(p.in[18] + ch);
      if (sample) {
        if (sw == 0) {
          StRaw RS;
          st_load<true>(p, RS, row0, b, h, 0, 0, lane);
          st_compute<true>(K, RS, 0, lane, ops, scal);
        }
        RAW_BARRIER();
        RAW_BARRIER();
      } else {
        StRaw RA, RB;
        st_load<false>(p, RA, row0, b, h, 0, sw, lane);
        st_compute<false>(K, RA, sw, lane, ops, scal);
        st_load<false>(p, RA, row0, b, h, 1, sw, lane);
        st_load<false>(p, RB, row0, b, h, 2, sw, lane);
        RAW_BARRIER();
        for (int c = 0; c < nch; c += 2) {
          st_compute<false>(K, RA, sw, lane, ops + TC * 384, scal + TC * 2);
          st_load<false>(p, RA, row0, b, h, (c + 3 < nch) ? c + 3 : c + 1, sw, lane);
          RAW_BARRIER();
          st_compute<false>(K, RB, sw, lane, ops, scal);
          st_load<false>(p, RB, row0, b, h, (c + 4 < nch) ? c + 4 : c + 2 < nch ? c + 2 : c, sw, lane);
          RAW_BARRIER();
        }
      }
    }
  }
}

__device__ __forceinline__ void pool_queue(const Params& p) {
  int* counter = (int*)(p.ws + O_CNT) + 2;
  while (true) {
    __syncthreads();
    if (threadIdx.x == 0) s_task = atomicAdd(counter, 1);
    __syncthreads();
    const int it = __builtin_amdgcn_readfirstlane(s_task);
    if (it >= 640) break;
    pool_item(p, it);
  }
}

__device__ __forceinline__ void mix1_phase(const Params& p) {
  const u16* Q = (const u16*)(p.ws + O_P);
  u16* Y = (u16*)(p.ws + O_Y);
  const u16* WM = (const u16*)(p.ws + O_WM);
  const int tid = threadIdx.x, lane = tid & 63, wave = tid >> 6;
  constexpr int N_GP = 512, N_GS = 128, N_LRU = MT / 16;
  for (int it = blockIdx.x; it < N_GP + N_GS + N_LRU; it += gridDim.x) {
    __syncthreads();
    if (it < N_GP) {
      const int h = it & 3, ck = (it >> 2) & 15, b = it >> 6;
      const int r0 = b * 2048 + ck * 128;
      u16* vT = (u16*)smem;
      {
        const u16* qb = Q + (size_t)(r0 + wave * 16) * 2048 + 512 + lane * 8;
        float lg[8], lb[8];
        if ((lane >> 4) == h) {
#pragma unroll
          for (int e = 0; e < 8; e++) { lg[e] = p.in[25][h * 128 + (lane & 15) * 8 + e]; lb[e] = p.in[26][h * 128 + (lane & 15) * 8 + e]; }
        } else {
#pragma unroll
          for (int e = 0; e < 8; e++) { lg[e] = 0.f; lb[e] = 0.f; }
        }
        uint4 cur0 = *(const uint4*)(qb), cur1 = *(const uint4*)(qb + 2048), cur2 = *(const uint4*)(qb + 2 * 2048), cur3 = *(const uint4*)(qb + 3 * 2048);
        for (int bt = 0; bt < 4; bt++) {
          uint4 nx0 = cur0, nx1 = cur1, nx2 = cur2, nx3 = cur3;
          if (bt < 3) {
            const u16* qn = qb + (size_t)(bt + 1) * 4 * 2048;
            nx0 = *(const uint4*)(qn); nx1 = *(const uint4*)(qn + 2048); nx2 = *(const uint4*)(qn + 2 * 2048); nx3 = *(const uint4*)(qn + 3 * 2048);
          }
#pragma unroll
          for (int u = 0; u < 4; u++) {
            const uint4 raw = (u == 0) ? cur0 : (u == 1) ? cur1 : (u == 2) ? cur2 : cur3;
            const int j = wave * 16 + bt * 4 + u;
            const u16* rp = (const u16*)&raw;
            float z[8];
            float sm = 0.f;
#pragma unroll
            for (int e = 0; e < 8; e++) { z[e] = geluf_(bf2f(rp[e])); sm += z[e]; }
            const float mean = wsum64(sm) * (1.0f / 512.0f);
            float s2 = 0.f;
#pragma unroll
            for (int e = 0; e < 8; e++) { z[e] -= mean; s2 += z[e] * z[e]; }
            const float rstd = rsqrtf(wsum64(s2) * (1.0f / 512.0f) + 1e-5f);
            if ((lane >> 4) == h) {
#pragma unroll
              for (int e = 0; e < 8; e++) {
                const int d = (lane & 15) * 8 + e;
                vT[d * 136 + j] = f2bf(z[e] * rstd * lg[e] + lb[e]);
              }
            }
          }
          cur0 = nx0; cur1 = nx1; cur2 = nx2; cur3 = nx3;
        }
      }
      __syncthreads();
      const int wm = wave >> 1, wn = wave & 1;
      f32x16 acc0, acc1;
#pragma unroll
      for (int i = 0; i < 16; i++) { acc0[i] = 0.f; acc1[i] = 0.f; }
      const u16* ag = WM + (size_t)h * 16384 + (size_t)(wm * 32 + (lane & 31)) * 128 + (lane >> 5) * 8;
      const u16* bb = vT + (wn * 64 + (lane & 31)) * 136 + (lane >> 5) * 8;
      const int nks = 2 * (wm + 1);
      for (int ks = 0; ks < nks; ks++) {
        bf16x8 a = *(const bf16x8*)(ag + ks * 16);
        bf16x8 b0 = *(const bf16x8*)(bb + ks * 16);
        bf16x8 b1 = *(const bf16x8*)(bb + 32 * 136 + ks * 16);
        acc0 = __builtin_amdgcn_mfma_f32_32x32x16_bf16(a, b0, acc0, 0, 0, 0);
        acc1 = __builtin_amdgcn_mfma_f32_32x32x16_bf16(a, b1, acc1, 0, 0, 0);
      }
      const int d0 = h * 128 + wn * 64 + (lane & 31), d1 = d0 + 32;
#pragma unroll 4
      for (int i = 0; i < 16; i++) {
        const int il = wm * 32 + (i & 3) + 8 * (i >> 2) + 4 * (lane >> 5);
        const int row = r0 + il;
        const float bsv = p.in[28][h * 128 + il];
        float u0 = geluf_(bf2f(Q[(size_t)row * 2048 + d0]));
        float u1 = geluf_(bf2f(Q[(size_t)row * 2048 + d1]));
        Y[(size_t)row * 1024 + d0] = f2bf(u0 * (acc0[i] + bsv));
        Y[(size_t)row * 1024 + d1] = f2bf(u1 * (acc1[i] + bsv));
      }
    } else if (it < N_GP + N_GS) {
      const int b = it - N_GP;
      const int r0 = NP + b * 4;
      float* vs = (float*)smem;
      if (wave < 4) {
        const int row = r0 + wave;
        uint4 raw = *(const uint4*)(Q + (size_t)row * 2048 + 512 + lane * 8);
        const u16* rp = (const u16*)&raw;
        float z[8];
        float s = 0.f;
#pragma unroll
        for (int e = 0; e < 8; e++) { z[e] = geluf_(bf2f(rp[e])); s += z[e]; }
        const float mean = wsum64(s) * (1.0f / 512.0f);
        float s2 = 0.f;
#pragma unroll
        for (int e = 0; e < 8; e++) { z[e] -= mean; s2 += z[e] * z[e]; }
        const float rstd = rsqrtf(wsum64(s2) * (1.0f / 512.0f) + 1e-5f);
#pragma unroll
        for (int e = 0; e < 8; e++) {
          const int d = lane * 8 + e;
          float vn = z[e] * rstd * p.in[25][d] + p.in[26][d];
          vs[wave * 512 + d] = vn;
          p.out[OUT_SGV + (size_t)(b * 4 + wave) * 512 + d] = vn;
        }
      }
      __syncthreads();
      {
        const int ch = tid, hh = ch >> 7;
        for (int i = 0; i < 4; i++) {
          float mix = p.in[28][hh * 128 + i];
          for (int j = 0; j <= i; j++) mix += p.in[27][(size_t)(hh * 128 + i) * 128 + j] * vs[j * 512 + ch];
          float u = geluf_(bf2f(Q[(size_t)(r0 + i) * 2048 + ch]));
          Y[(size_t)(r0 + i) * 1024 + ch] = f2bf(u * mix);
        }
      }
    } else {
      const int li = it - N_GP - N_GS;
      const int r0 = li * 16;
      u16* xcb = (u16*)smem;
      float* gxs = (float*)(smem + 16 * 520 * 2);
      float* gas = gxs + 16 * 512;
      const int ch = tid;
      float* CA = (float*)(p.ws + O_CA);
      float* HL = (float*)(p.ws + O_HL);
      float* SEG = (float*)(p.ws + O_SEG);
      const float cw0 = p.in[29][ch], cw1 = p.in[29][512 + ch], cw2 = p.in[29][1024 + ch], cw3 = p.in[29][1536 + ch];
      const float cb = p.in[30][ch];
      {
        float xr[19];
#pragma unroll
        for (int q = 0; q < 19; q++) {
          const int row = r0 - 3 + q;
          float v = 0.f;
          bool valid;
          int tq;
          if (r0 < NP) { tq = (r0 & 2047) - 3 + q; valid = tq >= 0; }
          else { valid = true; tq = 0; }
          if (r0 < NP) { if (valid) v = bf2f(Q[(size_t)row * 2048 + 1536 + ch]); }
          else v = bf2f(Q[(size_t)(row < NP ? NP : row) * 2048 + 1536 + ch]);
          xr[q] = v;
        }
#pragma unroll
        for (int q = 0; q < 16; q++) {
          float x0 = xr[q], x1 = xr[q + 1], x2 = xr[q + 2], x3 = xr[q + 3];
          if (r0 >= NP) {
            const int rs = r0 - NP + q;
            const int t = rs & 3;
            const float* st = p.in[5] + (size_t)(rs >> 2) * 1536 + ch;
            if (t < 3) x0 = st[t * 512];
            if (t < 2) x1 = st[(t + 1) * 512];
            if (t < 1) x2 = st[(t + 2) * 512];
          }
          const float xc = cb + cw0 * x0 + cw1 * x1 + cw2 * x2 + cw3 * x3;
          xcb[q * 520 + ch] = f2bf(xc);
        }
      }
      __syncthreads();
      {
        const u16* WXT = (const u16*)(p.ws + O_WXT);
        const int n = wave;
        typedef __attribute__((ext_vector_type(4))) float f32x4;
        f32x4 ac[8];
#pragma unroll
        for (int i = 0; i < 8; i++) { ac[i][0] = 0.f; ac[i][1] = 0.f; ac[i][2] = 0.f; ac[i][3] = 0.f; }
#pragma unroll
        for (int kh = 0; kh < 2; kh++) {
          const bf16x8 af = *(const bf16x8*)(xcb + (lane & 15) * 520 + n * 64 + kh * 32 + (lane >> 4) * 8);
          bf16x8 bfr[8];
#pragma unroll
          for (int i = 0; i < 8; i++) {
            const int w = i >> 2, dt = i & 3;
            bfr[i] = *(const bf16x8*)(WXT + ((size_t)((w * 8 + n) * 64 + dt * 16 + (lane & 15))) * 64 + kh * 32 + (lane >> 4) * 8);
          }
#pragma unroll
          for (int i = 0; i < 8; i++) ac[i] = __builtin_amdgcn_mfma_f32_16x16x32_bf16(af, bfr[i], ac[i], 0, 0, 0);
        }
#pragma unroll
        for (int i = 0; i < 8; i++) {
          const int w = i >> 2, dt = i & 3;
          float* dst = (w ? gas : gxs) + n * 64 + dt * 16 + (lane & 15);
#pragma unroll
          for (int r = 0; r < 4; r++) dst[((lane >> 4) * 4 + r) * 512] = ac[i][r];
        }
      }
      __syncthreads();
      const float bx = p.in[32][ch], ba = p.in[34][ch];
      const float lam = p.in[35][ch];
      const float spl = fmaxf(-lam, 0.f) + log1pf(__expf(-fabsf(lam)));
      float hl = 0.f, ca = 1.f;
#pragma unroll 4
      for (int q = 0; q < 16; q++) {
        const int row = r0 + q;
        if (row >= NP) {
          int rs = row - NP;
          if ((rs & 3) == 0) { hl = p.in[6][(size_t)(rs >> 2) * 512 + ch]; ca = 1.f; }
        }
        float gx = sigmoidf_(gxs[q * 512 + ch] + bx), ga = sigmoidf_(gas[q * 512 + ch] + ba);
        float la = -8.0f * ga * spl;
        float a = __expf(la);
        float bb = __builtin_amdgcn_sqrtf(fmaxf(1.0f - a * a, 0.f)) * gx * bf2f(xcb[q * 520 + ch]);
        hl = a * hl + bb;
        ca = ca * a;
        CA[(size_t)row * 512 + ch] = ca;
        HL[(size_t)row * 512 + ch] = hl;
      }
      SEG[(size_t)li * 1024 + ch] = ca;
      SEG[(size_t)li * 1024 + 512 + ch] = hl;
    }
  }
}

__device__ __forceinline__ void lru_fix_phase(const Params& p, const XcdBarrier& xb) {
  const u16* Q = (const u16*)(p.ws + O_P);
  u16* Y = (u16*)(p.ws + O_Y);
  const float* CA = (const float*)(p.ws + O_CA);
  const float* HL = (const float*)(p.ws + O_HL);
  const float* SEG = (const float*)(p.ws + O_SEG);
  const int ch = threadIdx.x;
  const bool blocked = (gridDim.x == 256);
  for (int k = 0; k < (blocked ? 1 : 0); k++) {
    const int li0 = blockIdx.x * 4;
    const int b = li0 >> 7, s0 = li0 & 127;
    const float* sg = SEG + (size_t)(b * 128) * 1024 + ch;
    float carry = 0.f;
#pragma unroll 8
    for (int q = 0; q < s0; q++) carry = sg[(size_t)q * 1024] * carry + sg[(size_t)q * 1024 + 512];
    for (int u = 0; u < 4; u++) {
      const int li = li0 + u;
      const int r0 = li * 16;
#pragma unroll 8
      for (int q = 0; q < 16; q++) {
        const int row = r0 + q;
        float hv = HL[(size_t)row * 512 + ch] + CA[(size_t)row * 512 + ch] * carry;
        float gate = geluf_(bf2f(Q[(size_t)row * 2048 + 1024 + ch]));
        Y[(size_t)row * 1024 + 512 + ch] = f2bf(hv * gate);
        if ((row & 2047) == 2047) p.out[OUT_PLRU + (size_t)(row >> 11) * 512 + ch] = hv;
      }
      carry = sg[(size_t)(s0 + u) * 1024] * carry + sg[(size_t)(s0 + u) * 1024 + 512];
    }
  }
  for (int li = (blocked ? 1024 : 0) + blockIdx.x; li < MT / 16; li += gridDim.x) {
    const int r0 = li * 16;
    float carry = 0.f;
    if (r0 < NP) {
      const int b = r0 >> 11, sN = (r0 & 2047) >> 4;
      const float* sg = SEG + (size_t)(b * 128) * 1024 + ch;
      for (int q = 0; q < sN; q++) carry = sg[(size_t)q * 1024] * carry + sg[(size_t)q * 1024 + 512];
    }
#pragma unroll 8
    for (int q = 0; q < 16; q++) {
      const int row = r0 + q;
      float hv = HL[(size_t)row * 512 + ch] + CA[(size_t)row * 512 + ch] * carry;
      float gate = geluf_(bf2f(Q[(size_t)row * 2048 + 1024 + ch]));
      Y[(size_t)row * 1024 + 512 + ch] = f2bf(hv * gate);
      if (row < NP) {
        if ((row & 2047) == 2047) p.out[OUT_PLRU + (size_t)(row >> 11) * 512 + ch] = hv;
      } else {
        int rs = row - NP;
        if ((rs & 3) == 3) p.out[OUT_SLRU + (size_t)(rs >> 2) * 512 + ch] = hv;
      }
    }
  }
  const int gt = blockIdx.x * 512 + threadIdx.x, gs = gridDim.x * 512;
  for (int e = gt; e < 8 * 3 * 512; e += gs) {
    int b = e / 1536, i = (e / 512) % 3, c = e & 511;
    p.out[OUT_PCONV + e] = bf2f(Q[(size_t)(b * 2048 + 2045 + i) * 2048 + 1536 + c]);
  }
  for (int e = gt; e < 128 * 3 * 512; e += gs) {
    int b = e / 1536, i = (e / 512) % 3, c = e & 511;
    p.out[OUT_SCONV + e] = bf2f(Q[(size_t)(NP + b * 4 + 1 + i) * 2048 + 1536 + c]);
  }
}

__device__ __forceinline__ void res_fix_phase(const Params& p) {
  u16* xb = (u16*)(p.ws + O_XB);
  float* part = (float*)(p.ws + O_PART);
  const int lane = threadIdx.x & 63, wave = threadIdx.x >> 6;
  for (int row = NP + blockIdx.x * 8 + wave; row < MT; row += gridDim.x * 8) {
    const float* xr = p.out + (size_t)row * 1024;
    float ss = 0.f;
#pragma unroll
    for (int i = 0; i < 4; i++) {
      float4 v = *(const float4*)(xr + i * 256 + lane * 4);
      ss += v.x * v.x + v.y * v.y + v.z * v.z + v.w * v.w;
      ushort4 o;
      o.x = f2bf(v.x); o.y = f2bf(v.y); o.z = f2bf(v.z); o.w = f2bf(v.w);
      *(ushort4*)(xb + (size_t)row * 1024 + i * 256 + lane * 4) = o;
    }
    ss = wsum64(ss);
    if (lane < 16) part[(size_t)row * 16 + lane] = (lane == 0) ? ss : 0.f;
  }
}

__device__ __forceinline__ void final_phase(const Params& p) {
  const float* part = (const float*)(p.ws + O_PART);
  const float* g = p.in[40];
  const int lane = threadIdx.x & 63, wave = threadIdx.x >> 6;
  for (int row = blockIdx.x * 8 + wave; row < MT; row += gridDim.x * 8) {
    float s = (lane < 16) ? part[(size_t)row * 16 + lane] : 0.f;
    s = wsum64(s);
    const float rs = rsqrtf(s * (1.0f / 1024.0f) + 1e-6f);
    float* xr = p.out + (size_t)row * 1024;
#pragma unroll
    for (int i = 0; i < 4; i++) {
      float4 v = *(float4*)(xr + i * 256 + lane * 4);
      float4 gg = *(const float4*)(g + i * 256 + lane * 4);
      v.x *= rs * gg.x; v.y *= rs * gg.y; v.z *= rs * gg.z; v.w *= rs * gg.w;
      *(float4*)(xr + i * 256 + lane * 4) = v;
    }
  }
}


constexpr int NPHASE = 22;
enum { K_P0 = 0, K_G_SCALE, K_G_PLAIN, K_G_FF1, K_G_RES, K_G_POST, K_POOL, K_SCAN, K_MIX1, K_LRUFIX, K_FINAL };

#define PH(n, sync_) if (plo <= (n) && (n) <= phi) { if ((n) > plo && (sync_)) { if ((n) == 1) { grid.sync(); xb = xcd_barrier_post((unsigned*)(ws + O_XBAR), (volatile LAS unsigned*)&xb_words); } else xcd_barrier(xb); }
#define PHEND }
#define WSB(o) ((const u16*)(ws + (o)))
#define WSO(o) ((u16*)(ws + (o)))
__global__ void __launch_bounds__(512) mega(Params p, int plo, int phi) {
  cg::grid_group grid = cg::this_grid();
  char* ws = p.ws;
  __shared__ uint4 xb_words;
  if (threadIdx.x == 0) xb_words = make_uint4(0u, 0u, 0u, 0u);
  __syncthreads();
  XcdBarrier xb; xb.bar = (unsigned*)(ws + O_XBAR); xb.x = 0; xb.st = (volatile LAS unsigned*)&xb_words;
  PH(0, 1) phase0(p); PHEND
  PH(1, 1) gemm_phase<EPI_SCALE>(p, WSB(O_XB), 1024, WSB(O_WIN0), 1024, 1024, 2816, WSO(O_P), 2816, 0, 0); PHEND
  PH(2, 1) pool_phase(p); PHEND
  PH(3, 1) gemm_phase<EPI_PLAIN>(p, WSB(O_LIN), 256, WSB(O_WLW), 64, 64, 768, WSO(O_WPRE), 768, 0, 0); PHEND
  PH(4, 0) gemm_phase<EPI_PLAIN>(p, WSB(O_LIN + 128), 256, WSB(O_WLA), 64, 64, 768, WSO(O_APRE), 768, 0, 140); PHEND
  PH(5, 1) rwkv_prep_phase(p); PHEND
  PH(6, 1) scan_phase(p, 0, 0, 3264); pool_queue(p); PHEND
  PH(7, 1) gemm_phase<EPI_POST>(p, WSB(O_LIN + 256), 256, WSB(O_WLG), 128, 128, 768, nullptr, 0, 0, 0); PHEND
  PH(8, 1) gemm_phase<EPI_RES>(p, WSB(O_Y), 1024, WSB(O_WOUT0), 1024, 1024, 1024, WSO(O_XB), 1024, 1, 0); PHEND
  PH(9, 1) res_fix_phase(p); PHEND
  PH(10, 1) gemm_phase<EPI_FF1>(p, WSB(O_XB), 1024, WSB(O_WF10), 1024, 1024, 4096, WSO(O_H), 4096, 0, 0); PHEND
  PH(11, 1) gemm_phase<EPI_RES>(p, WSB(O_H), 4096, WSB(O_WF20), 4096, 4096, 1024, WSO(O_XB), 1024, 0, 0); PHEND
  PH(12, 1) res_fix_phase(p); PHEND
  PH(13, 1) gemm_phase<EPI_SCALE>(p, WSB(O_XB), 1024, WSB(O_WIN1), 1024, 1024, 2048, WSO(O_P), 2048, 0, 0); PHEND
  PH(14, 1) mix1_phase(p); PHEND
  PH(15, 1) lru_fix_phase(p, xb); PHEND
  PH(16, 1) gemm_phase<EPI_RES>(p, WSB(O_Y), 1024, WSB(O_WOUT1), 1024, 1024, 1024, WSO(O_XB), 1024, 0, 0); PHEND
  PH(17, 1) res_fix_phase(p); PHEND
  PH(18, 1) gemm_phase<EPI_FF1>(p, WSB(O_XB), 1024, WSB(O_WF11), 1024, 1024, 4096, WSO(O_H), 4096, 0, 0); PHEND
  PH(19, 1) gemm_phase<EPI_RES>(p, WSB(O_H), 4096, WSB(O_WF21), 4096, 4096, 1024, WSO(O_XB), 1024, 0, 0); PHEND
  PH(20, 1) res_fix_phase(p); PHEND
  PH(21, 1) final_phase(p); PHEND
}

extern "C" void kernel_launch(void* const* d_in, const int* in_sizes, int n_in, void* d_out, int out_size, void* d_ws,
                              size_t ws_size, hipStream_t stream) {
  static int grid_blocks = 0;
  if (!grid_blocks) {
    int dev = 0, cus = 0, per_cu = 0;
    hipGetDevice(&dev);
    hipDeviceGetAttribute(&cus, hipDeviceAttributeMultiprocessorCount, dev);
    hipOccupancyMaxActiveBlocksPerMultiprocessor(&per_cu, mega, 512, 0);
    if (per_cu < 1) per_cu = 1;
    grid_blocks = cus;
    if (grid_blocks > cus * per_cu) grid_blocks = cus * per_cu;
    if (ws_size < WS_NEED) fprintf(stderr, "workspace too small: %zu < %zu\n", ws_size, (size_t)WS_NEED);
  }
  Params p{};
  for (int i = 0; i < 41; i++) p.in[i] = (const float*)d_in[i];
  p.out = (float*)d_out;
  p.ws = (char*)d_ws;
  int plo = 0, phi = NPHASE - 1;
  void* args[] = {&p, &plo, &phi};
  hipError_t e = hipLaunchCooperativeKernel((void*)mega, dim3(grid_blocks), dim3(512), args, 0, stream);
  if (e != hipSuccess) fprintf(stderr, "cooperative launch failed: %s (grid %d)\n", hipGetErrorString(e), grid_blocks);
}
```

```cpp
#include <hip/hip_runtime.h>
#include <hip/hip_cooperative_groups.h>
#include <cstdio>
namespace cg = cooperative_groups;

typedef unsigned short u16;
typedef __attribute__((ext_vector_type(8))) short bf16x8;
typedef __attribute__((ext_vector_type(16))) float f32x16;

constexpr int MT = 16896;
constexpr int NP = 16384;

struct Params {
  const float* in[41];
  float* out;
  char* ws;
};

constexpr size_t OUT_Y = 0;
constexpr size_t OUT_PPOOL = (size_t)MT * 1024;
constexpr size_t OUT_PSHIFT = OUT_PPOOL + 8 * 15 * 256;
constexpr size_t OUT_PWKV = OUT_PSHIFT + 8 * 2560;
constexpr size_t OUT_PCONV = OUT_PWKV + 8 * 12 * 4096;
constexpr size_t OUT_PLRU = OUT_PCONV + 8 * 3 * 512;
constexpr size_t OUT_SPOOL = OUT_PLRU + 8 * 512;
constexpr size_t OUT_SSHIFT = OUT_SPOOL + 128 * 15 * 256;
constexpr size_t OUT_SWKV = OUT_SSHIFT + 128 * 2560;
constexpr size_t OUT_SCONV = OUT_SWKV + (size_t)128 * 12 * 4096;
constexpr size_t OUT_SLRU = OUT_SCONV + 128 * 3 * 512;
constexpr size_t OUT_SGV = OUT_SLRU + 128 * 512;

constexpr size_t O_WIN0 = 0;
constexpr size_t O_WOUT0 = O_WIN0 + 2816ull * 1024 * 2;
constexpr size_t O_WF10 = O_WOUT0 + 1024ull * 1024 * 2;
constexpr size_t O_WF20 = O_WF10 + 4096ull * 1024 * 2;
constexpr size_t O_WIN1 = O_WF20 + 4096ull * 1024 * 2;
constexpr size_t O_WOUT1 = O_WIN1 + 2048ull * 1024 * 2;
constexpr size_t O_WF11 = O_WOUT1 + 1024ull * 1024 * 2;
constexpr size_t O_WF21 = O_WF11 + 4096ull * 1024 * 2;
constexpr size_t O_WLW = O_WF21 + 4096ull * 1024 * 2;
constexpr size_t O_WLA = O_WLW + 768 * 64 * 2;
constexpr size_t O_WLG = O_WLA + 768 * 64 * 2;
constexpr size_t O_WM = O_WLG + 768 * 128 * 2;
constexpr size_t O_CNT = O_WM + 4 * 128 * 128 * 2;
constexpr size_t O_PART = O_CNT + 256;
constexpr size_t O_XB = O_PART + (size_t)MT * 16 * 4;
constexpr size_t O_Y = O_XB + (size_t)MT * 1024 * 2;
constexpr size_t O_AR = O_Y + (size_t)MT * 1024 * 2;
constexpr size_t O_P = O_AR;
constexpr size_t O_LIN = O_P + (size_t)MT * 2816 * 2;
constexpr size_t O_WPRE = O_LIN + (size_t)MT * 256 * 2;
constexpr size_t O_APRE = O_XB;
constexpr size_t O_BS = O_APRE + (size_t)MT * 768 * 2;
constexpr size_t O_CA = O_AR + (size_t)MT * 2048 * 2;
constexpr size_t O_HL = O_CA + (size_t)MT * 512 * 4;
constexpr size_t O_SEG = O_HL + (size_t)MT * 512 * 4;
constexpr size_t O_H = O_AR;
constexpr size_t O_XBAR = O_SEG + (size_t)1056 * 1024 * 4;
constexpr size_t O_CAR = O_XBAR + 16384;
constexpr size_t O_WXT = O_CAR + (size_t)1024 * 512 * 4;
constexpr size_t WS_NEED = O_WXT + 131072;

__device__ __forceinline__ u16 f2bf(float f) {
  __bf16 h = (__bf16)f;
  return __builtin_bit_cast(u16, h);
}
__device__ __forceinline__ float bf2f(u16 h) { return __uint_as_float(((unsigned)h) << 16); }
__device__ __forceinline__ float frcp_(float x) { return __builtin_amdgcn_rcpf(x); }
__device__ __forceinline__ float sigmoidf_(float x) { return frcp_(1.0f + __expf(-x)); }
__device__ __forceinline__ float tanhf_(float x) {
  float e = __expf(2.0f * x);
  return 1.0f - 2.0f * frcp_(1.0f + e);
}
__device__ __forceinline__ float geluf_(float x) {
  float y = 0.7978845608028654f * (x + 0.044715f * x * x * x);
  return 0.5f * x * (1.0f + tanhf_(y));
}
template <int CTRL>
__device__ __forceinline__ float dppmov(float v) {
  return __int_as_float(__builtin_amdgcn_update_dpp(0, __float_as_int(v), CTRL, 0xF, 0xF, true));
}
__device__ __forceinline__ float reduce8(float v) {
  v += dppmov<0xB1>(v);
  v += dppmov<0x4E>(v);
  v += dppmov<0x141>(v);
  return v;
}
__device__ __forceinline__ float row16sum(float v) {
  v += dppmov<0xB1>(v);
  v += dppmov<0x4E>(v);
  v += dppmov<0x141>(v);
  v += dppmov<0x140>(v);
  return v;
}
__device__ __forceinline__ float wsum64(float v) {
  v = row16sum(v);
  v += __int_as_float(__builtin_amdgcn_update_dpp(0, __float_as_int(v), 0x142, 0xA, 0xF, false));
  v += __int_as_float(__builtin_amdgcn_update_dpp(0, __float_as_int(v), 0x143, 0xC, 0xF, false));
  return __int_as_float(__builtin_amdgcn_readlane(__float_as_int(v), 63));
}
__device__ __forceinline__ float hsum32(float v) {
  v = row16sum(v);
  return v + __shfl_xor(v, 16);
}
__device__ __forceinline__ const float* xrow(const Params& p, int row) {
  return row < NP ? p.in[0] + (size_t)row * 1024 : p.in[1] + (size_t)(row - NP) * 1024;
}
__device__ __forceinline__ float prevP(const Params& p, const u16* P, int row, int c) {
  const int rp = row > 0 ? row - 1 : 0;
  float v = bf2f(P[(size_t)rp * 2816 + 256 + c]);
  const bool start = (row < NP) ? ((row & 2047) == 0) : (((row - NP) & 3) == 0);
  if (start) v = (row < NP) ? 0.f : p.in[3][(size_t)((row - NP) >> 2) * 2560 + c];
  return v;
}

__shared__ __attribute__((aligned(16))) unsigned char smem[114688];
#define RAW_BARRIER() do { asm volatile("s_waitcnt lgkmcnt(0)" ::: "memory"); __builtin_amdgcn_s_barrier(); asm volatile("" ::: "memory"); } while (0)
__shared__ int s_task;
__shared__ int s_simdcnt[4];
__shared__ int s_role[8];
__shared__ int s_role2[8];

#define XB_TMO      128
#define XB_XCNT(j)  (256  + 64 * (j))
#define XB_XSUB(j)  (1280 + 64 * (j))
#define XB_XGEN(j)  (2304 + 64 * (j))
#define XB_TOP      3328
#define XB_TOPGEN   3392
#define XCD_BAR_WORDS 3456
#define XB_SPIN_CAP (1u << 18)
#define LAS __attribute__((address_space(3)))

__device__ __forceinline__ unsigned xb_ld(unsigned* p)              { return __hip_atomic_load(p, __ATOMIC_RELAXED, __HIP_MEMORY_SCOPE_AGENT); }
__device__ __forceinline__ unsigned xb_add(unsigned* p, unsigned v) { return __hip_atomic_fetch_add(p, v, __ATOMIC_RELAXED, __HIP_MEMORY_SCOPE_AGENT); }
__device__ __forceinline__ unsigned xb_xcc_id() { return (unsigned)__builtin_amdgcn_s_getreg((3 << 11) | 20) & 0xFu; }
#define XB_SPIN(cond, bar) do { unsigned _sp = 0; while (cond) { __builtin_amdgcn_s_sleep(1); \
    if ((++_sp & 255u) == 0u) { if (xb_ld(&(bar)[XB_TMO])) break; if (_sp > XB_SPIN_CAP) { atomicAdd(&(bar)[XB_TMO], 1u); break; } } } } while (0)

struct XcdBarrier {
    unsigned* bar; unsigned x;
    volatile LAS unsigned* st;
};

__device__ __forceinline__ XcdBarrier xcd_barrier_post(unsigned* bar, volatile LAS unsigned* st) {
    XcdBarrier b; b.bar = bar; b.x = xb_xcc_id(); b.st = st;
    if (threadIdx.x == 0) (void)xb_add(&bar[XB_XCNT(b.x)], 1u);
    return b;
}
__device__ __forceinline__ void xcd_barrier_complete(unsigned* bar, unsigned x, unsigned& nloc, unsigned& nx) {
    const unsigned G = gridDim.x * gridDim.y * gridDim.z;
    unsigned sum, cnt, mine, sp = 0u;
    for (;;) {
        sum = 0u; cnt = 0u; mine = 0u;
#pragma unroll
        for (unsigned j = 0; j < 16; ++j) { const unsigned c = xb_ld(&bar[XB_XCNT(j)]); sum += c; cnt += (c > 0u) ? 1u : 0u; mine = (j == x) ? c : mine; }
        if (sum == G) break;
        __builtin_amdgcn_s_sleep(1);
        if ((++sp & 255u) == 0u) { if (xb_ld(&bar[XB_TMO])) break; if (sp > XB_SPIN_CAP) { atomicAdd(&bar[XB_TMO], 1u); break; } }
    }
    nloc = mine > 0u ? mine : 1u; nx = cnt > 0u ? cnt : 1u;
}

__device__ __forceinline__ void xcd_barrier(const XcdBarrier& b) {
    asm volatile("s_waitcnt vmcnt(0)" ::: "memory");
    __syncthreads();
    if (threadIdx.x == 0) {
        unsigned* bar = b.bar;
        __builtin_amdgcn_s_waitcnt(0);
        unsigned nloc = b.st[0], nx = b.st[1];
        if (nloc == 0u) { xcd_barrier_complete(bar, b.x, nloc, nx); b.st[0] = nloc; b.st[1] = nx; }
        const unsigned old = xb_add(&bar[XB_XSUB(b.x)], 1u);
        const unsigned gen = old / nloc;
        if (old + 1u == (gen + 1u) * nloc) {
            __builtin_amdgcn_fence(__ATOMIC_RELEASE, "agent");
            asm volatile("s_waitcnt vmcnt(0)" ::: "memory");
            const unsigned og = xb_add(&bar[XB_TOP], 1u);
            const unsigned tg = og / nx;
            if (og + 1u == (tg + 1u) * nx) xb_add(&bar[XB_TOPGEN], 1u);
            else XB_SPIN(xb_ld(&bar[XB_TOPGEN]) == tg, bar);
            __builtin_amdgcn_fence(__ATOMIC_ACQUIRE, "agent");
            xb_add(&bar[XB_XGEN(b.x)], 1u);
            asm volatile("s_waitcnt vmcnt(0)" ::: "memory");
        } else {
            XB_SPIN(xb_ld(&bar[XB_XGEN(b.x)]) == gen, bar);
            __builtin_amdgcn_fence(__ATOMIC_ACQUIRE, "agent");
            asm volatile("s_waitcnt vmcnt(0)" ::: "memory");
        }
    }
    __syncthreads();
}


__device__ __forceinline__ void convT(const float* __restrict__ W, int K, int N, const float* __restrict__ g, u16* __restrict__ WT) {
  float* t = (float*)smem;
  const int tilesN = N / 128, tiles = (K / 64) * tilesN;
  const int tx = threadIdx.x & 127, ty = threadIdx.x >> 7;
  const int sx = threadIdx.x & 63, sy = threadIdx.x >> 6;
  for (int tl = blockIdx.x; tl < tiles; tl += gridDim.x) {
    const int k0 = (tl / tilesN) * 64, n0 = (tl % tilesN) * 128;
    float v[16];
#pragma unroll
    for (int i = 0; i < 16; i++) v[i] = W[(size_t)(k0 + ty + 4 * i) * N + n0 + tx];
    if (g) {
#pragma unroll
      for (int i = 0; i < 16; i++) v[i] *= g[k0 + ty + 4 * i];
    }
    __syncthreads();
#pragma unroll
    for (int i = 0; i < 16; i++) t[(ty + 4 * i) * 129 + tx] = v[i];
    __syncthreads();
#pragma unroll
    for (int i = 0; i < 16; i++) {
      const int n = sy + 8 * i;
      WT[(size_t)(n0 + n) * K + k0 + sx] = f2bf(t[sx * 129 + n]);
    }
  }
}

__device__ __forceinline__ void phase0(const Params& p) {
  char* ws = p.ws;
  convT(p.in[8], 1024, 2816, p.in[7], (u16*)(ws + O_WIN0));
  convT(p.in[22], 1024, 1024, nullptr, (u16*)(ws + O_WOUT0));
  convT(p.in[38], 1024, 4096, p.in[37], (u16*)(ws + O_WF10));
  convT(p.in[39], 4096, 1024, nullptr, (u16*)(ws + O_WF20));
  convT(p.in[24], 1024, 2048, p.in[23], (u16*)(ws + O_WIN1));
  convT(p.in[36], 1024, 1024, nullptr, (u16*)(ws + O_WOUT1));
  convT(p.in[38] + (size_t)1024 * 4096, 1024, 4096, p.in[37] + 1024, (u16*)(ws + O_WF11));
  convT(p.in[39] + (size_t)1024 * 4096, 4096, 1024, nullptr, (u16*)(ws + O_WF21));
  convT(p.in[13], 64, 768, nullptr, (u16*)(ws + O_WLW));
  convT(p.in[15], 64, 768, nullptr, (u16*)(ws + O_WLA));
  convT(p.in[16], 128, 768, nullptr, (u16*)(ws + O_WLG));
  {
    u16* wm = (u16*)(ws + O_WM);
    const float* wsrc = p.in[27];
    for (int e = blockIdx.x * 512 + threadIdx.x; e < 4 * 128 * 128; e += gridDim.x * 512) {
      int i = (e >> 7) & 127, j = e & 127;
      wm[e] = (j <= i) ? f2bf(wsrc[e]) : (u16)0;
    }
  }
  {
    u16* wxt = (u16*)(ws + O_WXT);
    for (int e = blockIdx.x * 512 + threadIdx.x; e < 16 * 64 * 64; e += gridDim.x * 512) {
      const int m = e >> 12, d = (e >> 6) & 63, c = e & 63;
      const float* src = (m < 8) ? p.in[31] : p.in[33];
      wxt[e] = f2bf(src[(m & 7) * 4096 + c * 64 + d]);
    }
  }
  if (blockIdx.x == 0 && threadIdx.x < 64) ((int*)(ws + O_CNT))[threadIdx.x] = 0;
  if (blockIdx.x == 1) for (int e = threadIdx.x; e < 3456; e += 512) ((unsigned*)(ws + O_XBAR))[e] = 0u;
  for (int e = blockIdx.x * 512 + threadIdx.x; e < 512 * 256; e += gridDim.x * 512) ((float4*)(p.out + (size_t)NP * 1024))[e] = ((const float4*)p.in[1])[e];
  {
    u16* xb = (u16*)(ws + O_XB);
    float* part = (float*)(ws + O_PART);
    const int lane = threadIdx.x & 63, wave = threadIdx.x >> 6;
    for (int row = blockIdx.x * 8 + wave; row < MT; row += gridDim.x * 8) {
      const float* xr = xrow(p, row);
      float ss = 0.f;
#pragma unroll
      for (int i = 0; i < 4; i++) {
        float4 v = *(const float4*)(xr + i * 256 + lane * 4);
        ss += v.x * v.x + v.y * v.y + v.z * v.z + v.w * v.w;
        ushort4 o;
        o.x = f2bf(v.x); o.y = f2bf(v.y); o.z = f2bf(v.z); o.w = f2bf(v.w);
        *(ushort4*)(xb + (size_t)row * 1024 + i * 256 + lane * 4) = o;
      }
      ss = wsum64(ss);
      if (lane < 16) part[(size_t)row * 16 + lane] = (lane == 0) ? ss : 0.f;
    }
  }
}

enum { EPI_SCALE = 0, EPI_PLAIN = 1, EPI_FF1 = 2, EPI_RES = 3, EPI_POST = 4 };

template <int EPI>
__device__ __forceinline__ void gemm_epi(const Params& p, const f32x16 acc0, const f32x16 acc1, int mi, int wm, int wn, int lane,
                                         int m0, int nt, int c0, int c1, const float* sRs, u16* __restrict__ outb, int ldo,
                                         int resid_in) {
  float* part = (float*)(p.ws + O_PART);
  float* xf = p.out;
    const int rbase = wm * 64 + mi * 32 + 4 * (lane >> 5);
    if (EPI == EPI_SCALE || EPI == EPI_PLAIN || EPI == EPI_FF1) {
#pragma unroll
      for (int i = 0; i < 16; i++) {
        const int rl = rbase + (i & 3) + 8 * (i >> 2);
        const int row = m0 + rl;
        float v0 = acc0[i], v1 = acc1[i];
        if (EPI != EPI_PLAIN) { float rs = sRs[rl]; v0 *= rs; v1 *= rs; }
        if (EPI == EPI_FF1) { v0 = fmaxf(v0, 0.f); v1 = fmaxf(v1, 0.f); v0 *= v0; v1 *= v1; }
        outb[(size_t)row * ldo + c0] = f2bf(v0);
        outb[(size_t)row * ldo + c1] = f2bf(v1);
      }
    } else if (EPI == EPI_RES) {
#pragma unroll
      for (int i = 0; i < 16; i++) {
        const int rl = rbase + (i & 3) + 8 * (i >> 2);
        const int row = m0 + rl;
        float v0 = acc0[i], v1 = acc1[i];
        xf[(size_t)row * 1024 + c0] = v0;
        xf[(size_t)row * 1024 + c1] = v1;
        outb[(size_t)row * 1024 + c0] = f2bf(v0);
        outb[(size_t)row * 1024 + c1] = f2bf(v1);
        float s = hsum32(v0 * v0 + v1 * v1);
        if ((lane & 31) == 0) part[(size_t)row * 16 + nt * 2 + wn] = s;
      }
    } else {
      const int hh = nt * 2 + wn;
      const u16* P = (const u16*)(p.ws + O_P);
      u16* Y = (u16*)(p.ws + O_Y);
      const float* bs = (const float*)(p.ws + O_BS);
      const int ch0 = hh * 64 + (lane & 31), ch1 = ch0 + 32;
      const float gg0 = p.in[20][ch0], gg1 = p.in[20][ch1];
      const float gb0 = p.in[21][ch0], gb1 = p.in[21][ch1];
      const float mu0 = p.in[11][1536 + ch0], mu1 = p.in[11][1536 + ch1];
#pragma unroll 16
      for (int i = 0; i < 16; i++) {
        const int rl = rbase + (i & 3) + 8 * (i >> 2);
        const int row = m0 + rl;
        float o0 = bf2f(Y[(size_t)row * 1024 + 256 + ch0]);
        float o1 = bf2f(Y[(size_t)row * 1024 + 256 + ch1]);
        float mean = hsum32(o0 + o1) * (1.0f / 64.0f);
        float d0 = o0 - mean, d1 = o1 - mean;
        float var = hsum32(d0 * d0 + d1 * d1) * (1.0f / 64.0f);
        float rstd = rsqrtf(var + 64e-5f);
        float pv0 = bf2f(P[(size_t)row * 2816 + 256 + 1536 + ch0]);
        float pv1 = bf2f(P[(size_t)row * 2816 + 256 + 1536 + ch1]);
        float pp0 = prevP(p, P, row, 1536 + ch0), pp1 = prevP(p, P, row, 1536 + ch1);
        float vv0 = pv0 + (pp0 - pv0) * mu0, vv1 = pv1 + (pp1 - pv1) * mu1;
        float b = bs[((size_t)row * 12 + hh) * 4 + 2];
        float y0 = (d0 * rstd * gg0 + gb0 + b * vv0) * acc0[i];
        float y1 = (d1 * rstd * gg1 + gb1 + b * vv1) * acc1[i];
        Y[(size_t)row * 1024 + 256 + ch0] = f2bf(y0);
        Y[(size_t)row * 1024 + 256 + ch1] = f2bf(y1);
      }
    }
}

template <int EPI>
__device__ __forceinline__ void gemm_phase(const Params& p, const u16* __restrict__ A, int lda, const u16* __restrict__ BT, int ldb,
                           int K, int N, u16* __restrict__ outb, int ldo, int resid_in, int boff) {
  constexpr int LS = 72;
  constexpr int SA = 256 * LS, SB = 128 * LS, STG = SA + SB;
  u16* sm = (u16*)smem;
  float* sRs = (float*)(sm + 2 * STG);
  const int tid = threadIdx.x, lane = tid & 63, wave = tid >> 6;
  const int wm = wave >> 1, wn = wave & 1;
  const int lrow = tid >> 3, lch = tid & 7;
  const int NT = N / 128;
  const int tiles = (MT / 256) * NT;
  const int KTALL = K / 64;
  float* part = (float*)(p.ws + O_PART);
  int bstart = (int)blockIdx.x - boff;
  if (bstart < 0) bstart += gridDim.x;
  const size_t a64 = (size_t)64 * lda, b64 = (size_t)64 * ldb;
  const int G = gridDim.x;
  int t_full = tiles, split = 1;
  if (EPI == EPI_RES) {
    const int tail = tiles % G;
    if (tail > 0 && (G % tail) == 0 && (KTALL % (G / tail)) == 0) { t_full = tiles - tail; const int smax = (KTALL >= 64) ? 8 : 4; split = (G / tail) > smax ? smax : (G / tail); }
  }
  const int units = t_full + (tiles - t_full) * split;
  for (int un = bstart; un < units; un += G) {
    int tl = un, kbeg = 0, KT = KTALL;
    bool part_unit = false;
    if (un >= t_full) { const int v = un - t_full; tl = t_full + v / split; KT = KTALL / split; kbeg = (v % split) * KT; part_unit = true; }
    int mt = tl / NT, nt = tl % NT;
    if (EPI == EPI_RES && NT == 8 && G == 256 && !part_unit) {
      const int rr = tl >> 8, bb = tl & 255;
      const int xx = bb & 7, jj = bb >> 3;
      mt = rr * 32 + xx * 4 + (jj >> 3);
      nt = jj & 7;
    } else if ((EPI == EPI_FF1 || EPI == EPI_SCALE) && G == 256 && (NT == 32 || NT == 16) && tl < (tiles & ~255)) {
      const int rr = tl >> 8, bb = tl & 255;
      const int xx = bb & 7, jj = bb >> 3;
      if (NT == 32) { mt = rr * 8 + (xx >> 2) * 4 + (jj >> 3); nt = (xx & 3) * 8 + (jj & 7); }
      else { mt = rr * 16 + (xx >> 1) * 4 + (jj >> 3); nt = (xx & 1) * 8 + (jj & 7); }
    }
    const int m0 = mt * 256, n0 = nt * 128;
    const u16* gA = A + (size_t)(m0 + lrow) * lda + lch * 8 + (size_t)kbeg * 64;
    const u16* gB = BT + (size_t)(n0 + lrow) * ldb + lch * 8 + (size_t)kbeg * 64;
    uint4 xa0, xa1, xa2, xa3, xb0, xb1;
    uint4 ya0, ya1, ya2, ya3, yb0, yb1;
#define LOADX(kt_) { const u16* qa = gA + (kt_) * 64; const u16* qb = gB + (kt_) * 64; \
    xa0 = *(const uint4*)qa; xa1 = *(const uint4*)(qa + a64); xa2 = *(const uint4*)(qa + 2 * a64); xa3 = *(const uint4*)(qa + 3 * a64); \
    xb0 = *(const uint4*)qb; xb1 = *(const uint4*)(qb + b64); }
#define LOADY(kt_) { const u16* qa = gA + (kt_) * 64; const u16* qb = gB + (kt_) * 64; \
    ya0 = *(const uint4*)qa; ya1 = *(const uint4*)(qa + a64); ya2 = *(const uint4*)(qa + 2 * a64); ya3 = *(const uint4*)(qa + 3 * a64); \
    yb0 = *(const uint4*)qb; yb1 = *(const uint4*)(qb + b64); }
#define WRITEX(st_) { u16* wa = sm + (st_) * STG + lrow * LS + lch * 8; u16* wb = wa + SA; \
    *(uint4*)wa = xa0; *(uint4*)(wa + 64 * LS) = xa1; *(uint4*)(wa + 128 * LS) = xa2; *(uint4*)(wa + 192 * LS) = xa3; \
    *(uint4*)wb = xb0; *(uint4*)(wb + 64 * LS) = xb1; }
#define WRITEY(st_) { u16* wa = sm + (st_) * STG + lrow * LS + lch * 8; u16* wb = wa + SA; \
    *(uint4*)wa = ya0; *(uint4*)(wa + 64 * LS) = ya1; *(uint4*)(wa + 128 * LS) = ya2; *(uint4*)(wa + 192 * LS) = ya3; \
    *(uint4*)wb = yb0; *(uint4*)(wb + 64 * LS) = yb1; }
#define COMPUTE(st_) { const u16* ab = sm + (st_) * STG + (wm * 64 + (lane & 31)) * LS + (lane >> 5) * 8; \
    const u16* bb = sm + (st_) * STG + SA + (wn * 64 + (lane & 31)) * LS + (lane >> 5) * 8; \
    _Pragma("unroll") for (int ks = 0; ks < 4; ks++) { \
      bf16x8 fa0 = *(const bf16x8*)(ab + ks * 16); bf16x8 fa1 = *(const bf16x8*)(ab + 32 * LS + ks * 16); \
      bf16x8 fb0 = *(const bf16x8*)(bb + ks * 16); bf16x8 fb1 = *(const bf16x8*)(bb + 32 * LS + ks * 16); \
      acc00 = __builtin_amdgcn_mfma_f32_32x32x16_bf16(fa0, fb0, acc00, 0, 0, 0); \
      acc01 = __builtin_amdgcn_mfma_f32_32x32x16_bf16(fa0, fb1, acc01, 0, 0, 0); \
      acc10 = __builtin_amdgcn_mfma_f32_32x32x16_bf16(fa1, fb0, acc10, 0, 0, 0); \
      acc11 = __builtin_amdgcn_mfma_f32_32x32x16_bf16(fa1, fb1, acc11, 0, 0, 0); } }
    LOADX(0);
    if (KT > 1) LOADY(1);
    f32x16 acc00, acc01, acc10, acc11;
    if (EPI == EPI_RES && !part_unit) {
      const int cc0 = n0 + wn * 64 + (lane & 31);
      float* xfq = p.out;
#pragma unroll
      for (int i = 0; i < 16; i++) {
        const int row = m0 + wm * 64 + 4 * (lane >> 5) + (i & 3) + 8 * (i >> 2);
        const float* ra = resid_in ? xrow(p, row) : (xfq + (size_t)row * 1024);
        const float* rb = resid_in ? xrow(p, row + 32) : (xfq + (size_t)(row + 32) * 1024);
        acc00[i] = ra[cc0]; acc01[i] = ra[cc0 + 32];
        acc10[i] = rb[cc0]; acc11[i] = rb[cc0 + 32];
      }
    } else {
#pragma unroll
      for (int i = 0; i < 16; i++) { acc00[i] = 0.f; acc01[i] = 0.f; acc10[i] = 0.f; acc11[i] = 0.f; }
    }
    __syncthreads();
    if (EPI == EPI_SCALE || EPI == EPI_FF1) {
      if (tid < 256) {
        const float4* pp = (const float4*)(part + (size_t)(m0 + tid) * 16);
        float4 a = pp[0], b = pp[1], c = pp[2], d = pp[3];
        float s = (a.x + a.y + a.z + a.w) + (b.x + b.y + b.z + b.w) + (c.x + c.y + c.z + c.w) + (d.x + d.y + d.z + d.w);
        sRs[tid] = rsqrtf(s * (1.0f / 1024.0f) + 1e-6f);
      }
    }
    WRITEX(0);
    if (KT > 2) LOADX(2);
    RAW_BARRIER();
    for (int kt = 0; kt < KT; kt += 2) {
      if (kt + 1 < KT) WRITEY(1);
      if (kt + 3 < KT) LOADY(kt + 3);
      COMPUTE(0);
      RAW_BARRIER();
      if (kt + 1 >= KT) break;
      if (kt + 2 < KT) WRITEX(0);
      if (kt + 4 < KT) LOADX(kt + 4);
      COMPUTE(1);
      RAW_BARRIER();
    }
#undef LOADX
#undef LOADY
#undef WRITEX
#undef WRITEY
#undef COMPUTE
    const int c0 = n0 + wn * 64 + (lane & 31);
    const int c1 = c0 + 32;
    if (EPI == EPI_RES && part_unit) {
      float* xfp = p.out;
#pragma unroll
      for (int i = 0; i < 16; i++) {
        const int rl = wm * 64 + 4 * (lane >> 5) + (i & 3) + 8 * (i >> 2);
        float* r0p = xfp + (size_t)(m0 + rl) * 1024;
        float* r1p = r0p + (size_t)32 * 1024;
        atomicAdd(r0p + c0, acc00[i]); atomicAdd(r0p + c1, acc01[i]);
        atomicAdd(r1p + c0, acc10[i]); atomicAdd(r1p + c1, acc11[i]);
      }
    } else {
      gemm_epi<EPI>(p, acc00, acc01, 0, wm, wn, lane, m0, nt, c0, c1, sRs, outb, ldo, resid_in);
      gemm_epi<EPI>(p, acc10, acc11, 1, wm, wn, lane, m0, nt, c0, c1, sRs, outb, ldo, resid_in);
    }
  }
}

__device__ __forceinline__ void pool_item(const Params& p, int it) {
  const u16* P = (const u16*)(p.ws + O_P);
  u16* Y = (u16*)(p.ws + O_Y);
  float* hist = (float*)smem;
  float* dS = hist + 47 * 256;
  const int tid = threadIdx.x;
  const int col = tid & 255, hf = tid >> 8;
  const int gi = col >> 6, dd = col & 63;
  const int w = 2 << gi;
  const float* pw = p.in[9] + gi * 4096 + dd;
  const float sc = p.in[10][col];
  {
    int r0, t0, nrows, pos0;
    const float* st = nullptr;
    const float* shs = nullptr;
    if (it < 512) { r0 = it * 32; t0 = r0 & 2047; nrows = 32; pos0 = t0; }
    else { const int b = it - 512; r0 = NP + b * 4; t0 = 0; nrows = 4; pos0 = 16384; st = p.in[2] + (size_t)b * 3840; shs = p.in[3] + (size_t)b * 2560; }
    __syncthreads();
    const int nh = 15 + nrows;
#pragma unroll 8
    for (int hr = hf; hr < nh; hr += 2) {
      const int t = t0 - 15 + hr;
      float v = 0.f;
      if (t >= 0) v = bf2f(P[(size_t)(r0 - t0 + t) * 2816 + col]);
      else if (st) v = st[(15 + t) * 256 + col];
      hist[hr * 256 + col] = v;
    }
    __syncthreads();
    const int q0 = hf * 16;
    for (int q = 0; q < 16; q++) {
      const int tk = q0 + q;
      if (tk < nrows) {
        float s = 0.f;
        for (int i = 0; i < w; i++) s += hist[(15 + tk - i) * 256 + col];
        const float cnt = (float)min(w, pos0 + tk + 1);
        dS[tk * 256 + col] = s / cnt - hist[(15 + tk) * 256 + col];
      }
    }
    __syncthreads();
    float acc[16];
#pragma unroll
    for (int q = 0; q < 16; q++) acc[q] = 0.f;
    if (q0 < nrows) {
#pragma unroll 4
      for (int c = 0; c < 64; c += 4) {
        float w0 = pw[(c + 0) * 64], w1 = pw[(c + 1) * 64], w2 = pw[(c + 2) * 64], w3 = pw[(c + 3) * 64];
#pragma unroll
        for (int q = 0; q < 16; q++) {
          float4 d = *(const float4*)(dS + (q0 + q) * 256 + gi * 64 + c);
          acc[q] += d.x * w0 + d.y * w1 + d.z * w2 + d.w * w3;
        }
      }
    }
#pragma unroll
    for (int q = 0; q < 16; q++) {
      if (q0 + q < nrows) Y[(size_t)(r0 + q0 + q) * 1024 + col] = f2bf(acc[q] * sc);
    }
  }
}

__device__ __forceinline__ void pool_phase(const Params& p) {
  const u16* P = (const u16*)(p.ws + O_P);
  u16* LIN = (u16*)(p.ws + O_LIN);
  const int tid = threadIdx.x;
  const int col = tid & 255, hf = tid >> 8;
  const float mu = p.in[11][2304 + col];
  for (int it = blockIdx.x; it < 512 + 128; it += gridDim.x) {
    int r0, t0, nrows;
    const float* shs = nullptr;
    if (it < 512) { r0 = it * 32; t0 = r0 & 2047; nrows = 32; }
    else { const int b = it - 512; r0 = NP + b * 4; t0 = 0; nrows = 4; shs = p.in[3] + (size_t)b * 2560; }
    const int q0 = hf * 16;
    if (q0 < nrows) {
      const int nq = min(16, nrows - q0);
      float pv[17];
      {
        const int rowp = r0 + q0 - 1;
        float v0;
        if (t0 + q0 == 0) v0 = shs ? shs[2304 + col] : 0.f;
        else v0 = bf2f(P[(size_t)rowp * 2816 + 2560 + col]);
        pv[0] = v0;
      }
#pragma unroll
      for (int q = 0; q < 16; q++) pv[q + 1] = (q < nq) ? bf2f(P[(size_t)(r0 + q0 + q) * 2816 + 2560 + col]) : 0.f;
#pragma unroll
      for (int q = 0; q < 16; q++) {
        if (q < nq) {
          float xs = pv[q + 1] + (pv[q] - pv[q + 1]) * mu;
          float v = (col < 64) ? tanhf_(xs) : ((col < 128) ? xs : sigmoidf_(xs));
          LIN[(size_t)(r0 + q0 + q) * 256 + col] = f2bf(v);
        }
      }
    }
  }
  const int gt = blockIdx.x * 512 + tid, gs = gridDim.x * 512;
  for (int e = gt; e < 8 * 15 * 256; e += gs) {
    int b = e / 3840, r = (e / 256) % 15, c = e & 255;
    p.out[OUT_PPOOL + e] = bf2f(P[(size_t)(b * 2048 + 2033 + r) * 2816 + c]);
  }
  for (int e = gt; e < 128 * 15 * 256; e += gs) {
    int b = e / 3840, r = (e / 256) % 15, c = e & 255;
    float v;
    if (r < 11) v = p.in[2][(size_t)b * 3840 + (r + 4) * 256 + c];
    else v = bf2f(P[(size_t)(NP + b * 4 + (r - 11)) * 2816 + c]);
    p.out[OUT_SPOOL + e] = v;
  }
  for (int e = gt; e < 8 * 2560; e += gs) {
    int b = e / 2560, c = e % 2560;
    p.out[OUT_PSHIFT + e] = bf2f(P[(size_t)(b * 2048 + 2047) * 2816 + 256 + c]);
  }
  for (int e = gt; e < 128 * 2560; e += gs) {
    int b = e / 2560, c = e % 2560;
    p.out[OUT_SSHIFT + e] = bf2f(P[(size_t)(NP + b * 4 + 3) * 2816 + 256 + c]);
  }
}

__device__ __forceinline__ void rwkv_prep_phase(const Params& p) {
  const u16* P = (const u16*)(p.ws + O_P);
  u16* APRE = (u16*)(p.ws + O_APRE);
  u16* WPRE = (u16*)(p.ws + O_WPRE);
  float* SC = (float*)(p.ws + O_BS);
  const int lane = threadIdx.x & 63, wave = __builtin_amdgcn_readfirstlane(threadIdx.x >> 6);
  for (int row = blockIdx.x * 8 + wave; row < MT; row += gridDim.x * 8) {
    const u16* Pr = P + (size_t)row * 2816 + 256;
#pragma unroll 12
    for (int h = 0; h < 12; h++) {
      const int ch = h * 64 + lane;
      float pr = bf2f(Pr[ch]), pk = bf2f(Pr[768 + ch]);
      float qr = prevP(p, P, row, ch), qk = prevP(p, P, row, 768 + ch);
      float wl = p.in[12][ch] + bf2f(WPRE[(size_t)row * 768 + ch]);
      float r = pr + (qr - pr) * p.in[11][ch], k = pk + (qk - pk) * p.in[11][768 + ch];
      float a = sigmoidf_(p.in[14][ch] + bf2f(APRE[(size_t)row * 768 + ch]));
      a = bf2f(f2bf(a));
      float omd = 1.0f - __expf(-0.6065306597126334f * sigmoidf_(wl));
      float kkr = k * p.in[17][ch];
      float n2 = wsum64(kkr * kkr);
      float inv = frcp_(fmaxf(__builtin_amdgcn_sqrtf(n2), 1e-12f));
      float kap = kkr * inv;
      float kp = k * (1.0f + (a - 1.0f) * p.in[18][ch]);
      float al = kap * a;
      float ar = wsum64(al * r);
      float kr = wsum64(kp * r);
      float bsum = wsum64(r * kp * p.in[19][ch]);
      APRE[(size_t)row * 768 + ch] = f2bf(a);
      WPRE[(size_t)row * 768 + ch] = f2bf(omd);
      if (lane == 0) *(float4*)(SC + ((size_t)row * 12 + h) * 4) = make_float4(ar, kr, bsum, inv);
    }
  }
}

constexpr int TC = 16;
typedef float v2f __attribute__((ext_vector_type(2)));
typedef float v4f __attribute__((ext_vector_type(4)));

struct StRaw {
  unsigned cr[2], ck[2], cv[2];
  unsigned qr[2], qk[2], qv[2];
  unsigned wp[2], ap[2];
  float inv[2], sc2[2];
  v2f s_r, s_k, s_v;
  float m;
};
struct StConst { v2f mur, muk, muv, kk_, ka_; };

__device__ __forceinline__ v2f bfpair(unsigned u) {
  v2f r;
  r.x = __uint_as_float(u << 16);
  r.y = __uint_as_float(u & 0xffff0000u);
  return r;
}

template <bool SAMPLE>
__device__ __forceinline__ void st_load(const Params& p, StRaw& R, int row0, int b, int h, int c, int sw, int lane) {
  const u16* P = (const u16*)(p.ws + O_P);
  const u16* WPRE = (const u16*)(p.ws + O_WPRE);
  const u16* APRE = (const u16*)(p.ws + O_APRE);
  const float* SC = (const float*)(p.ws + O_BS);
  const int l2 = lane & 31, tp = lane >> 5;
  const int ch = h * 64 + 2 * l2;
  const int t0 = c * TC + sw * 4;
  R.m = (t0 + tp == 0) ? 0.f : 1.f;
  if (SAMPLE) {
    const float* sp = p.in[3] + (size_t)b * 2560 + ch;
    R.s_r = *(const v2f*)sp; R.s_k = *(const v2f*)(sp + 768); R.s_v = *(const v2f*)(sp + 1536);
  }
#pragma unroll
  for (int ps = 0; ps < 2; ps++) {
    const int t = t0 + 2 * ps + tp;
    const int tq = t > 0 ? t - 1 : 0;
    const u16* Pc = P + (size_t)(row0 + t) * 2816 + 256 + ch;
    const u16* Pq = P + (size_t)(row0 + tq) * 2816 + 256 + ch;
    R.cr[ps] = *(const unsigned*)Pc; R.ck[ps] = *(const unsigned*)(Pc + 768); R.cv[ps] = *(const unsigned*)(Pc + 1536);
    R.qr[ps] = *(const unsigned*)Pq; R.qk[ps] = *(const unsigned*)(Pq + 768); R.qv[ps] = *(const unsigned*)(Pq + 1536);
    const size_t row = row0 + t;
    R.wp[ps] = *(const unsigned*)(WPRE + row * 768 + ch);
    R.ap[ps] = *(const unsigned*)(APRE + row * 768 + ch);
    R.inv[ps] = SC[(row * 12 + h) * 4 + 3];
    R.sc2[ps] = SC[(row * 12 + h) * 4 + (lane & 1)];
  }
}

template <bool SAMPLE>
__device__ __forceinline__ void st_compute(const StConst& K, const StRaw& R, int sw, int lane, float* ops, float* scal) {
  const int l2 = lane & 31, tp = lane >> 5;
#pragma unroll
  for (int ps = 0; ps < 2; ps++) {
    const int tt = sw * 4 + 2 * ps + tp;
    v2f pr = bfpair(R.cr[ps]), pk = bfpair(R.ck[ps]), pv = bfpair(R.cv[ps]);
    v2f qr = bfpair(R.qr[ps]), qk = bfpair(R.qk[ps]), qv = bfpair(R.qv[ps]);
    if (ps == 0) {
      if (SAMPLE) { if (R.m == 0.f) { qr = R.s_r; qk = R.s_k; qv = R.s_v; } }
      else { const v2f mm = {R.m, R.m}; qr *= mm; qk *= mm; qv *= mm; }
    }
    const v2f r = pr + (qr - pr) * K.mur;
    const v2f k = pk + (qk - pk) * K.muk;
    const v2f v = pv + (qv - pv) * K.muv;
    const v2f one = {1.0f, 1.0f};
    const v2f dec = one - bfpair(R.wp[ps]);
    const v2f a = bfpair(R.ap[ps]);
    const v2f iv = {R.inv[ps], R.inv[ps]};
    const v2f kap = k * K.kk_ * iv;
    const v2f kp = k * (one + (a - one) * K.ka_);
    float* o6 = ops + tt * 384 + 2 * l2;
    *(v2f*)(o6) = dec; *(v2f*)(o6 + 64) = kap * a; *(v2f*)(o6 + 128) = kp; *(v2f*)(o6 + 192) = kap; *(v2f*)(o6 + 256) = dec * r; *(v2f*)(o6 + 320) = v;
    if (l2 < 2) scal[tt * 2 + l2] = R.sc2[ps];
  }
}

struct ScD { v4f a0, a1, q0, q1; };
struct ScU { v4f w0, w1, l0, l1, k0, k1; float v; v2f sc; };
__device__ __forceinline__ void scd_load(ScD& O, const float* o6, int j8) {
  O.a0 = *(const v4f*)(o6 + 192 + j8); O.a1 = *(const v4f*)(o6 + 192 + j8 + 4);
  O.q0 = *(const v4f*)(o6 + 256 + j8); O.q1 = *(const v4f*)(o6 + 256 + j8 + 4);
}
__device__ __forceinline__ void scu_load(ScU& O, const float* o6, const float* sb, int tt, int j8, int srow) {
  O.w0 = *(const v4f*)(o6 + j8); O.w1 = *(const v4f*)(o6 + j8 + 4);
  O.l0 = *(const v4f*)(o6 + 64 + j8); O.l1 = *(const v4f*)(o6 + 64 + j8 + 4);
  O.k0 = *(const v4f*)(o6 + 128 + j8); O.k1 = *(const v4f*)(o6 + 128 + j8 + 4);
  O.v = o6[320 + srow];
  O.sc = *(const v2f*)(sb + tt * 2);
}
__device__ __forceinline__ void sc_step(const ScD& D, const ScU& U, v2f& s0, v2f& s1, v2f& s2, v2f& s3, float* obuf, int tt, int lane) {
  v2f pd2 = s0 * D.a0.lo;
  v2f qd2 = s0 * D.q0.lo;
  pd2 = s1 * D.a0.hi + pd2; qd2 = s1 * D.q0.hi + qd2;
  pd2 = s2 * D.a1.lo + pd2; qd2 = s2 * D.q1.lo + qd2;
  pd2 = s3 * D.a1.hi + pd2; qd2 = s3 * D.q1.hi + qd2;
  float pd = reduce8(pd2.x + pd2.y);
  float qd = reduce8(qd2.x + qd2.y);
  const float v = U.v;
  const float o = qd - pd * U.sc.x + v * U.sc.y;
  const v2f vv = {v, v};
  const v2f np = {-pd, -pd};
  s0 = s0 * U.w0.lo + (np * U.l0.lo + vv * U.k0.lo);
  s1 = s1 * U.w0.hi + (np * U.l0.hi + vv * U.k0.hi);
  s2 = s2 * U.w1.lo + (np * U.l1.lo + vv * U.k1.lo);
  s3 = s3 * U.w1.hi + (np * U.l1.hi + vv * U.k1.hi);
  obuf[tt * 8 + (lane >> 3)] = o;
}

template <int STEPS>
__device__ __forceinline__ void scan_steps(v2f& s0, v2f& s1, v2f& s2, v2f& s3, const float* ob, const float* sb, int j8, int srow,
                                           float* obuf, int lane) {
  ScD A, B, C;
  ScU P, Q;
  scd_load(A, ob, j8);
  scu_load(P, ob, sb, 0, j8, srow);
  scd_load(B, ob + 384, j8);
#define SC_STEP(DX_, DZ_, UX_, UZ_, tt_) { \
    if ((tt_) + 1 < STEPS) scu_load(UZ_, ob + ((tt_) + 1) * 384, sb, (tt_) + 1, j8, srow); \
    if ((tt_) + 2 < STEPS) scd_load(DZ_, ob + ((tt_) + 2) * 384, j8); \
    asm volatile("" ::: "memory"); sc_step(DX_, UX_, s0, s1, s2, s3, obuf, (tt_), lane); asm volatile("" ::: "memory"); }
  SC_STEP(A, C, P, Q, 0) SC_STEP(B, A, Q, P, 1) SC_STEP(C, B, P, Q, 2) SC_STEP(A, C, Q, P, 3)
  if (STEPS > 4) {
    SC_STEP(B, A, P, Q, 4) SC_STEP(C, B, Q, P, 5) SC_STEP(A, C, P, Q, 6) SC_STEP(B, A, Q, P, 7)
    SC_STEP(C, B, P, Q, 8) SC_STEP(A, C, Q, P, 9) SC_STEP(B, A, P, Q, 10) SC_STEP(C, B, Q, P, 11)
    SC_STEP(A, C, P, Q, 12) SC_STEP(B, A, Q, P, 13) SC_STEP(C, B, P, Q, 14) SC_STEP(A, C, Q, P, 15)
  }
#undef SC_STEP
}

__device__ __forceinline__ void scan_phase(const Params& p, int cidx, int task_lo, int task_hi) {
  float* ops = (float*)smem;
  float* scal = ops + 2 * TC * 384;
  float* obufs = scal + 2 * TC * 2;
  u16* Y = (u16*)(p.ws + O_Y);
  int* counter = (int*)(p.ws + O_CNT) + cidx;
  const int tid = threadIdx.x, lane = tid & 63, wave = __builtin_amdgcn_readfirstlane(tid >> 6);
  {
    if (tid < 4) s_simdcnt[tid] = 0;
    __syncthreads();
    if (lane == 0) {
      const int simd = (int)__builtin_amdgcn_s_getreg(2308) & 3;
      const int r = atomicAdd(&s_simdcnt[simd], 1);
      s_role[wave] = simd | (r << 4);
    }
    __syncthreads();
    if (tid == 0) {
      int ns = 0;
      for (int w = 0; w < 8; w++) ns += ((s_role[w] >> 4) == 0);
      int st = 0;
      for (int w = 0; w < 8; w++) {
        int v;
        if (ns == 4) v = ((s_role[w] >> 4) == 0) ? (s_role[w] & 3) : (4 + st++);
        else v = w;
        s_role2[w] = v;
      }
    }
    __syncthreads();
  }
  const int rolew = __builtin_amdgcn_readfirstlane(s_role2[wave]);
  const bool stat = (gridDim.x == 256 && task_lo == 0);
  bool first = true;
  while (true) {
    __syncthreads();
    if (tid == 0) s_task = (stat && first && blockIdx.x < 192) ? -1 : atomicAdd(counter, 1);
    __syncthreads();
    const int tq = __builtin_amdgcn_readfirstlane(s_task);
    first = false;
    const int task = (tq < 0) ? ((int)(blockIdx.x & 7) * 24 + (int)(blockIdx.x >> 3)) : (tq + (stat ? 192 : task_lo));
    if (task >= task_hi) break;
    int b, h, half, row0, T;
    bool sample;
    if (task < 192) { b = task / 24; h = (task % 24) >> 1; half = task & 1; row0 = b * 2048; T = 2048; sample = false; }
    else { int u = task - 192; b = u / 24; h = (u % 24) >> 1; half = u & 1; row0 = NP + b * 4; T = 4; sample = true; }
    const int nch = (T + TC - 1) / TC;
    const int sbase = half * 32 + (rolew & 3) * 8;
    const int srow = sbase + (lane >> 3);
    const int j8 = (lane & 7) * 8;
    float* obuf = obufs + (rolew & 3) * 128;
    if (rolew < 4) {
      v2f s0 = {0.f, 0.f}, s1 = s0, s2 = s0, s3 = s0;
      if (sample) {
        const float* sp = p.in[4] + ((size_t)(b * 12 + h) * 64 + srow) * 64 + j8;
        v4f x0 = *(const v4f*)sp, x1 = *(const v4f*)(sp + 4);
        s0 = x0.lo; s1 = x0.hi; s2 = x1.lo; s3 = x1.hi;
      }
      RAW_BARRIER();
      for (int c = 0; c < nch; c++) {
        const int buf = c & 1;
        const float* ob = ops + buf * TC * 384;
        const float* sb = scal + buf * TC * 2;
        if (sample) scan_steps<4>(s0, s1, s2, s3, ob, sb, j8, srow, obuf, lane);
        else scan_steps<TC>(s0, s1, s2, s3, ob, sb, j8, srow, obuf, lane);
        const int tt = lane >> 2, pr = lane & 3;
        if (tt < T) {
          v2f ov = *(const v2f*)(obuf + tt * 8 + 2 * pr);
          unsigned pk = (unsigned)f2bf(ov.x) | ((unsigned)f2bf(ov.y) << 16);
          *(unsigned*)(Y + (size_t)(row0 + c * TC + tt) * 1024 + 256 + h * 64 + sbase + 2 * pr) = pk;
        }
        RAW_BARRIER();
      }
      float* dp = p.out + (sample ? OUT_SWKV : OUT_PWKV) + ((size_t)(b * 12 + h) * 64 + srow) * 64 + j8;
      *(float4*)dp = make_float4(s0.x, s0.y, s1.x, s1.y);
      *(float4*)(dp + 4) = make_float4(s2.x, s2.y, s3.x, s3.y);
    } else {
      const int sw = rolew - 4;
      const int ch = h * 64 + 2 * (lane & 31);
      StConst K;
      K.mur = *(const v2f*)(p.in[11] + ch); K.muk = *(const v2f*)(p.in[11] + 768 + ch); K.muv = *(const v2f*)(p.in[11] + 1536 + ch);
      K.kk_ = *(const v2f*)(p.in[17] + ch); K.ka_ = *(const v2f*)(p.in[18] + ch);
      if (sample) {
        if (sw == 0) {
          StRaw RS;
          st_load<true>(p, RS, row0, b, h, 0, 0, lane);
          st_compute<true>(K, RS, 0, lane, ops, scal);
        }
        RAW_BARRIER();
        RAW_BARRIER();
      } else {
        StRaw RA, RB;
        st_load<false>(p, RA, row0, b, h, 0, sw, lane);
        st_compute<false>(K, RA, sw, lane, ops, scal);
        st_load<false>(p, RA, row0, b, h, 1, sw, lane);
        st_load<false>(p, RB, row0, b, h, 2, sw, lane);
        RAW_BARRIER();
        for (int c = 0; c < nch; c += 2) {
          st_compute<false>(K, RA, sw, lane, ops + TC * 384, scal + TC * 2);
          st_load<false>(p, RA, row0, b, h, (c + 3 < nch) ? c + 3 : c + 1, sw, lane);
          RAW_BARRIER();
          st_compute<false>(K, RB, sw, lane, ops, scal);
          st_load<false>(p, RB, row0, b, h, (c + 4 < nch) ? c + 4 : c + 2 < nch ? c + 2 : c, sw, lane);
          RAW_BARRIER();
        }
      }
    }
  }
}

__device__ __forceinline__ void pool_queue(const Params& p) {
  int* counter = (int*)(p.ws + O_CNT) + 2;
  while (true) {
    __syncthreads();
    if (threadIdx.x == 0) s_task = atomicAdd(counter, 1);
    __syncthreads();
    const int it = __builtin_amdgcn_readfirstlane(s_task);
    if (it >= 640) break;
    pool_item(p, it);
  }
}

__device__ __forceinline__ void mix1_phase(const Params& p) {
  const u16* Q = (const u16*)(p.ws + O_P);
  u16* Y = (u16*)(p.ws + O_Y);
  const u16* WM = (const u16*)(p.ws + O_WM);
  const int tid = threadIdx.x, lane = tid & 63, wave = tid >> 6;
  constexpr int N_GP = 512, N_GS = 128, N_LRU = MT / 16;
  for (int it = blockIdx.x; it < N_GP + N_GS + N_LRU; it += gridDim.x) {
    __syncthreads();
    if (it < N_GP) {
      const int h = it & 3, ck = (it >> 2) & 15, b = it >> 6;
      const int r0 = b * 2048 + ck * 128;
      u16* vT = (u16*)smem;
      {
        const u16* qb = Q + (size_t)(r0 + wave * 16) * 2048 + 512 + lane * 8;
        float lg[8], lb[8];
        if ((lane >> 4) == h) {
#pragma unroll
          for (int e = 0; e < 8; e++) { lg[e] = p.in[25][h * 128 + (lane & 15) * 8 + e]; lb[e] = p.in[26][h * 128 + (lane & 15) * 8 + e]; }
        } else {
#pragma unroll
          for (int e = 0; e < 8; e++) { lg[e] = 0.f; lb[e] = 0.f; }
        }
        uint4 cur0 = *(const uint4*)(qb), cur1 = *(const uint4*)(qb + 2048), cur2 = *(const uint4*)(qb + 2 * 2048), cur3 = *(const uint4*)(qb + 3 * 2048);
        for (int bt = 0; bt < 4; bt++) {
          uint4 nx0 = cur0, nx1 = cur1, nx2 = cur2, nx3 = cur3;
          if (bt < 3) {
            const u16* qn = qb + (size_t)(bt + 1) * 4 * 2048;
            nx0 = *(const uint4*)(qn); nx1 = *(const uint4*)(qn + 2048); nx2 = *(const uint4*)(qn + 2 * 2048); nx3 = *(const uint4*)(qn + 3 * 2048);
          }
#pragma unroll
          for (int u = 0; u < 4; u++) {
            const uint4 raw = (u == 0) ? cur0 : (u == 1) ? cur1 : (u == 2) ? cur2 : cur3;
            const int j = wave * 16 + bt * 4 + u;
            const u16* rp = (const u16*)&raw;
            float z[8];
            float sm = 0.f;
#pragma unroll
            for (int e = 0; e < 8; e++) { z[e] = geluf_(bf2f(rp[e])); sm += z[e]; }
            const float mean = wsum64(sm) * (1.0f / 512.0f);
            float s2 = 0.f;
#pragma unroll
            for (int e = 0; e < 8; e++) { z[e] -= mean; s2 += z[e] * z[e]; }
            const float rstd = rsqrtf(wsum64(s2) * (1.0f / 512.0f) + 1e-5f);
            if ((lane >> 4) == h) {
#pragma unroll
              for (int e = 0; e < 8; e++) {
                const int d = (lane & 15) * 8 + e;
                vT[d * 136 + j] = f2bf(z[e] * rstd * lg[e] + lb[e]);
              }
            }
          }
          cur0 = nx0; cur1 = nx1; cur2 = nx2; cur3 = nx3;
        }
      }
      __syncthreads();
      const int wm = wave >> 1, wn = wave & 1;
      f32x16 acc0, acc1;
#pragma unroll
      for (int i = 0; i < 16; i++) { acc0[i] = 0.f; acc1[i] = 0.f; }
      const u16* ag = WM + (size_t)h * 16384 + (size_t)(wm * 32 + (lane & 31)) * 128 + (lane >> 5) * 8;
      const u16* bb = vT + (wn * 64 + (lane & 31)) * 136 + (lane >> 5) * 8;
      const int nks = 2 * (wm + 1);
      for (int ks = 0; ks < nks; ks++) {
        bf16x8 a = *(const bf16x8*)(ag + ks * 16);
        bf16x8 b0 = *(const bf16x8*)(bb + ks * 16);
        bf16x8 b1 = *(const bf16x8*)(bb + 32 * 136 + ks * 16);
        acc0 = __builtin_amdgcn_mfma_f32_32x32x16_bf16(a, b0, acc0, 0, 0, 0);
        acc1 = __builtin_amdgcn_mfma_f32_32x32x16_bf16(a, b1, acc1, 0, 0, 0);
      }
      const int d0 = h * 128 + wn * 64 + (lane & 31), d1 = d0 + 32;
#pragma unroll 16
      for (int i = 0; i < 16; i++) {
        const int il = wm * 32 + (i & 3) + 8 * (i >> 2) + 4 * (lane >> 5);
        const int row = r0 + il;
        const float bsv = p.in[28][h * 128 + il];
        float u0 = geluf_(bf2f(Q[(size_t)row * 2048 + d0]));
        float u1 = geluf_(bf2f(Q[(size_t)row * 2048 + d1]));
        Y[(size_t)row * 1024 + d0] = f2bf(u0 * (acc0[i] + bsv));
        Y[(size_t)row * 1024 + d1] = f2bf(u1 * (acc1[i] + bsv));
      }
    } else if (it < N_GP + N_GS) {
      const int b = it - N_GP;
      const int r0 = NP + b * 4;
      float* vs = (float*)smem;
      if (wave < 4) {
        const int row = r0 + wave;
        uint4 raw = *(const uint4*)(Q + (size_t)row * 2048 + 512 + lane * 8);
        const u16* rp = (const u16*)&raw;
        float z[8];
        float s = 0.f;
#pragma unroll
        for (int e = 0; e < 8; e++) { z[e] = geluf_(bf2f(rp[e])); s += z[e]; }
        const float mean = wsum64(s) * (1.0f / 512.0f);
        float s2 = 0.f;
#pragma unroll
        for (int e = 0; e < 8; e++) { z[e] -= mean; s2 += z[e] * z[e]; }
        const float rstd = rsqrtf(wsum64(s2) * (1.0f / 512.0f) + 1e-5f);
#pragma unroll
        for (int e = 0; e < 8; e++) {
          const int d = lane * 8 + e;
          float vn = z[e] * rstd * p.in[25][d] + p.in[26][d];
          vs[wave * 512 + d] = vn;
          p.out[OUT_SGV + (size_t)(b * 4 + wave) * 512 + d] = vn;
        }
      }
      __syncthreads();
      {
        const int ch = tid, hh = ch >> 7;
        for (int i = 0; i < 4; i++) {
          float mix = p.in[28][hh * 128 + i];
          for (int j = 0; j <= i; j++) mix += p.in[27][(size_t)(hh * 128 + i) * 128 + j] * vs[j * 512 + ch];
          float u = geluf_(bf2f(Q[(size_t)(r0 + i) * 2048 + ch]));
          Y[(size_t)(r0 + i) * 1024 + ch] = f2bf(u * mix);
        }
      }
    } else {
      const int li = it - N_GP - N_GS;
      const int r0 = li * 16;
      u16* xcb = (u16*)smem;
      float* gxs = (float*)(smem + 16 * 520 * 2);
      float* gas = gxs + 16 * 512;
      const int ch = tid;
      float* CA = (float*)(p.ws + O_CA);
      float* HL = (float*)(p.ws + O_HL);
      float* SEG = (float*)(p.ws + O_SEG);
      const float cw0 = p.in[29][ch], cw1 = p.in[29][512 + ch], cw2 = p.in[29][1024 + ch], cw3 = p.in[29][1536 + ch];
      const float cb = p.in[30][ch];
      {
        float xr[19];
#pragma unroll
        for (int q = 0; q < 19; q++) {
          const int row = r0 - 3 + q;
          float v = 0.f;
          bool valid;
          int tq;
          if (r0 < NP) { tq = (r0 & 2047) - 3 + q; valid = tq >= 0; }
          else { valid = true; tq = 0; }
          if (r0 < NP) { if (valid) v = bf2f(Q[(size_t)row * 2048 + 1536 + ch]); }
          else v = bf2f(Q[(size_t)(row < NP ? NP : row) * 2048 + 1536 + ch]);
          xr[q] = v;
        }
#pragma unroll
        for (int q = 0; q < 16; q++) {
          float x0 = xr[q], x1 = xr[q + 1], x2 = xr[q + 2], x3 = xr[q + 3];
          if (r0 >= NP) {
            const int rs = r0 - NP + q;
            const int t = rs & 3;
            const float* st = p.in[5] + (size_t)(rs >> 2) * 1536 + ch;
            if (t < 3) x0 = st[t * 512];
            if (t < 2) x1 = st[(t + 1) * 512];
            if (t < 1) x2 = st[(t + 2) * 512];
          }
          const float xc = cb + cw0 * x0 + cw1 * x1 + cw2 * x2 + cw3 * x3;
          xcb[q * 520 + ch] = f2bf(xc);
        }
      }
      __syncthreads();
      {
        const u16* WXT = (const u16*)(p.ws + O_WXT);
        const int n = wave;
        typedef __attribute__((ext_vector_type(4))) float f32x4;
        f32x4 ac[8];
#pragma unroll
        for (int i = 0; i < 8; i++) { ac[i][0] = 0.f; ac[i][1] = 0.f; ac[i][2] = 0.f; ac[i][3] = 0.f; }
#pragma unroll
        for (int kh = 0; kh < 2; kh++) {
          const bf16x8 af = *(const bf16x8*)(xcb + (lane & 15) * 520 + n * 64 + kh * 32 + (lane >> 4) * 8);
          bf16x8 bfr[8];
#pragma unroll
          for (int i = 0; i < 8; i++) {
            const int w = i >> 2, dt = i & 3;
            bfr[i] = *(const bf16x8*)(WXT + ((size_t)((w * 8 + n) * 64 + dt * 16 + (lane & 15))) * 64 + kh * 32 + (lane >> 4) * 8);
          }
#pragma unroll
          for (int i = 0; i < 8; i++) ac[i] = __builtin_amdgcn_mfma_f32_16x16x32_bf16(af, bfr[i], ac[i], 0, 0, 0);
        }
#pragma unroll
        for (int i = 0; i < 8; i++) {
          const int w = i >> 2, dt = i & 3;
          float* dst = (w ? gas : gxs) + n * 64 + dt * 16 + (lane & 15);
#pragma unroll
          for (int r = 0; r < 4; r++) dst[((lane >> 4) * 4 + r) * 512] = ac[i][r];
        }
      }
      __syncthreads();
      const float bx = p.in[32][ch], ba = p.in[34][ch];
      const float lam = p.in[35][ch];
      const float spl = fmaxf(-lam, 0.f) + log1pf(__expf(-fabsf(lam)));
      float hl = 0.f, ca = 1.f;
#pragma unroll 4
      for (int q = 0; q < 16; q++) {
        const int row = r0 + q;
        if (row >= NP) {
          int rs = row - NP;
          if ((rs & 3) == 0) { hl = p.in[6][(size_t)(rs >> 2) * 512 + ch]; ca = 1.f; }
        }
        float gx = sigmoidf_(gxs[q * 512 + ch] + bx), ga = sigmoidf_(gas[q * 512 + ch] + ba);
        float la = -8.0f * ga * spl;
        float a = __expf(la);
        float bb = __builtin_amdgcn_sqrtf(fmaxf(1.0f - a * a, 0.f)) * gx * bf2f(xcb[q * 520 + ch]);
        hl = a * hl + bb;
        ca = ca * a;
        CA[(size_t)row * 512 + ch] = ca;
        HL[(size_t)row * 512 + ch] = hl;
      }
      SEG[(size_t)li * 1024 + ch] = ca;
      SEG[(size_t)li * 1024 + 512 + ch] = hl;
    }
  }
}

__device__ __forceinline__ void lru_fix_phase(const Params& p, const XcdBarrier& xb) {
  const u16* Q = (const u16*)(p.ws + O_P);
  u16* Y = (u16*)(p.ws + O_Y);
  const float* CA = (const float*)(p.ws + O_CA);
  const float* HL = (const float*)(p.ws + O_HL);
  const float* SEG = (const float*)(p.ws + O_SEG);
  const int ch = threadIdx.x;
  const bool blocked = (gridDim.x == 256);
  for (int k = 0; k < (blocked ? 1 : 0); k++) {
    const int li0 = blockIdx.x * 4;
    const int b = li0 >> 7, s0 = li0 & 127;
    const float* sg = SEG + (size_t)(b * 128) * 1024 + ch;
    float carry = 0.f;
#pragma unroll 8
    for (int q = 0; q < s0; q++) carry = sg[(size_t)q * 1024] * carry + sg[(size_t)q * 1024 + 512];
    for (int u = 0; u < 4; u++) {
      const int li = li0 + u;
      const int r0 = li * 16;
#pragma unroll 8
      for (int q = 0; q < 16; q++) {
        const int row = r0 + q;
        float hv = HL[(size_t)row * 512 + ch] + CA[(size_t)row * 512 + ch] * carry;
        float gate = geluf_(bf2f(Q[(size_t)row * 2048 + 1024 + ch]));
        Y[(size_t)row * 1024 + 512 + ch] = f2bf(hv * gate);
        if ((row & 2047) == 2047) p.out[OUT_PLRU + (size_t)(row >> 11) * 512 + ch] = hv;
      }
      carry = sg[(size_t)(s0 + u) * 1024] * carry + sg[(size_t)(s0 + u) * 1024 + 512];
    }
  }
  for (int li = (blocked ? 1024 : 0) + blockIdx.x; li < MT / 16; li += gridDim.x) {
    const int r0 = li * 16;
    float carry = 0.f;
    if (r0 < NP) {
      const int b = r0 >> 11, sN = (r0 & 2047) >> 4;
      const float* sg = SEG + (size_t)(b * 128) * 1024 + ch;
      for (int q = 0; q < sN; q++) carry = sg[(size_t)q * 1024] * carry + sg[(size_t)q * 1024 + 512];
    }
#pragma unroll 8
    for (int q = 0; q < 16; q++) {
      const int row = r0 + q;
      float hv = HL[(size_t)row * 512 + ch] + CA[(size_t)row * 512 + ch] * carry;
      float gate = geluf_(bf2f(Q[(size_t)row * 2048 + 1024 + ch]));
      Y[(size_t)row * 1024 + 512 + ch] = f2bf(hv * gate);
      if (row < NP) {
        if ((row & 2047) == 2047) p.out[OUT_PLRU + (size_t)(row >> 11) * 512 + ch] = hv;
      } else {
        int rs = row - NP;
        if ((rs & 3) == 3) p.out[OUT_SLRU + (size_t)(rs >> 2) * 512 + ch] = hv;
      }
    }
  }
  const int gt = blockIdx.x * 512 + threadIdx.x, gs = gridDim.x * 512;
  for (int e = gt; e < 8 * 3 * 512; e += gs) {
    int b = e / 1536, i = (e / 512) % 3, c = e & 511;
    p.out[OUT_PCONV + e] = bf2f(Q[(size_t)(b * 2048 + 2045 + i) * 2048 + 1536 + c]);
  }
  for (int e = gt; e < 128 * 3 * 512; e += gs) {
    int b = e / 1536, i = (e / 512) % 3, c = e & 511;
    p.out[OUT_SCONV + e] = bf2f(Q[(size_t)(NP + b * 4 + 1 + i) * 2048 + 1536 + c]);
  }
}

__device__ __forceinline__ void res_fix_phase(const Params& p) {
  u16* xb = (u16*)(p.ws + O_XB);
  float* part = (float*)(p.ws + O_PART);
  const int lane = threadIdx.x & 63, wave = threadIdx.x >> 6;
  for (int row = NP + blockIdx.x * 8 + wave; row < MT; row += gridDim.x * 8) {
    const float* xr = p.out + (size_t)row * 1024;
    float ss = 0.f;
#pragma unroll
    for (int i = 0; i < 4; i++) {
      float4 v = *(const float4*)(xr + i * 256 + lane * 4);
      ss += v.x * v.x + v.y * v.y + v.z * v.z + v.w * v.w;
      ushort4 o;
      o.x = f2bf(v.x); o.y = f2bf(v.y); o.z = f2bf(v.z); o.w = f2bf(v.w);
      *(ushort4*)(xb + (size_t)row * 1024 + i * 256 + lane * 4) = o;
    }
    ss = wsum64(ss);
    if (lane < 16) part[(size_t)row * 16 + lane] = (lane == 0) ? ss : 0.f;
  }
}

__device__ __forceinline__ void final_phase(const Params& p) {
  const float* part = (const float*)(p.ws + O_PART);
  const float* g = p.in[40];
  const int lane = threadIdx.x & 63, wave = threadIdx.x >> 6;
  for (int row = blockIdx.x * 8 + wave; row < MT; row += gridDim.x * 8) {
    float s = (lane < 16) ? part[(size_t)row * 16 + lane] : 0.f;
    s = wsum64(s);
    const float rs = rsqrtf(s * (1.0f / 1024.0f) + 1e-6f);
    float* xr = p.out + (size_t)row * 1024;
#pragma unroll
    for (int i = 0; i < 4; i++) {
      float4 v = *(float4*)(xr + i * 256 + lane * 4);
      float4 gg = *(const float4*)(g + i * 256 + lane * 4);
      v.x *= rs * gg.x; v.y *= rs * gg.y; v.z *= rs * gg.z; v.w *= rs * gg.w;
      *(float4*)(xr + i * 256 + lane * 4) = v;
    }
  }
}


constexpr int NPHASE = 22;
enum { K_P0 = 0, K_G_SCALE, K_G_PLAIN, K_G_FF1, K_G_RES, K_G_POST, K_POOL, K_SCAN, K_MIX1, K_LRUFIX, K_FINAL };

#define PH(n, sync_) if (plo <= (n) && (n) <= phi) { if ((n) > plo && (sync_)) { if ((n) == 1) { grid.sync(); xb = xcd_barrier_post((unsigned*)(ws + O_XBAR), (volatile LAS unsigned*)&xb_words); } else xcd_barrier(xb); }
#define PHEND }
#define WSB(o) ((const u16*)(ws + (o)))
#define WSO(o) ((u16*)(ws + (o)))
__global__ void __launch_bounds__(512) mega(Params p, int plo, int phi) {
  cg::grid_group grid = cg::this_grid();
  char* ws = p.ws;
  __shared__ uint4 xb_words;
  if (threadIdx.x == 0) xb_words = make_uint4(0u, 0u, 0u, 0u);
  __syncthreads();
  XcdBarrier xb; xb.bar = (unsigned*)(ws + O_XBAR); xb.x = 0; xb.st = (volatile LAS unsigned*)&xb_words;
  PH(0, 1) phase0(p); PHEND
  PH(1, 1) gemm_phase<EPI_SCALE>(p, WSB(O_XB), 1024, WSB(O_WIN0), 1024, 1024, 2816, WSO(O_P), 2816, 0, 0); PHEND
  PH(2, 1) pool_phase(p); PHEND
  PH(3, 1) gemm_phase<EPI_PLAIN>(p, WSB(O_LIN), 256, WSB(O_WLW), 64, 64, 768, WSO(O_WPRE), 768, 0, 0); PHEND
  PH(4, 0) gemm_phase<EPI_PLAIN>(p, WSB(O_LIN + 128), 256, WSB(O_WLA), 64, 64, 768, WSO(O_APRE), 768, 0, 140); PHEND
  PH(5, 1) rwkv_prep_phase(p); PHEND
  PH(6, 1) scan_phase(p, 0, 0, 3264); pool_queue(p); PHEND
  PH(7, 1) gemm_phase<EPI_POST>(p, WSB(O_LIN + 256), 256, WSB(O_WLG), 128, 128, 768, nullptr, 0, 0, 0); PHEND
  PH(8, 1) gemm_phase<EPI_RES>(p, WSB(O_Y), 1024, WSB(O_WOUT0), 1024, 1024, 1024, WSO(O_XB), 1024, 1, 0); PHEND
  PH(9, 1) res_fix_phase(p); PHEND
  PH(10, 1) gemm_phase<EPI_FF1>(p, WSB(O_XB), 1024, WSB(O_WF10), 1024, 1024, 4096, WSO(O_H), 4096, 0, 0); PHEND
  PH(11, 1) gemm_phase<EPI_RES>(p, WSB(O_H), 4096, WSB(O_WF20), 4096, 4096, 1024, WSO(O_XB), 1024, 0, 0); PHEND
  PH(12, 1) res_fix_phase(p); PHEND
  PH(13, 1) gemm_phase<EPI_SCALE>(p, WSB(O_XB), 1024, WSB(O_WIN1), 1024, 1024, 2048, WSO(O_P), 2048, 0, 0); PHEND
  PH(14, 1) mix1_phase(p); PHEND
  PH(15, 1) lru_fix_phase(p, xb); PHEND
  PH(16, 1) gemm_phase<EPI_RES>(p, WSB(O_Y), 1024, WSB(O_WOUT1), 1024, 1024, 1024, WSO(O_XB), 1024, 0, 0); PHEND
  PH(17, 1) res_fix_phase(p); PHEND
  PH(18, 1) gemm_phase<EPI_FF1>(p, WSB(O_XB), 1024, WSB(O_WF11), 1024, 1024, 4096, WSO(O_H), 4096, 0, 0); PHEND
  PH(19, 1) gemm_phase<EPI_RES>(p, WSB(O_H), 4096, WSB(O_WF21), 4096, 4096, 1024, WSO(O_XB), 1024, 0, 0); PHEND
  PH(20, 1) res_fix_phase(p); PHEND
  PH(21, 1) final_phase(p); PHEND
}

extern "C" void kernel_launch(void* const* d_in, const int* in_sizes, int n_in, void* d_out, int out_size, void* d_ws,
                              size_t ws_size, hipStream_t stream) {
  static int grid_blocks = 0;
  if (!grid_blocks) {
    int dev = 0, cus = 0, per_cu = 0;
    hipGetDevice(&dev);
    hipDeviceGetAttribute(&cus, hipDeviceAttributeMultiprocessorCount, dev);
    hipOccupancyMaxActiveBlocksPerMultiprocessor(&per_cu, mega, 512, 0);
    if (per_cu < 1) per_cu = 1;
    grid_blocks = cus;
    if (grid_blocks > cus * per_cu) grid_blocks = cus * per_cu;
    if (ws_size < WS_NEED) fprintf(stderr, "workspace too small: %zu < %zu\n", ws_size, (size_t)WS_NEED);
  }
  Params p{};
  for (int i = 0; i < 41; i++) p.in[i] = (const float*)d_in[i];
  p.out = (float*)d_out;
  p.ws = (char*)d_ws;
  int plo = 0, phi = NPHASE - 1;
  void* args[] = {&p, &plo, &phi};
  hipError_t e = hipLaunchCooperativeKernel((void*)mega, dim3(grid_blocks), dim3(512), args, 0, stream);
  if (e != hipSuccess) fprintf(stderr, "cooperative launch failed: %s (grid %d)\n", hipGetErrorString(e), grid_blocks);
}
```

```cpp
#include <hip/hip_runtime.h>
#include <hip/hip_cooperative_groups.h>
#include <cstdio>
namespace cg = cooperative_groups;

typedef unsigned short u16;
typedef __attribute__((ext_vector_type(8))) short bf16x8;
typedef __attribute__((ext_vector_type(16))) float f32x16;

constexpr int MT = 16896;
constexpr int NP = 16384;

struct Params {
  const float* in[41];
  float* out;
  char* ws;
};

constexpr size_t OUT_Y = 0;
constexpr size_t OUT_PPOOL = (size_t)MT * 1024;
constexpr size_t OUT_PSHIFT = OUT_PPOOL + 8 * 15 * 256;
constexpr size_t OUT_PWKV = OUT_PSHIFT + 8 * 2560;
constexpr size_t OUT_PCONV = OUT_PWKV + 8 * 12 * 4096;
constexpr size_t OUT_PLRU = OUT_PCONV + 8 * 3 * 512;
constexpr size_t OUT_SPOOL = OUT_PLRU + 8 * 512;
constexpr size_t OUT_SSHIFT = OUT_SPOOL + 128 * 15 * 256;
constexpr size_t OUT_SWKV = OUT_SSHIFT + 128 * 2560;
constexpr size_t OUT_SCONV = OUT_SWKV + (size_t)128 * 12 * 4096;
constexpr size_t OUT_SLRU = OUT_SCONV + 128 * 3 * 512;
constexpr size_t OUT_SGV = OUT_SLRU + 128 * 512;

constexpr size_t O_WIN0 = 0;
constexpr size_t O_WOUT0 = O_WIN0 + 2816ull * 1024 * 2;
constexpr size_t O_WF10 = O_WOUT0 + 1024ull * 1024 * 2;
constexpr size_t O_WF20 = O_WF10 + 4096ull * 1024 * 2;
constexpr size_t O_WIN1 = O_WF20 + 4096ull * 1024 * 2;
constexpr size_t O_WOUT1 = O_WIN1 + 2048ull * 1024 * 2;
constexpr size_t O_WF11 = O_WOUT1 + 1024ull * 1024 * 2;
constexpr size_t O_WF21 = O_WF11 + 4096ull * 1024 * 2;
constexpr size_t O_WLW = O_WF21 + 4096ull * 1024 * 2;
constexpr size_t O_WLA = O_WLW + 768 * 64 * 2;
constexpr size_t O_WLG = O_WLA + 768 * 64 * 2;
constexpr size_t O_WM = O_WLG + 768 * 128 * 2;
constexpr size_t O_CNT = O_WM + 4 * 128 * 128 * 2;
constexpr size_t O_PART = O_CNT + 256;
constexpr size_t O_XB = O_PART + (size_t)MT * 16 * 4;
constexpr size_t O_Y = O_XB + (size_t)MT * 1024 * 2;
constexpr size_t O_AR = O_Y + (size_t)MT * 1024 * 2;
constexpr size_t O_P = O_AR;
constexpr size_t O_LIN = O_P + (size_t)MT * 2816 * 2;
constexpr size_t O_WPRE = O_LIN + (size_t)MT * 256 * 2;
constexpr size_t O_APRE = O_XB;
constexpr size_t O_BS = O_APRE + (size_t)MT * 768 * 2;
constexpr size_t O_CA = O_AR + (size_t)MT * 2048 * 2;
constexpr size_t O_HL = O_CA + (size_t)MT * 512 * 4;
constexpr size_t O_SEG = O_HL + (size_t)MT * 512 * 4;
constexpr size_t O_H = O_AR;
constexpr size_t O_XBAR = O_SEG + (size_t)1056 * 1024 * 4;
constexpr size_t O_CAR = O_XBAR + 16384;
constexpr size_t O_WXT = O_CAR + (size_t)1024 * 512 * 4;
constexpr size_t WS_NEED = O_WXT + 131072;

__device__ __forceinline__ u16 f2bf(float f) {
  __bf16 h = (__bf16)f;
  return __builtin_bit_cast(u16, h);
}
__device__ __forceinline__ float bf2f(u16 h) { return __uint_as_float(((unsigned)h) << 16); }
__device__ __forceinline__ float frcp_(float x) { return __builtin_amdgcn_rcpf(x); }
__device__ __forceinline__ float sigmoidf_(float x) { return frcp_(1.0f + __expf(-x)); }
__device__ __forceinline__ float tanhf_(float x) {
  float e = __expf(2.0f * x);
  return 1.0f - 2.0f * frcp_(1.0f + e);
}
__device__ __forceinline__ float geluf_(float x) {
  float y = 0.7978845608028654f * (x + 0.044715f * x * x * x);
  return 0.5f * x * (1.0f + tanhf_(y));
}
template <int CTRL>
__device__ __forceinline__ float dppmov(float v) {
  return __int_as_float(__builtin_amdgcn_update_dpp(0, __float_as_int(v), CTRL, 0xF, 0xF, true));
}
__device__ __forceinline__ float reduce8(float v) {
  v += dppmov<0xB1>(v);
  v += dppmov<0x4E>(v);
  v += dppmov<0x141>(v);
  return v;
}
__device__ __forceinline__ float row16sum(float v) {
  v += dppmov<0xB1>(v);
  v += dppmov<0x4E>(v);
  v += dppmov<0x141>(v);
  v += dppmov<0x140>(v);
  return v;
}
__device__ __forceinline__ float wsum64(float v) {
  v = row16sum(v);
  v += __int_as_float(__builtin_amdgcn_update_dpp(0, __float_as_int(v), 0x142, 0xA, 0xF, false));
  v += __int_as_float(__builtin_amdgcn_update_dpp(0, __float_as_int(v), 0x143, 0xC, 0xF, false));
  return __int_as_float(__builtin_amdgcn_readlane(__float_as_int(v), 63));
}
__device__ __forceinline__ float hsum32(float v) {
  v = row16sum(v);
  return v + __shfl_xor(v, 16);
}
__device__ __forceinline__ const float* xrow(const Params& p, int row) {
  return row < NP ? p.in[0] + (size_t)row * 1024 : p.in[1] + (size_t)(row - NP) * 1024;
}
__device__ __forceinline__ float prevP(const Params& p, const u16* P, int row, int c) {
  const int rp = row > 0 ? row - 1 : 0;
  float v = bf2f(P[(size_t)rp * 2816 + 256 + c]);
  const bool start = (row < NP) ? ((row & 2047) == 0) : (((row - NP) & 3) == 0);
  if (start) v = (row < NP) ? 0.f : p.in[3][(size_t)((row - NP) >> 2) * 2560 + c];
  return v;
}

__shared__ __attribute__((aligned(16))) unsigned char smem[114688];
#define RAW_BARRIER() do { asm volatile("s_waitcnt lgkmcnt(0)" ::: "memory"); __builtin_amdgcn_s_barrier(); asm volatile("" ::: "memory"); } while (0)
__shared__ int s_task;
__shared__ int s_simdcnt[4];
__shared__ int s_role[8];
__shared__ int s_role2[8];

#define XB_TMO      128
#define XB_XCNT(j)  (256  + 64 * (j))
#define XB_XSUB(j)  (1280 + 64 * (j))
#define XB_XGEN(j)  (2304 + 64 * (j))
#define XB_TOP      3328
#define XB_TOPGEN   3392
#define XCD_BAR_WORDS 3456
#define XB_SPIN_CAP (1u << 18)
#define LAS __attribute__((address_space(3)))

__device__ __forceinline__ unsigned xb_ld(unsigned* p)              { return __hip_atomic_load(p, __ATOMIC_RELAXED, __HIP_MEMORY_SCOPE_AGENT); }
__device__ __forceinline__ unsigned xb_add(unsigned* p, unsigned v) { return __hip_atomic_fetch_add(p, v, __ATOMIC_RELAXED, __HIP_MEMORY_SCOPE_AGENT); }
__device__ __forceinline__ unsigned xb_xcc_id() { return (unsigned)__builtin_amdgcn_s_getreg((3 << 11) | 20) & 0xFu; }
#define XB_SPIN(cond, bar) do { unsigned _sp = 0; while (cond) { __builtin_amdgcn_s_sleep(1); \
    if ((++_sp & 255u) == 0u) { if (xb_ld(&(bar)[XB_TMO])) break; if (_sp > XB_SPIN_CAP) { atomicAdd(&(bar)[XB_TMO], 1u); break; } } } } while (0)

struct XcdBarrier {
    unsigned* bar; unsigned x;
    volatile LAS unsigned* st;
};

__device__ __forceinline__ XcdBarrier xcd_barrier_post(unsigned* bar, volatile LAS unsigned* st) {
    XcdBarrier b; b.bar = bar; b.x = xb_xcc_id(); b.st = st;
    if (threadIdx.x == 0) (void)xb_add(&bar[XB_XCNT(b.x)], 1u);
    return b;
}
__device__ __forceinline__ void xcd_barrier_complete(unsigned* bar, unsigned x, unsigned& nloc, unsigned& nx) {
    const unsigned G = gridDim.x * gridDim.y * gridDim.z;
    unsigned sum, cnt, mine, sp = 0u;
    for (;;) {
        sum = 0u; cnt = 0u; mine = 0u;
#pragma unroll
        for (unsigned j = 0; j < 16; ++j) { const unsigned c = xb_ld(&bar[XB_XCNT(j)]); sum += c; cnt += (c > 0u) ? 1u : 0u; mine = (j == x) ? c : mine; }
        if (sum == G) break;
        __builtin_amdgcn_s_sleep(1);
        if ((++sp & 255u) == 0u) { if (xb_ld(&bar[XB_TMO])) break; if (sp > XB_SPIN_CAP) { atomicAdd(&bar[XB_TMO], 1u); break; } }
    }
    nloc = mine > 0u ? mine : 1u; nx = cnt > 0u ? cnt : 1u;
}

__device__ __forceinline__ void xcd_barrier(const XcdBarrier& b) {
    asm volatile("s_waitcnt vmcnt(0)" ::: "memory");
    __syncthreads();
    if (threadIdx.x == 0) {
        unsigned* bar = b.bar;
        __builtin_amdgcn_s_waitcnt(0);
        unsigned nloc = b.st[0], nx = b.st[1];
        if (nloc == 0u) { xcd_barrier_complete(bar, b.x, nloc, nx); b.st[0] = nloc; b.st[1] = nx; }
        const unsigned old = xb_add(&bar[XB_XSUB(b.x)], 1u);
        const unsigned gen = old / nloc;
        if (old + 1u == (gen + 1u) * nloc) {
            __builtin_amdgcn_fence(__ATOMIC_RELEASE, "agent");
            asm volatile("s_waitcnt vmcnt(0)" ::: "memory");
            const unsigned og = xb_add(&bar[XB_TOP], 1u);
            const unsigned tg = og / nx;
            if (og + 1u == (tg + 1u) * nx) xb_add(&bar[XB_TOPGEN], 1u);
            else XB_SPIN(xb_ld(&bar[XB_TOPGEN]) == tg, bar);
            __builtin_amdgcn_fence(__ATOMIC_ACQUIRE, "agent");
            xb_add(&bar[XB_XGEN(b.x)], 1u);
            asm volatile("s_waitcnt vmcnt(0)" ::: "memory");
        } else {
            XB_SPIN(xb_ld(&bar[XB_XGEN(b.x)]) == gen, bar);
            __builtin_amdgcn_fence(__ATOMIC_ACQUIRE, "agent");
            asm volatile("s_waitcnt vmcnt(0)" ::: "memory");
        }
    }
    __syncthreads();
}


__device__ __forceinline__ void convT(const float* __restrict__ W, int K, int N, const float* __restrict__ g, u16* __restrict__ WT) {
  float* t = (float*)smem;
  const int tilesN = N / 128, tiles = (K / 64) * tilesN;
  const int tx = threadIdx.x & 127, ty = threadIdx.x >> 7;
  const int sx = threadIdx.x & 63, sy = threadIdx.x >> 6;
  for (int tl = blockIdx.x; tl < tiles; tl += gridDim.x) {
    const int k0 = (tl / tilesN) * 64, n0 = (tl % tilesN) * 128;
    float v[16];
#pragma unroll
    for (int i = 0; i < 16; i++) v[i] = W[(size_t)(k0 + ty + 4 * i) * N + n0 + tx];
    if (g) {
#pragma unroll
      for (int i = 0; i < 16; i++) v[i] *= g[k0 + ty + 4 * i];
    }
    __syncthreads();
#pragma unroll
    for (int i = 0; i < 16; i++) t[(ty + 4 * i) * 129 + tx] = v[i];
    __syncthreads();
#pragma unroll
    for (int i = 0; i < 16; i++) {
      const int n = sy + 8 * i;
      WT[(size_t)(n0 + n) * K + k0 + sx] = f2bf(t[sx * 129 + n]);
    }
  }
}

__device__ __forceinline__ void phase0(const Params& p) {
  char* ws = p.ws;
  convT(p.in[8], 1024, 2816, p.in[7], (u16*)(ws + O_WIN0));
  convT(p.in[22], 1024, 1024, nullptr, (u16*)(ws + O_WOUT0));
  convT(p.in[38], 1024, 4096, p.in[37], (u16*)(ws + O_WF10));
  convT(p.in[39], 4096, 1024, nullptr, (u16*)(ws + O_WF20));
  convT(p.in[24], 1024, 2048, p.in[23], (u16*)(ws + O_WIN1));
  convT(p.in[36], 1024, 1024, nullptr, (u16*)(ws + O_WOUT1));
  convT(p.in[38] + (size_t)1024 * 4096, 1024, 4096, p.in[37] + 1024, (u16*)(ws + O_WF11));
  convT(p.in[39] + (size_t)1024 * 4096, 4096, 1024, nullptr, (u16*)(ws + O_WF21));
  convT(p.in[13], 64, 768, nullptr, (u16*)(ws + O_WLW));
  convT(p.in[15], 64, 768, nullptr, (u16*)(ws + O_WLA));
  convT(p.in[16], 128, 768, nullptr, (u16*)(ws + O_WLG));
  {
    u16* wm = (u16*)(ws + O_WM);
    const float* wsrc = p.in[27];
    for (int e = blockIdx.x * 512 + threadIdx.x; e < 4 * 128 * 128; e += gridDim.x * 512) {
      int i = (e >> 7) & 127, j = e & 127;
      wm[e] = (j <= i) ? f2bf(wsrc[e]) : (u16)0;
    }
  }
  {
    u16* wxt = (u16*)(ws + O_WXT);
    for (int e = blockIdx.x * 512 + threadIdx.x; e < 16 * 64 * 64; e += gridDim.x * 512) {
      const int m = e >> 12, d = (e >> 6) & 63, c = e & 63;
      const float* src = (m < 8) ? p.in[31] : p.in[33];
      wxt[e] = f2bf(src[(m & 7) * 4096 + c * 64 + d]);
    }
  }
  if (blockIdx.x == 0 && threadIdx.x < 64) ((int*)(ws + O_CNT))[threadIdx.x] = 0;
  if (blockIdx.x == 1) for (int e = threadIdx.x; e < 3456; e += 512) ((unsigned*)(ws + O_XBAR))[e] = 0u;
  for (int e = blockIdx.x * 512 + threadIdx.x; e < 512 * 256; e += gridDim.x * 512) ((float4*)(p.out + (size_t)NP * 1024))[e] = ((const float4*)p.in[1])[e];
  {
    u16* xb = (u16*)(ws + O_XB);
    float* part = (float*)(ws + O_PART);
    const int lane = threadIdx.x & 63, wave = threadIdx.x >> 6;
    for (int row = blockIdx.x * 8 + wave; row < MT; row += gridDim.x * 8) {
      const float* xr = xrow(p, row);
      float ss = 0.f;
#pragma unroll
      for (int i = 0; i < 4; i++) {
        float4 v = *(const float4*)(xr + i * 256 + lane * 4);
        ss += v.x * v.x + v.y * v.y + v.z * v.z + v.w * v.w;
        ushort4 o;
        o.x = f2bf(v.x); o.y = f2bf(v.y); o.z = f2bf(v.z); o.w = f2bf(v.w);
        *(ushort4*)(xb + (size_t)row * 1024 + i * 256 + lane * 4) = o;
      }
      ss = wsum64(ss);
      if (lane < 16) part[(size_t)row * 16 + lane] = (lane == 0) ? ss : 0.f;
    }
  }
}

enum { EPI_SCALE = 0, EPI_PLAIN = 1, EPI_FF1 = 2, EPI_RES = 3, EPI_POST = 4 };

template <int EPI>
__device__ __forceinline__ void gemm_epi(const Params& p, const f32x16 acc0, const f32x16 acc1, int mi, int wm, int wn, int lane,
                                         int m0, int nt, int c0, int c1, const float* sRs, u16* __restrict__ outb, int ldo,
                                         int resid_in) {
  float* part = (float*)(p.ws + O_PART);
  float* xf = p.out;
    const int rbase = wm * 64 + mi * 32 + 4 * (lane >> 5);
    if (EPI == EPI_SCALE || EPI == EPI_PLAIN || EPI == EPI_FF1) {
#pragma unroll
      for (int i = 0; i < 16; i++) {
        const int rl = rbase + (i & 3) + 8 * (i >> 2);
        const int row = m0 + rl;
        float v0 = acc0[i], v1 = acc1[i];
        if (EPI != EPI_PLAIN) { float rs = sRs[rl]; v0 *= rs; v1 *= rs; }
        if (EPI == EPI_FF1) { v0 = fmaxf(v0, 0.f); v1 = fmaxf(v1, 0.f); v0 *= v0; v1 *= v1; }
        outb[(size_t)row * ldo + c0] = f2bf(v0);
        outb[(size_t)row * ldo + c1] = f2bf(v1);
      }
    } else if (EPI == EPI_RES) {
#pragma unroll
      for (int i = 0; i < 16; i++) {
        const int rl = rbase + (i & 3) + 8 * (i >> 2);
        const int row = m0 + rl;
        float v0 = acc0[i], v1 = acc1[i];
        xf[(size_t)row * 1024 + c0] = v0;
        xf[(size_t)row * 1024 + c1] = v1;
        outb[(size_t)row * 1024 + c0] = f2bf(v0);
        outb[(size_t)row * 1024 + c1] = f2bf(v1);
        float s = hsum32(v0 * v0 + v1 * v1);
        if ((lane & 31) == 0) part[(size_t)row * 16 + nt * 2 + wn] = s;
      }
    } else {
      const int hh = nt * 2 + wn;
      const u16* P = (const u16*)(p.ws + O_P);
      u16* Y = (u16*)(p.ws + O_Y);
      const float* bs = (const float*)(p.ws + O_BS);
      const int ch0 = hh * 64 + (lane & 31), ch1 = ch0 + 32;
      const float gg0 = p.in[20][ch0], gg1 = p.in[20][ch1];
      const float gb0 = p.in[21][ch0], gb1 = p.in[21][ch1];
      const float mu0 = p.in[11][1536 + ch0], mu1 = p.in[11][1536 + ch1];
#pragma unroll 16
      for (int i = 0; i < 16; i++) {
        const int rl = rbase + (i & 3) + 8 * (i >> 2);
        const int row = m0 + rl;
        float o0 = bf2f(Y[(size_t)row * 1024 + 256 + ch0]);
        float o1 = bf2f(Y[(size_t)row * 1024 + 256 + ch1]);
        float mean = hsum32(o0 + o1) * (1.0f / 64.0f);
        float d0 = o0 - mean, d1 = o1 - mean;
        float var = hsum32(d0 * d0 + d1 * d1) * (1.0f / 64.0f);
        float rstd = rsqrtf(var + 64e-5f);
        float pv0 = bf2f(P[(size_t)row * 2816 + 256 + 1536 + ch0]);
        float pv1 = bf2f(P[(size_t)row * 2816 + 256 + 1536 + ch1]);
        float pp0 = prevP(p, P, row, 1536 + ch0), pp1 = prevP(p, P, row, 1536 + ch1);
        float vv0 = pv0 + (pp0 - pv0) * mu0, vv1 = pv1 + (pp1 - pv1) * mu1;
        float b = bs[((size_t)row * 12 + hh) * 4 + 2];
        float y0 = (d0 * rstd * gg0 + gb0 + b * vv0) * acc0[i];
        float y1 = (d1 * rstd * gg1 + gb1 + b * vv1) * acc1[i];
        Y[(size_t)row * 1024 + 256 + ch0] = f2bf(y0);
        Y[(size_t)row * 1024 + 256 + ch1] = f2bf(y1);
      }
    }
}

template <int EPI>
__device__ __forceinline__ void gemm_phase(const Params& p, const u16* __restrict__ A, int lda, const u16* __restrict__ BT, int ldb,
                           int K, int N, u16* __restrict__ outb, int ldo, int resid_in, int boff) {
  constexpr int LS = 72;
  constexpr int SA = 256 * LS, SB = 128 * LS, STG = SA + SB;
  u16* sm = (u16*)smem;
  float* sRs = (float*)(sm + 2 * STG);
  const int tid = threadIdx.x, lane = tid & 63, wave = tid >> 6;
  const int wm = wave >> 1, wn = wave & 1;
  const int lrow = tid >> 3, lch = tid & 7;
  const int NT = N / 128;
  const int tiles = (MT / 256) * NT;
  const int KTALL = K / 64;
  float* part = (float*)(p.ws + O_PART);
  int bstart = (int)blockIdx.x - boff;
  if (bstart < 0) bstart += gridDim.x;
  const size_t a64 = (size_t)64 * lda, b64 = (size_t)64 * ldb;
  const int G = gridDim.x;
  int t_full = tiles, split = 1;
  if (EPI == EPI_RES) {
    const int tail = tiles % G;
    if (tail > 0 && (G % tail) == 0 && (KTALL % (G / tail)) == 0) { t_full = tiles - tail; const int smax = (KTALL >= 64) ? 8 : 4; split = (G / tail) > smax ? smax : (G / tail); }
  }
  const int units = t_full + (tiles - t_full) * split;
  for (int un = bstart; un < units; un += G) {
    int tl = un, kbeg = 0, KT = KTALL;
    bool part_unit = false;
    if (un >= t_full) { const int v = un - t_full; tl = t_full + v / split; KT = KTALL / split; kbeg = (v % split) * KT; part_unit = true; }
    int mt = tl / NT, nt = tl % NT;
    if (EPI == EPI_RES && NT == 8 && G == 256 && !part_unit) {
      const int rr = tl >> 8, bb = tl & 255;
      const int xx = bb & 7, jj = bb >> 3;
      mt = rr * 32 + xx * 4 + (jj >> 3);
      nt = jj & 7;
    } else if ((EPI == EPI_FF1 || EPI == EPI_SCALE) && G == 256 && (NT == 32 || NT == 16) && tl < (tiles & ~255)) {
      const int rr = tl >> 8, bb = tl & 255;
      const int xx = bb & 7, jj = bb >> 3;
      if (NT == 32) { mt = rr * 8 + (xx >> 2) * 4 + (jj >> 3); nt = (xx & 3) * 8 + (jj & 7); }
      else { mt = rr * 16 + (xx >> 1) * 4 + (jj >> 3); nt = (xx & 1) * 8 + (jj & 7); }
    }
    const int m0 = mt * 256, n0 = nt * 128;
    const u16* gA = A + (size_t)(m0 + lrow) * lda + lch * 8 + (size_t)kbeg * 64;
    const u16* gB = BT + (size_t)(n0 + lrow) * ldb + lch * 8 + (size_t)kbeg * 64;
    uint4 xa0, xa1, xa2, xa3, xb0, xb1;
    uint4 ya0, ya1, ya2, ya3, yb0, yb1;
#define LOADX(kt_) { const u16* qa = gA + (kt_) * 64; const u16* qb = gB + (kt_) * 64; \
    xa0 = *(const uint4*)qa; xa1 = *(const uint4*)(qa + a64); xa2 = *(const uint4*)(qa + 2 * a64); xa3 = *(const uint4*)(qa + 3 * a64); \
    xb0 = *(const uint4*)qb; xb1 = *(const uint4*)(qb + b64); }
#define LOADY(kt_) { const u16* qa = gA + (kt_) * 64; const u16* qb = gB + (kt_) * 64; \
    ya0 = *(const uint4*)qa; ya1 = *(const uint4*)(qa + a64); ya2 = *(const uint4*)(qa + 2 * a64); ya3 = *(const uint4*)(qa + 3 * a64); \
    yb0 = *(const uint4*)qb; yb1 = *(const uint4*)(qb + b64); }
#define WRITEX(st_) { u16* wa = sm + (st_) * STG + lrow * LS + lch * 8; u16* wb = wa + SA; \
    *(uint4*)wa = xa0; *(uint4*)(wa + 64 * LS) = xa1; *(uint4*)(wa + 128 * LS) = xa2; *(uint4*)(wa + 192 * LS) = xa3; \
    *(uint4*)wb = xb0; *(uint4*)(wb + 64 * LS) = xb1; }
#define WRITEY(st_) { u16* wa = sm + (st_) * STG + lrow * LS + lch * 8; u16* wb = wa + SA; \
    *(uint4*)wa = ya0; *(uint4*)(wa + 64 * LS) = ya1; *(uint4*)(wa + 128 * LS) = ya2; *(uint4*)(wa + 192 * LS) = ya3; \
    *(uint4*)wb = yb0; *(uint4*)(wb + 64 * LS) = yb1; }
#define COMPUTE(st_) { const u16* ab = sm + (st_) * STG + (wm * 64 + (lane & 31)) * LS + (lane >> 5) * 8; \
    const u16* bb = sm + (st_) * STG + SA + (wn * 64 + (lane & 31)) * LS + (lane >> 5) * 8; \
    _Pragma("unroll") for (int ks = 0; ks < 4; ks++) { \
      bf16x8 fa0 = *(const bf16x8*)(ab + ks * 16); bf16x8 fa1 = *(const bf16x8*)(ab + 32 * LS + ks * 16); \
      bf16x8 fb0 = *(const bf16x8*)(bb + ks * 16); bf16x8 fb1 = *(const bf16x8*)(bb + 32 * LS + ks * 16); \
      acc00 = __builtin_amdgcn_mfma_f32_32x32x16_bf16(fa0, fb0, acc00, 0, 0, 0); \
      acc01 = __builtin_amdgcn_mfma_f32_32x32x16_bf16(fa0, fb1, acc01, 0, 0, 0); \
      acc10 = __builtin_amdgcn_mfma_f32_32x32x16_bf16(fa1, fb0, acc10, 0, 0, 0); \
      acc11 = __builtin_amdgcn_mfma_f32_32x32x16_bf16(fa1, fb1, acc11, 0, 0, 0); } }
    LOADX(0);
    if (KT > 1) LOADY(1);
    f32x16 acc00, acc01, acc10, acc11;
    if (EPI == EPI_RES && !part_unit) {
      const int cc0 = n0 + wn * 64 + (lane & 31);
      float* xfq = p.out;
#pragma unroll
      for (int i = 0; i < 16; i++) {
        const int row = m0 + wm * 64 + 4 * (lane >> 5) + (i & 3) + 8 * (i >> 2);
        const float* ra = resid_in ? xrow(p, row) : (xfq + (size_t)row * 1024);
        const float* rb = resid_in ? xrow(p, row + 32) : (xfq + (size_t)(row + 32) * 1024);
        acc00[i] = ra[cc0]; acc01[i] = ra[cc0 + 32];
        acc10[i] = rb[cc0]; acc11[i] = rb[cc0 + 32];
      }
    } else {
#pragma unroll
      for (int i = 0; i < 16; i++) { acc00[i] = 0.f; acc01[i] = 0.f; acc10[i] = 0.f; acc11[i] = 0.f; }
    }
    __syncthreads();
    if (EPI == EPI_SCALE || EPI == EPI_FF1) {
      if (tid < 256) {
        const float4* pp = (const float4*)(part + (size_t)(m0 + tid) * 16);
        float4 a = pp[0], b = pp[1], c = pp[2], d = pp[3];
        float s = (a.x + a.y + a.z + a.w) + (b.x + b.y + b.z + b.w) + (c.x + c.y + c.z + c.w) + (d.x + d.y + d.z + d.w);
        sRs[tid] = rsqrtf(s * (1.0f / 1024.0f) + 1e-6f);
      }
    }
    WRITEX(0);
    if (KT > 2) LOADX(2);
    RAW_BARRIER();
    for (int kt = 0; kt < KT; kt += 2) {
      if (kt + 1 < KT) WRITEY(1);
      if (kt + 3 < KT) LOADY(kt + 3);
      COMPUTE(0);
      RAW_BARRIER();
      if (kt + 1 >= KT) break;
      if (kt + 2 < KT) WRITEX(0);
      if (kt + 4 < KT) LOADX(kt + 4);
      COMPUTE(1);
      RAW_BARRIER();
    }
#undef LOADX
#undef LOADY
#undef WRITEX
#undef WRITEY
#undef COMPUTE
    const int c0 = n0 + wn * 64 + (lane & 31);
    const int c1 = c0 + 32;
    if (EPI == EPI_RES && part_unit) {
      float* xfp = p.out;
#pragma unroll
      for (int i = 0; i < 16; i++) {
        const int rl = wm * 64 + 4 * (lane >> 5) + (i & 3) + 8 * (i >> 2);
        float* r0p = xfp + (size_t)(m0 + rl) * 1024;
        float* r1p = r0p + (size_t)32 * 1024;
        atomicAdd(r0p + c0, acc00[i]); atomicAdd(r0p + c1, acc01[i]);
        atomicAdd(r1p + c0, acc10[i]); atomicAdd(r1p + c1, acc11[i]);
      }
    } else {
      gemm_epi<EPI>(p, acc00, acc01, 0, wm, wn, lane, m0, nt, c0, c1, sRs, outb, ldo, resid_in);
      gemm_epi<EPI>(p, acc10, acc11, 1, wm, wn, lane, m0, nt, c0, c1, sRs, outb, ldo, resid_in);
    }
  }
}

__device__ __forceinline__ void pool_item(const Params& p, int it) {
  const u16* P = (const u16*)(p.ws + O_P);
  u16* Y = (u16*)(p.ws + O_Y);
  float* hist = (float*)smem;
  float* dS = hist + 47 * 256;
  const int tid = threadIdx.x;
  const int col = tid & 255, hf = tid >> 8;
  const int gi = col >> 6, dd = col & 63;
  const int w = 2 << gi;
  const float* pw = p.in[9] + gi * 4096 + dd;
  const float sc = p.in[10][col];
  {
    int r0, t0, nrows, pos0;
    const float* st = nullptr;
    const float* shs = nullptr;
    if (it < 512) { r0 = it * 32; t0 = r0 & 2047; nrows = 32; pos0 = t0; }
    else { const int b = it - 512; r0 = NP + b * 4; t0 = 0; nrows = 4; pos0 = 16384; st = p.in[2] + (size_t)b * 3840; shs = p.in[3] + (size_t)b * 2560; }
    __syncthreads();
    const int nh = 15 + nrows;
#pragma unroll 8
    for (int hr = hf; hr < nh; hr += 2) {
      const int t = t0 - 15 + hr;
      float v = 0.f;
      if (t >= 0) v = bf2f(P[(size_t)(r0 - t0 + t) * 2816 + col]);
      else if (st) v = st[(15 + t) * 256 + col];
      hist[hr * 256 + col] = v;
    }
    __syncthreads();
    const int q0 = hf * 16;
    for (int q = 0; q < 16; q++) {
      const int tk = q0 + q;
      if (tk < nrows) {
        float s = 0.f;
        for (int i = 0; i < w; i++) s += hist[(15 + tk - i) * 256 + col];
        const float cnt = (float)min(w, pos0 + tk + 1);
        dS[tk * 256 + col] = s / cnt - hist[(15 + tk) * 256 + col];
      }
    }
    __syncthreads();
    float acc[16];
#pragma unroll
    for (int q = 0; q < 16; q++) acc[q] = 0.f;
    if (q0 < nrows) {
#pragma unroll 4
      for (int c = 0; c < 64; c += 4) {
        float w0 = pw[(c + 0) * 64], w1 = pw[(c + 1) * 64], w2 = pw[(c + 2) * 64], w3 = pw[(c + 3) * 64];
#pragma unroll
        for (int q = 0; q < 16; q++) {
          float4 d = *(const float4*)(dS + (q0 + q) * 256 + gi * 64 + c);
          acc[q] += d.x * w0 + d.y * w1 + d.z * w2 + d.w * w3;
        }
      }
    }
#pragma unroll
    for (int q = 0; q < 16; q++) {
      if (q0 + q < nrows) Y[(size_t)(r0 + q0 + q) * 1024 + col] = f2bf(acc[q] * sc);
    }
  }
}

__device__ __forceinline__ void pool_phase(const Params& p) {
  const u16* P = (const u16*)(p.ws + O_P);
  u16* LIN = (u16*)(p.ws + O_LIN);
  const int tid = threadIdx.x;
  const int col = tid & 255, hf = tid >> 8;
  const float mu = p.in[11][2304 + col];
  for (int it = blockIdx.x; it < 512 + 128; it += gridDim.x) {
    int r0, t0, nrows;
    const float* shs = nullptr;
    if (it < 512) { r0 = it * 32; t0 = r0 & 2047; nrows = 32; }
    else { const int b = it - 512; r0 = NP + b * 4; t0 = 0; nrows = 4; shs = p.in[3] + (size_t)b * 2560; }
    const int q0 = hf * 16;
    if (q0 < nrows) {
      const int nq = min(16, nrows - q0);
      float pv[17];
      {
        const int rowp = r0 + q0 - 1;
        float v0;
        if (t0 + q0 == 0) v0 = shs ? shs[2304 + col] : 0.f;
        else v0 = bf2f(P[(size_t)rowp * 2816 + 2560 + col]);
        pv[0] = v0;
      }
#pragma unroll
      for (int q = 0; q < 16; q++) pv[q + 1] = (q < nq) ? bf2f(P[(size_t)(r0 + q0 + q) * 2816 + 2560 + col]) : 0.f;
#pragma unroll
      for (int q = 0; q < 16; q++) {
        if (q < nq) {
          float xs = pv[q + 1] + (pv[q] - pv[q + 1]) * mu;
          float v = (col < 64) ? tanhf_(xs) : ((col < 128) ? xs : sigmoidf_(xs));
          LIN[(size_t)(r0 + q0 + q) * 256 + col] = f2bf(v);
        }
      }
    }
  }
  const int gt = blockIdx.x * 512 + tid, gs = gridDim.x * 512;
  for (int e = gt; e < 8 * 15 * 256; e += gs) {
    int b = e / 3840, r = (e / 256) % 15, c = e & 255;
    p.out[OUT_PPOOL + e] = bf2f(P[(size_t)(b * 2048 + 2033 + r) * 2816 + c]);
  }
  for (int e = gt; e < 128 * 15 * 256; e += gs) {
    int b = e / 3840, r = (e / 256) % 15, c = e & 255;
    float v;
    if (r < 11) v = p.in[2][(size_t)b * 3840 + (r + 4) * 256 + c];
    else v = bf2f(P[(size_t)(NP + b * 4 + (r - 11)) * 2816 + c]);
    p.out[OUT_SPOOL + e] = v;
  }
  for (int e = gt; e < 8 * 2560; e += gs) {
    int b = e / 2560, c = e % 2560;
    p.out[OUT_PSHIFT + e] = bf2f(P[(size_t)(b * 2048 + 2047) * 2816 + 256 + c]);
  }
  for (int e = gt; e < 128 * 2560; e += gs) {
    int b = e / 2560, c = e % 2560;
    p.out[OUT_SSHIFT + e] = bf2f(P[(size_t)(NP + b * 4 + 3) * 2816 + 256 + c]);
  }
}

__device__ __forceinline__ void rwkv_prep_phase(const Params& p) {
  const u16* P = (const u16*)(p.ws + O_P);
  u16* APRE = (u16*)(p.ws + O_APRE);
  u16* WPRE = (u16*)(p.ws + O_WPRE);
  float* SC = (float*)(p.ws + O_BS);
  const int lane = threadIdx.x & 63, wave = __builtin_amdgcn_readfirstlane(threadIdx.x >> 6);
  for (int row = blockIdx.x * 8 + wave; row < MT; row += gridDim.x * 8) {
    const u16* Pr = P + (size_t)row * 2816 + 256;
#pragma unroll 12
    for (int h = 0; h < 12; h++) {
      const int ch = h * 64 + lane;
      float pr = bf2f(Pr[ch]), pk = bf2f(Pr[768 + ch]);
      float qr = prevP(p, P, row, ch), qk = prevP(p, P, row, 768 + ch);
      float wl = p.in[12][ch] + bf2f(WPRE[(size_t)row * 768 + ch]);
      float r = pr + (qr - pr) * p.in[11][ch], k = pk + (qk - pk) * p.in[11][768 + ch];
      float a = sigmoidf_(p.in[14][ch] + bf2f(APRE[(size_t)row * 768 + ch]));
      a = bf2f(f2bf(a));
      float omd = 1.0f - __expf(-0.6065306597126334f * sigmoidf_(wl));
      float kkr = k * p.in[17][ch];
      float n2 = wsum64(kkr * kkr);
      float inv = frcp_(fmaxf(__builtin_amdgcn_sqrtf(n2), 1e-12f));
      float kap = kkr * inv;
      float kp = k * (1.0f + (a - 1.0f) * p.in[18][ch]);
      float al = kap * a;
      float ar = wsum64(al * r);
      float kr = wsum64(kp * r);
      float bsum = wsum64(r * kp * p.in[19][ch]);
      APRE[(size_t)row * 768 + ch] = f2bf(a);
      WPRE[(size_t)row * 768 + ch] = f2bf(omd);
      if (lane == 0) *(float4*)(SC + ((size_t)row * 12 + h) * 4) = make_float4(ar, kr, bsum, inv);
    }
  }
}

constexpr int TC = 16;
typedef float v2f __attribute__((ext_vector_type(2)));
typedef float v4f __attribute__((ext_vector_type(4)));

struct StRaw {
  unsigned cr[2], ck[2], cv[2];
  unsigned qr[2], qk[2], qv[2];
  unsigned wp[2], ap[2];
  float inv[2], sc2[2];
  v2f s_r, s_k, s_v;
  float m;
};
struct StConst { v2f mur, muk, muv, kk_, ka_; };

__device__ __forceinline__ v2f bfpair(unsigned u) {
  v2f r;
  r.x = __uint_as_float(u << 16);
  r.y = __uint_as_float(u & 0xffff0000u);
  return r;
}

template <bool SAMPLE>
__device__ __forceinline__ void st_load(const Params& p, StRaw& R, int row0, int b, int h, int c, int sw, int lane) {
  const u16* P = (const u16*)(p.ws + O_P);
  const u16* WPRE = (const u16*)(p.ws + O_WPRE);
  const u16* APRE = (const u16*)(p.ws + O_APRE);
  const float* SC = (const float*)(p.ws + O_BS);
  const int l2 = lane & 31, tp = lane >> 5;
  const int ch = h * 64 + 2 * l2;
  const int t0 = c * TC + sw * 4;
  R.m = (t0 + tp == 0) ? 0.f : 1.f;
  if (SAMPLE) {
    const float* sp = p.in[3] + (size_t)b * 2560 + ch;
    R.s_r = *(const v2f*)sp; R.s_k = *(const v2f*)(sp + 768); R.s_v = *(const v2f*)(sp + 1536);
  }
#pragma unroll
  for (int ps = 0; ps < 2; ps++) {
    const int t = t0 + 2 * ps + tp;
    const int tq = t > 0 ? t - 1 : 0;
    const u16* Pc = P + (size_t)(row0 + t) * 2816 + 256 + ch;
    const u16* Pq = P + (size_t)(row0 + tq) * 2816 + 256 + ch;
    R.cr[ps] = *(const unsigned*)Pc; R.ck[ps] = *(const unsigned*)(Pc + 768); R.cv[ps] = *(const unsigned*)(Pc + 1536);
    R.qr[ps] = *(const unsigned*)Pq; R.qk[ps] = *(const unsigned*)(Pq + 768); R.qv[ps] = *(const unsigned*)(Pq + 1536);
    const size_t row = row0 + t;
    R.wp[ps] = *(const unsigned*)(WPRE + row * 768 + ch);
    R.ap[ps] = *(const unsigned*)(APRE + row * 768 + ch);
    R.inv[ps] = SC[(row * 12 + h) * 4 + 3];
    R.sc2[ps] = SC[(row * 12 + h) * 4 + (lane & 1)];
  }
}

template <bool SAMPLE>
__device__ __forceinline__ void st_compute(const StConst& K, const StRaw& R, int sw, int lane, float* ops, float* scal) {
  const int l2 = lane & 31, tp = lane >> 5;
#pragma unroll
  for (int ps = 0; ps < 2; ps++) {
    const int tt = sw * 4 + 2 * ps + tp;
    v2f pr = bfpair(R.cr[ps]), pk = bfpair(R.ck[ps]), pv = bfpair(R.cv[ps]);
    v2f qr = bfpair(R.qr[ps]), qk = bfpair(R.qk[ps]), qv = bfpair(R.qv[ps]);
    if (ps == 0) {
      if (SAMPLE) { if (R.m == 0.f) { qr = R.s_r; qk = R.s_k; qv = R.s_v; } }
      else { const v2f mm = {R.m, R.m}; qr *= mm; qk *= mm; qv *= mm; }
    }
    const v2f r = pr + (qr - pr) * K.mur;
    const v2f k = pk + (qk - pk) * K.muk;
    const v2f v = pv + (qv - pv) * K.muv;
    const v2f one = {1.0f, 1.0f};
    const v2f dec = one - bfpair(R.wp[ps]);
    const v2f a = bfpair(R.ap[ps]);
    const v2f iv = {R.inv[ps], R.inv[ps]};
    const v2f kap = k * K.kk_ * iv;
    const v2f kp = k * (one + (a - one) * K.ka_);
    float* o6 = ops + tt * 384 + 2 * l2;
    *(v2f*)(o6) = dec; *(v2f*)(o6 + 64) = kap * a; *(v2f*)(o6 + 128) = kp; *(v2f*)(o6 + 192) = kap; *(v2f*)(o6 + 256) = dec * r; *(v2f*)(o6 + 320) = v;
    if (l2 < 2) scal[tt * 2 + l2] = R.sc2[ps];
  }
}

struct ScD { v4f a0, a1, q0, q1; };
struct ScU { v4f w0, w1, l0, l1, k0, k1; float v; v2f sc; };
__device__ __forceinline__ void scd_load(ScD& O, const float* o6, int j8) {
  O.a0 = *(const v4f*)(o6 + 192 + j8); O.a1 = *(const v4f*)(o6 + 192 + j8 + 4);
  O.q0 = *(const v4f*)(o6 + 256 + j8); O.q1 = *(const v4f*)(o6 + 256 + j8 + 4);
}
__device__ __forceinline__ void scu_load(ScU& O, const float* o6, const float* sb, int tt, int j8, int srow) {
  O.w0 = *(const v4f*)(o6 + j8); O.w1 = *(const v4f*)(o6 + j8 + 4);
  O.l0 = *(const v4f*)(o6 + 64 + j8); O.l1 = *(const v4f*)(o6 + 64 + j8 + 4);
  O.k0 = *(const v4f*)(o6 + 128 + j8); O.k1 = *(const v4f*)(o6 + 128 + j8 + 4);
  O.v = o6[320 + srow];
  O.sc = *(const v2f*)(sb + tt * 2);
}
__device__ __forceinline__ void sc_step(const ScD& D, const ScU& U, v2f& s0, v2f& s1, v2f& s2, v2f& s3, float* obuf, int tt, int lane) {
  v2f pd2 = s0 * D.a0.lo;
  v2f qd2 = s0 * D.q0.lo;
  pd2 = s1 * D.a0.hi + pd2; qd2 = s1 * D.q0.hi + qd2;
  pd2 = s2 * D.a1.lo + pd2; qd2 = s2 * D.q1.lo + qd2;
  pd2 = s3 * D.a1.hi + pd2; qd2 = s3 * D.q1.hi + qd2;
  float pd = reduce8(pd2.x + pd2.y);
  float qd = reduce8(qd2.x + qd2.y);
  const float v = U.v;
  const float o = qd - pd * U.sc.x + v * U.sc.y;
  const v2f vv = {v, v};
  const v2f np = {-pd, -pd};
  s0 = s0 * U.w0.lo + (np * U.l0.lo + vv * U.k0.lo);
  s1 = s1 * U.w0.hi + (np * U.l0.hi + vv * U.k0.hi);
  s2 = s2 * U.w1.lo + (np * U.l1.lo + vv * U.k1.lo);
  s3 = s3 * U.w1.hi + (np * U.l1.hi + vv * U.k1.hi);
  obuf[tt * 8 + (lane >> 3)] = o;
}

template <int STEPS>
__device__ __forceinline__ void scan_steps(v2f& s0, v2f& s1, v2f& s2, v2f& s3, const float* ob, const float* sb, int j8, int srow,
                                           float* obuf, int lane) {
  ScD A, B, C;
  ScU P, Q;
  scd_load(A, ob, j8);
  scu_load(P, ob, sb, 0, j8, srow);
  scd_load(B, ob + 384, j8);
#define SC_STEP(DX_, DZ_, UX_, UZ_, tt_) { \
    if ((tt_) + 1 < STEPS) scu_load(UZ_, ob + ((tt_) + 1) * 384, sb, (tt_) + 1, j8, srow); \
    if ((tt_) + 2 < STEPS) scd_load(DZ_, ob + ((tt_) + 2) * 384, j8); \
    asm volatile("" ::: "memory"); sc_step(DX_, UX_, s0, s1, s2, s3, obuf, (tt_), lane); asm volatile("" ::: "memory"); }
  SC_STEP(A, C, P, Q, 0) SC_STEP(B, A, Q, P, 1) SC_STEP(C, B, P, Q, 2) SC_STEP(A, C, Q, P, 3)
  if (STEPS > 4) {
    SC_STEP(B, A, P, Q, 4) SC_STEP(C, B, Q, P, 5) SC_STEP(A, C, P, Q, 6) SC_STEP(B, A, Q, P, 7)
    SC_STEP(C, B, P, Q, 8) SC_STEP(A, C, Q, P, 9) SC_STEP(B, A, P, Q, 10) SC_STEP(C, B, Q, P, 11)
    SC_STEP(A, C, P, Q, 12) SC_STEP(B, A, Q, P, 13) SC_STEP(C, B, P, Q, 14) SC_STEP(A, C, Q, P, 15)
  }
#undef SC_STEP
}

__device__ __forceinline__ void scan_phase(const Params& p, int cidx, int task_lo, int task_hi) {
  float* ops = (float*)smem;
  float* scal = ops + 2 * TC * 384;
  float* obufs = scal + 2 * TC * 2;
  u16* Y = (u16*)(p.ws + O_Y);
  int* counter = (int*)(p.ws + O_CNT) + cidx;
  const int tid = threadIdx.x, lane = tid & 63, wave = __builtin_amdgcn_readfirstlane(tid >> 6);
  {
    if (tid < 4) s_simdcnt[tid] = 0;
    __syncthreads();
    if (lane == 0) {
      const int simd = (int)__builtin_amdgcn_s_getreg(2308) & 3;
      const int r = atomicAdd(&s_simdcnt[simd], 1);
      s_role[wave] = simd | (r << 4);
    }
    __syncthreads();
    if (tid == 0) {
      int ns = 0;
      for (int w = 0; w < 8; w++) ns += ((s_role[w] >> 4) == 0);
      int st = 0;
      for (int w = 0; w < 8; w++) {
        int v;
        if (ns == 4) v = ((s_role[w] >> 4) == 0) ? (s_role[w] & 3) : (4 + st++);
        else v = w;
        s_role2[w] = v;
      }
    }
    __syncthreads();
  }
  const int rolew = __builtin_amdgcn_readfirstlane(s_role2[wave]);
  const bool stat = (gridDim.x == 256 && task_lo == 0);
  bool first = true;
  while (true) {
    __syncthreads();
    if (tid == 0) s_task = (stat && first && blockIdx.x < 192) ? -1 : atomicAdd(counter, 1);
    __syncthreads();
    const int tq = __builtin_amdgcn_readfirstlane(s_task);
    first = false;
    const int task = (tq < 0) ? ((int)(blockIdx.x & 7) * 24 + (int)(blockIdx.x >> 3)) : (tq + (stat ? 192 : task_lo));
    if (task >= task_hi) break;
    int b, h, half, row0, T;
    bool sample;
    if (task < 192) { b = task / 24; h = (task % 24) >> 1; half = task & 1; row0 = b * 2048; T = 2048; sample = false; }
    else { int u = task - 192; b = u / 24; h = (u % 24) >> 1; half = u & 1; row0 = NP + b * 4; T = 4; sample = true; }
    const int nch = (T + TC - 1) / TC;
    const int sbase = half * 32 + (rolew & 3) * 8;
    const int srow = sbase + (lane >> 3);
    const int j8 = (lane & 7) * 8;
    float* obuf = obufs + (rolew & 3) * 128;
    if (rolew < 4) {
      v2f s0 = {0.f, 0.f}, s1 = s0, s2 = s0, s3 = s0;
      if (sample) {
        const float* sp = p.in[4] + ((size_t)(b * 12 + h) * 64 + srow) * 64 + j8;
        v4f x0 = *(const v4f*)sp, x1 = *(const v4f*)(sp + 4);
        s0 = x0.lo; s1 = x0.hi; s2 = x1.lo; s3 = x1.hi;
      }
      RAW_BARRIER();
      for (int c = 0; c < nch; c++) {
        const int buf = c & 1;
        const float* ob = ops + buf * TC * 384;
        const float* sb = scal + buf * TC * 2;
        if (sample) scan_steps<4>(s0, s1, s2, s3, ob, sb, j8, srow, obuf, lane);
        else scan_steps<TC>(s0, s1, s2, s3, ob, sb, j8, srow, obuf, lane);
        const int tt = lane >> 2, pr = lane & 3;
        if (tt < T) {
          v2f ov = *(const v2f*)(obuf + tt * 8 + 2 * pr);
          unsigned pk = (unsigned)f2bf(ov.x) | ((unsigned)f2bf(ov.y) << 16);
          *(unsigned*)(Y + (size_t)(row0 + c * TC + tt) * 1024 + 256 + h * 64 + sbase + 2 * pr) = pk;
        }
        RAW_BARRIER();
      }
      float* dp = p.out + (sample ? OUT_SWKV : OUT_PWKV) + ((size_t)(b * 12 + h) * 64 + srow) * 64 + j8;
      *(float4*)dp = make_float4(s0.x, s0.y, s1.x, s1.y);
      *(float4*)(dp + 4) = make_float4(s2.x, s2.y, s3.x, s3.y);
    } else {
      const int sw = rolew - 4;
      const int ch = h * 64 + 2 * (lane & 31);
      StConst K;
      K.mur = *(const v2f*)(p.in[11] + ch); K.muk = *(const v2f*)(p.in[11] + 768 + ch); K.muv = *(const v2f*)(p.in[11] + 1536 + ch);
      K.kk_ = *(const v2f*)(p.in[17] + ch); K.ka_ = *(const v2f*)(p.in[18] + ch);
      if (sample) {
        if (sw == 0) {
          StRaw RS;
          st_load<true>(p, RS, row0, b, h, 0, 0, lane);
          st_compute<true>(K, RS, 0, lane, ops, scal);
        }
        RAW_BARRIER();
        RAW_BARRIER();
      } else {
        StRaw RA, RB;
        st_load<false>(p, RA, row0, b, h, 0, sw, lane);
        st_compute<false>(K, RA, sw, lane, ops, scal);
        st_load<false>(p, RA, row0, b, h, 1, sw, lane);
        st_load<false>(p, RB, row0, b, h, 2, sw, lane);
        RAW_BARRIER();
        for (int c = 0; c < nch; c += 2) {
          st_compute<false>(K, RA, sw, lane, ops + TC * 384, scal + TC * 2);
          st_load<false>(p, RA, row0, b, h, (c + 3 < nch) ? c + 3 : c + 1, sw, lane);
          RAW_BARRIER();
          st_compute<false>(K, RB, sw, lane, ops, scal);
          st_load<false>(p, RB, row0, b, h, (c + 4 < nch) ? c + 4 : c + 2 < nch ? c + 2 : c, sw, lane);
          RAW_BARRIER();
        }
      }
    }
  }
}

__device__ __forceinline__ void pool_queue(const Params& p) {
  int* counter = (int*)(p.ws + O_CNT) + 2;
  while (true) {
    __syncthreads();
    if (threadIdx.x == 0) s_task = atomicAdd(counter, 1);
    __syncthreads();
    const int it = __builtin_amdgcn_readfirstlane(s_task);
    if (it >= 640) break;
    pool_item(p, it);
  }
}

__device__ __forceinline__ void mix1_phase(const Params& p) {
  const u16* Q = (const u16*)(p.ws + O_P);
  u16* Y = (u16*)(p.ws + O_Y);
  const u16* WM = (const u16*)(p.ws + O_WM);
  const int tid = threadIdx.x, lane = tid & 63, wave = tid >> 6;
  constexpr int N_GP = 512, N_GS = 128, N_LRU = MT / 16;
  for (int it = blockIdx.x; it < N_GP + N_GS + N_LRU; it += gridDim.x) {
    __syncthreads();
    if (it < N_GP) {
      const int h = it & 3, ck = (it >> 2) & 15, b = it >> 6;
      const int r0 = b * 2048 + ck * 128;
      u16* vT = (u16*)smem;
      {
        const u16* qb = Q + (size_t)(r0 + wave * 16) * 2048 + 512 + lane * 8;
        float lg[8], lb[8];
        if ((lane >> 4) == h) {
#pragma unroll
          for (int e = 0; e < 8; e++) { lg[e] = p.in[25][h * 128 + (lane & 15) * 8 + e]; lb[e] = p.in[26][h * 128 + (lane & 15) * 8 + e]; }
        } else {
#pragma unroll
          for (int e = 0; e < 8; e++) { lg[e] = 0.f; lb[e] = 0.f; }
        }
        uint4 cur0 = *(const uint4*)(qb), cur1 = *(const uint4*)(qb + 2048), cur2 = *(const uint4*)(qb + 2 * 2048), cur3 = *(const uint4*)(qb + 3 * 2048);
        for (int bt = 0; bt < 4; bt++) {
          uint4 nx0 = cur0, nx1 = cur1, nx2 = cur2, nx3 = cur3;
          if (bt < 3) {
            const u16* qn = qb + (size_t)(bt + 1) * 4 * 2048;
            nx0 = *(const uint4*)(qn); nx1 = *(const uint4*)(qn + 2048); nx2 = *(const uint4*)(qn + 2 * 2048); nx3 = *(const uint4*)(qn + 3 * 2048);
          }
#pragma unroll
          for (int u = 0; u < 4; u++) {
            const uint4 raw = (u == 0) ? cur0 : (u == 1) ? cur1 : (u == 2) ? cur2 : cur3;
            const int j = wave * 16 + bt * 4 + u;
            const u16* rp = (const u16*)&raw;
            float z[8];
            float sm = 0.f;
#pragma unroll
            for (int e = 0; e < 8; e++) { z[e] = geluf_(bf2f(rp[e])); sm += z[e]; }
            const float mean = wsum64(sm) * (1.0f / 512.0f);
            float s2 = 0.f;
#pragma unroll
            for (int e = 0; e < 8; e++) { z[e] -= mean; s2 += z[e] * z[e]; }
            const float rstd = rsqrtf(wsum64(s2) * (1.0f / 512.0f) + 1e-5f);
            if ((lane >> 4) == h) {
#pragma unroll
              for (int e = 0; e < 8; e++) {
                const int d = (lane & 15) * 8 + e;
                vT[d * 136 + j] = f2bf(z[e] * rstd * lg[e] + lb[e]);
              }
            }
          }
          cur0 = nx0; cur1 = nx1; cur2 = nx2; cur3 = nx3;
        }
      }
      __syncthreads();
      const int wm = wave >> 1, wn = wave & 1;
      f32x16 acc0, acc1;
#pragma unroll
      for (int i = 0; i < 16; i++) { acc0[i] = 0.f; acc1[i] = 0.f; }
      const u16* ag = WM + (size_t)h * 16384 + (size_t)(wm * 32 + (lane & 31)) * 128 + (lane >> 5) * 8;
      const u16* bb = vT + (wn * 64 + (lane & 31)) * 136 + (lane >> 5) * 8;
      const int nks = 2 * (wm + 1);
      for (int ks = 0; ks < nks; ks++) {
        bf16x8 a = *(const bf16x8*)(ag + ks * 16);
        bf16x8 b0 = *(const bf16x8*)(bb + ks * 16);
        bf16x8 b1 = *(const bf16x8*)(bb + 32 * 136 + ks * 16);
        acc0 = __builtin_amdgcn_mfma_f32_32x32x16_bf16(a, b0, acc0, 0, 0, 0);
        acc1 = __builtin_amdgcn_mfma_f32_32x32x16_bf16(a, b1, acc1, 0, 0, 0);
      }
      const int d0 = h * 128 + wn * 64 + (lane & 31), d1 = d0 + 32;
#pragma unroll 16
      for (int i = 0; i < 16; i++) {
        const int il = wm * 32 + (i & 3) + 8 * (i >> 2) + 4 * (lane >> 5);
        const int row = r0 + il;
        const float bsv = p.in[28][h * 128 + il];
        float u0 = geluf_(bf2f(Q[(size_t)row * 2048 + d0]));
        float u1 = geluf_(bf2f(Q[(size_t)row * 2048 + d1]));
        Y[(size_t)row * 1024 + d0] = f2bf(u0 * (acc0[i] + bsv));
        Y[(size_t)row * 1024 + d1] = f2bf(u1 * (acc1[i] + bsv));
      }
    } else if (it < N_GP + N_GS) {
      const int b = it - N_GP;
      const int r0 = NP + b * 4;
      float* vs = (float*)smem;
      if (wave < 4) {
        const int row = r0 + wave;
        uint4 raw = *(const uint4*)(Q + (size_t)row * 2048 + 512 + lane * 8);
        const u16* rp = (const u16*)&raw;
        float z[8];
        float s = 0.f;
#pragma unroll
        for (int e = 0; e < 8; e++) { z[e] = geluf_(bf2f(rp[e])); s += z[e]; }
        const float mean = wsum64(s) * (1.0f / 512.0f);
        float s2 = 0.f;
#pragma unroll
        for (int e = 0; e < 8; e++) { z[e] -= mean; s2 += z[e] * z[e]; }
        const float rstd = rsqrtf(wsum64(s2) * (1.0f / 512.0f) + 1e-5f);
#pragma unroll
        for (int e = 0; e < 8; e++) {
          const int d = lane * 8 + e;
          float vn = z[e] * rstd * p.in[25][d] + p.in[26][d];
          vs[wave * 512 + d] = vn;
          p.out[OUT_SGV + (size_t)(b * 4 + wave) * 512 + d] = vn;
        }
      }
      __syncthreads();
      {
        const int ch = tid, hh = ch >> 7;
        for (int i = 0; i < 4; i++) {
          float mix = p.in[28][hh * 128 + i];
          for (int j = 0; j <= i; j++) mix += p.in[27][(size_t)(hh * 128 + i) * 128 + j] * vs[j * 512 + ch];
          float u = geluf_(bf2f(Q[(size_t)(r0 + i) * 2048 + ch]));
          Y[(size_t)(r0 + i) * 1024 + ch] = f2bf(u * mix);
        }
      }
    } else {
      const int li = it - N_GP - N_GS;
      const int r0 = li * 16;
      u16* xcb = (u16*)smem;
      float* gxs = (float*)(smem + 16 * 520 * 2);
      float* gas = gxs + 16 * 512;
      const int ch = tid;
      float* CA = (float*)(p.ws + O_CA);
      float* HL = (float*)(p.ws + O_HL);
      float* SEG = (float*)(p.ws + O_SEG);
      const float cw0 = p.in[29][ch], cw1 = p.in[29][512 + ch], cw2 = p.in[29][1024 + ch], cw3 = p.in[29][1536 + ch];
      const float cb = p.in[30][ch];
      {
        float xr[19];
#pragma unroll
        for (int q = 0; q < 19; q++) {
          const int row = r0 - 3 + q;
          float v = 0.f;
          bool valid;
          int tq;
          if (r0 < NP) { tq = (r0 & 2047) - 3 + q; valid = tq >= 0; }
          else { valid = true; tq = 0; }
          if (r0 < NP) { if (valid) v = bf2f(Q[(size_t)row * 2048 + 1536 + ch]); }
          else v = bf2f(Q[(size_t)(row < NP ? NP : row) * 2048 + 1536 + ch]);
          xr[q] = v;
        }
#pragma unroll
        for (int q = 0; q < 16; q++) {
          float x0 = xr[q], x1 = xr[q + 1], x2 = xr[q + 2], x3 = xr[q + 3];
          if (r0 >= NP) {
            const int rs = r0 - NP + q;
            const int t = rs & 3;
            const float* st = p.in[5] + (size_t)(rs >> 2) * 1536 + ch;
            if (t < 3) x0 = st[t * 512];
            if (t < 2) x1 = st[(t + 1) * 512];
            if (t < 1) x2 = st[(t + 2) * 512];
          }
          const float xc = cb + cw0 * x0 + cw1 * x1 + cw2 * x2 + cw3 * x3;
          xcb[q * 520 + ch] = f2bf(xc);
        }
      }
      __syncthreads();
      {
        const u16* WXT = (const u16*)(p.ws + O_WXT);
        const int n = wave;
        typedef __attribute__((ext_vector_type(4))) float f32x4;
        f32x4 ac[8];
#pragma unroll
        for (int i = 0; i < 8; i++) { ac[i][0] = 0.f; ac[i][1] = 0.f; ac[i][2] = 0.f; ac[i][3] = 0.f; }
#pragma unroll
        for (int kh = 0; kh < 2; kh++) {
          const bf16x8 af = *(const bf16x8*)(xcb + (lane & 15) * 520 + n * 64 + kh * 32 + (lane >> 4) * 8);
          bf16x8 bfr[8];
#pragma unroll
          for (int i = 0; i < 8; i++) {
            const int w = i >> 2, dt = i & 3;
            bfr[i] = *(const bf16x8*)(WXT + ((size_t)((w * 8 + n) * 64 + dt * 16 + (lane & 15))) * 64 + kh * 32 + (lane >> 4) * 8);
          }
#pragma unroll
          for (int i = 0; i < 8; i++) ac[i] = __builtin_amdgcn_mfma_f32_16x16x32_bf16(af, bfr[i], ac[i], 0, 0, 0);
        }
#pragma unroll
        for (int i = 0; i < 8; i++) {
          const int w = i >> 2, dt = i & 3;
          float* dst = (w ? gas : gxs) + n * 64 + dt * 16 + (lane & 15);
#pragma unroll
          for (int r = 0; r < 4; r++) dst[((lane >> 4) * 4 + r) * 512] = ac[i][r];
        }
      }
      __syncthreads();
      const float bx = p.in[32][ch], ba = p.in[34][ch];
      const float lam = p.in[35][ch];
      const float spl = fmaxf(-lam, 0.f) + log1pf(__expf(-fabsf(lam)));
      float hl = 0.f, ca = 1.f;
#pragma unroll 4
      for (int q = 0; q < 16; q++) {
        const int row = r0 + q;
        if (row >= NP) {
          int rs = row - NP;
          if ((rs & 3) == 0) { hl = p.in[6][(size_t)(rs >> 2) * 512 + ch]; ca = 1.f; }
        }
        float gx = sigmoidf_(gxs[q * 512 + ch] + bx), ga = sigmoidf_(gas[q * 512 + ch] + ba);
        float la = -8.0f * ga * spl;
        float a = __expf(la);
        float bb = __builtin_amdgcn_sqrtf(fmaxf(1.0f - a * a, 0.f)) * gx * bf2f(xcb[q * 520 + ch]);
        hl = a * hl + bb;
        ca = ca * a;
        CA[(size_t)row * 512 + ch] = ca;
        HL[(size_t)row * 512 + ch] = hl;
      }
      SEG[(size_t)li * 1024 + ch] = ca;
      SEG[(size_t)li * 1024 + 512 + ch] = hl;
    }
  }
}

__device__ __forceinline__ void lru_fix_phase(const Params& p, const XcdBarrier& xb) {
  const u16* Q = (const u16*)(p.ws + O_P);
  u16* Y = (u16*)(p.ws + O_Y);
  const float* CA = (const float*)(p.ws + O_CA);
  const float* HL = (const float*)(p.ws + O_HL);
  const float* SEG = (const float*)(p.ws + O_SEG);
  const int ch = threadIdx.x;
  const bool blocked = (gridDim.x == 256);
  for (int k = 0; k < (blocked ? 1 : 0); k++) {
    const int li0 = blockIdx.x * 4;
    const int b = li0 >> 7, s0 = li0 & 127;
    const float* sg = SEG + (size_t)(b * 128) * 1024 + ch;
    float carry = 0.f;
#pragma unroll 8
    for (int q = 0; q < s0; q++) carry = sg[(size_t)q * 1024] * carry + sg[(size_t)q * 1024 + 512];
    for (int u = 0; u < 4; u++) {
      const int li = li0 + u;
      const int r0 = li * 16;
#pragma unroll 8
      for (int q = 0; q < 16; q++) {
        const int row = r0 + q;
        float hv = HL[(size_t)row * 512 + ch] + CA[(size_t)row * 512 + ch] * carry;
        float gate = geluf_(bf2f(Q[(size_t)row * 2048 + 1024 + ch]));
        Y[(size_t)row * 1024 + 512 + ch] = f2bf(hv * gate);
        if ((row & 2047) == 2047) p.out[OUT_PLRU + (size_t)(row >> 11) * 512 + ch] = hv;
      }
      carry = sg[(size_t)(s0 + u) * 1024] * carry + sg[(size_t)(s0 + u) * 1024 + 512];
    }
  }
  for (int li = (blocked ? 1024 : 0) + blockIdx.x; li < MT / 16; li += gridDim.x) {
    const int r0 = li * 16;
    float carry = 0.f;
    if (r0 < NP) {
      const int b = r0 >> 11, sN = (r0 & 2047) >> 4;
      const float* sg = SEG + (size_t)(b * 128) * 1024 + ch;
      for (int q = 0; q < sN; q++) carry = sg[(size_t)q * 1024] * carry + sg[(size_t)q * 1024 + 512];
    }
#pragma unroll 8
    for (int q = 0; q < 16; q++) {
      const int row = r0 + q;
      float hv = HL[(size_t)row * 512 + ch] + CA[(size_t)row * 512 + ch] * carry;
      float gate = geluf_(bf2f(Q[(size_t)row * 2048 + 1024 + ch]));
      Y[(size_t)row * 1024 + 512 + ch] = f2bf(hv * gate);
      if (row < NP) {
        if ((row & 2047) == 2047) p.out[OUT_PLRU + (size_t)(row >> 11) * 512 + ch] = hv;
      } else {
        int rs = row - NP;
        if ((rs & 3) == 3) p.out[OUT_SLRU + (size_t)(rs >> 2) * 512 + ch] = hv;
      }
    }
  }
  const int gt = blockIdx.x * 512 + threadIdx.x, gs = gridDim.x * 512;
  for (int e = gt; e < 8 * 3 * 512; e += gs) {
    int b = e / 1536, i = (e / 512) % 3, c = e & 511;
    p.out[OUT_PCONV + e] = bf2f(Q[(size_t)(b * 2048 + 2045 + i) * 2048 + 1536 + c]);
  }
  for (int e = gt; e < 128 * 3 * 512; e += gs) {
    int b = e / 1536, i = (e / 512) % 3, c = e & 511;
    p.out[OUT_SCONV + e] = bf2f(Q[(size_t)(NP + b * 4 + 1 + i) * 2048 + 1536 + c]);
  }
}

__device__ __forceinline__ void res_fix_phase(const Params& p) {
  u16* xb = (u16*)(p.ws + O_XB);
  float* part = (float*)(p.ws + O_PART);
  const int lane = threadIdx.x & 63, wave = threadIdx.x >> 6;
  for (int row = NP + blockIdx.x * 8 + wave; row < MT; row += gridDim.x * 8) {
    const float* xr = p.out + (size_t)row * 1024;
    float ss = 0.f;
#pragma unroll
    for (int i = 0; i < 4; i++) {
      float4 v = *(const float4*)(xr + i * 256 + lane * 4);
      ss += v.x * v.x + v.y * v.y + v.z * v.z + v.w * v.w;
      ushort4 o;
      o.x = f2bf(v.x); o.y = f2bf(v.y); o.z = f2bf(v.z); o.w = f2bf(v.w);
      *(ushort4*)(xb + (size_t)row * 1024 + i * 256 + lane * 4) = o;
    }
    ss = wsum64(ss);
    if (lane < 16) part[(size_t)row * 16 + lane] = (lane == 0) ? ss : 0.f;
  }
}

__device__ __forceinline__ void final_phase(const Params& p) {
  const float* g = p.in[40];
  const int lane = threadIdx.x & 63, wave = threadIdx.x >> 6;
  for (int row = blockIdx.x * 8 + wave; row < MT; row += gridDim.x * 8) {
    float* xr = p.out + (size_t)row * 1024;
    float4 v0 = *(float4*)(xr + lane * 4), v1 = *(float4*)(xr + 256 + lane * 4);
    float4 v2 = *(float4*)(xr + 512 + lane * 4), v3 = *(float4*)(xr + 768 + lane * 4);
    float s = v0.x * v0.x + v0.y * v0.y + v0.z * v0.z + v0.w * v0.w + v1.x * v1.x + v1.y * v1.y + v1.z * v1.z + v1.w * v1.w +
              v2.x * v2.x + v2.y * v2.y + v2.z * v2.z + v2.w * v2.w + v3.x * v3.x + v3.y * v3.y + v3.z * v3.z + v3.w * v3.w;
    s = wsum64(s);
    const float rs = rsqrtf(s * (1.0f / 1024.0f) + 1e-6f);
    const float4 g0 = *(const float4*)(g + lane * 4), g1 = *(const float4*)(g + 256 + lane * 4);
    const float4 g2 = *(const float4*)(g + 512 + lane * 4), g3 = *(const float4*)(g + 768 + lane * 4);
    v0.x *= rs * g0.x; v0.y *= rs * g0.y; v0.z *= rs * g0.z; v0.w *= rs * g0.w;
    v1.x *= rs * g1.x; v1.y *= rs * g1.y; v1.z *= rs * g1.z; v1.w *= rs * g1.w;
    v2.x *= rs * g2.x; v2.y *= rs * g2.y; v2.z *= rs * g2.z; v2.w *= rs * g2.w;
    v3.x *= rs * g3.x; v3.y *= rs * g3.y; v3.z *= rs * g3.z; v3.w *= rs * g3.w;
    *(float4*)(xr + lane * 4) = v0; *(float4*)(xr + 256 + lane * 4) = v1;
    *(float4*)(xr + 512 + lane * 4) = v2; *(float4*)(xr + 768 + lane * 4) = v3;
  }
}


constexpr int NPHASE = 21;
enum { K_P0 = 0, K_G_SCALE, K_G_PLAIN, K_G_FF1, K_G_RES, K_G_POST, K_POOL, K_SCAN, K_MIX1, K_LRUFIX, K_FINAL };

#define PH(n, sync_) if (plo <= (n) && (n) <= phi) { if ((n) > plo && (sync_)) { if ((n) == 1) { grid.sync(); xb = xcd_barrier_post((unsigned*)(ws + O_XBAR), (volatile LAS unsigned*)&xb_words); } else xcd_barrier(xb); }
#define PHEND }
#define WSB(o) ((const u16*)(ws + (o)))
#define WSO(o) ((u16*)(ws + (o)))
__global__ void __launch_bounds__(512) mega(Params p, int plo, int phi) {
  cg::grid_group grid = cg::this_grid();
  char* ws = p.ws;
  __shared__ uint4 xb_words;
  if (threadIdx.x == 0) xb_words = make_uint4(0u, 0u, 0u, 0u);
  __syncthreads();
  XcdBarrier xb; xb.bar = (unsigned*)(ws + O_XBAR); xb.x = 0; xb.st = (volatile LAS unsigned*)&xb_words;
  PH(0, 1) phase0(p); PHEND
  PH(1, 1) gemm_phase<EPI_SCALE>(p, WSB(O_XB), 1024, WSB(O_WIN0), 1024, 1024, 2816, WSO(O_P), 2816, 0, 0); PHEND
  PH(2, 1) pool_phase(p); PHEND
  PH(3, 1) gemm_phase<EPI_PLAIN>(p, WSB(O_LIN), 256, WSB(O_WLW), 64, 64, 768, WSO(O_WPRE), 768, 0, 0); PHEND
  PH(4, 0) gemm_phase<EPI_PLAIN>(p, WSB(O_LIN + 128), 256, WSB(O_WLA), 64, 64, 768, WSO(O_APRE), 768, 0, 140); PHEND
  PH(5, 1) rwkv_prep_phase(p); PHEND
  PH(6, 1) scan_phase(p, 0, 0, 3264); pool_queue(p); PHEND
  PH(7, 1) gemm_phase<EPI_POST>(p, WSB(O_LIN + 256), 256, WSB(O_WLG), 128, 128, 768, nullptr, 0, 0, 0); PHEND
  PH(8, 1) gemm_phase<EPI_RES>(p, WSB(O_Y), 1024, WSB(O_WOUT0), 1024, 1024, 1024, WSO(O_XB), 1024, 1, 0); PHEND
  PH(9, 1) res_fix_phase(p); PHEND
  PH(10, 1) gemm_phase<EPI_FF1>(p, WSB(O_XB), 1024, WSB(O_WF10), 1024, 1024, 4096, WSO(O_H), 4096, 0, 0); PHEND
  PH(11, 1) gemm_phase<EPI_RES>(p, WSB(O_H), 4096, WSB(O_WF20), 4096, 4096, 1024, WSO(O_XB), 1024, 0, 0); PHEND
  PH(12, 1) res_fix_phase(p); PHEND
  PH(13, 1) gemm_phase<EPI_SCALE>(p, WSB(O_XB), 1024, WSB(O_WIN1), 1024, 1024, 2048, WSO(O_P), 2048, 0, 0); PHEND
  PH(14, 1) mix1_phase(p); PHEND
  PH(15, 1) lru_fix_phase(p, xb); PHEND
  PH(16, 1) gemm_phase<EPI_RES>(p, WSB(O_Y), 1024, WSB(O_WOUT1), 1024, 1024, 1024, WSO(O_XB), 1024, 0, 0); PHEND
  PH(17, 1) res_fix_phase(p); PHEND
  PH(18, 1) gemm_phase<EPI_FF1>(p, WSB(O_XB), 1024, WSB(O_WF11), 1024, 1024, 4096, WSO(O_H), 4096, 0, 0); PHEND
  PH(19, 1) gemm_phase<EPI_RES>(p, WSB(O_H), 4096, WSB(O_WF21), 4096, 4096, 1024, WSO(O_XB), 1024, 0, 0); PHEND
  PH(20, 1) final_phase(p); PHEND
}

extern "C" void kernel_launch(void* const* d_in, const int* in_sizes, int n_in, void* d_out, int out_size, void* d_ws,
                              size_t ws_size, hipStream_t stream) {
  static int grid_blocks = 0;
  if (!grid_blocks) {
    int dev = 0, cus = 0, per_cu = 0;
    hipGetDevice(&dev);
    hipDeviceGetAttribute(&cus, hipDeviceAttributeMultiprocessorCount, dev);
    hipOccupancyMaxActiveBlocksPerMultiprocessor(&per_cu, mega, 512, 0);
    if (per_cu < 1) per_cu = 1;
    grid_blocks = cus;
    if (grid_blocks > cus * per_cu) grid_blocks = cus * per_cu;
    if (ws_size < WS_NEED) fprintf(stderr, "workspace too small: %zu < %zu\n", ws_size, (size_t)WS_NEED);
  }
  Params p{};
  for (int i = 0; i < 41; i++) p.in[i] = (const float*)d_in[i];
  p.out = (float*)d_out;
  p.ws = (char*)d_ws;
  int plo = 0, phi = NPHASE - 1;
  void* args[] = {&p, &plo, &phi};
  hipError_t e = hipLaunchCooperativeKernel((void*)mega, dim3(grid_blocks), dim3(512), args, 0, stream);
  if (e != hipSuccess) fprintf(stderr, "cooperative launch failed: %s (grid %d)\n", hipGetErrorString(e), grid_blocks);
}
```
